# Optimizing an MI355X kernel written in HIP

```python
import math
import jax, jax.numpy as jnp
from jax import lax
import numpy as np

D_MODEL = 1024
BATCH = 16
SEQ = 2048
DEPTH = 1

CHUNK = 64
Q_BLOCK = 128
N_MEM = 256
N_HEADS_A = 8
HEAD_DIM_A = 64
D_A = N_HEADS_A * 2 * HEAD_DIM_A
D_CONV = D_MODEL
CONV_K = 31
N_HEADS_X = 4
HEAD_DIM_X = 256
D_X = N_HEADS_X * HEAD_DIM_X
N_BRANCH = 3
N_BUCKETS = 32
MAX_DIST = 128
EPS = 1e-6
NEG_INF = -1e30
IN_SIZES = (D_A, D_A, D_A, D_A, 2 * D_CONV, D_CONV, D_X, D_X, N_BRANCH * D_MODEL)
IN_WIDTH = sum(IN_SIZES)
IN_SPLITS = tuple(int(s) for s in np.cumsum(IN_SIZES)[:-1])

kernel_name = "hybrid_diffattn_conformer_memxattn_gated"


def _rmsnorm(x, g):
    xf = x.astype(jnp.float32)
    y = xf * lax.rsqrt(jnp.mean(xf * xf, axis=-1, keepdims=True) + EPS)
    return (y * g.astype(jnp.float32)).astype(x.dtype)


def _layernorm(x, g, b):
    xf = x.astype(jnp.float32)
    mu = jnp.mean(xf, axis=-1, keepdims=True)
    var = jnp.mean(jnp.square(xf - mu), axis=-1, keepdims=True)
    y = (xf - mu) * lax.rsqrt(var + EPS)
    return (y * g.astype(jnp.float32) + b.astype(jnp.float32)).astype(x.dtype)


def _t5_bucket(rel):
    nb = N_BUCKETS // 2
    max_exact = nb // 2
    ret = (rel > 0).astype(jnp.int32) * nb
    n = jnp.abs(rel)
    nf = jnp.maximum(n, 1).astype(jnp.float32)
    large = max_exact + (jnp.log(nf / max_exact) / math.log(MAX_DIST / max_exact)
                         * (nb - max_exact)).astype(jnp.int32)
    large = jnp.minimum(large, nb - 1)
    return ret + jnp.where(n < max_exact, n, large)


def _diff_attention(q, k, v, rel_bias, lam):
    S = q.shape[1]
    scale = HEAD_DIM_A ** -0.5
    outs = []
    for i in range(S // Q_BLOCK):
        q0 = i * Q_BLOCK
        lk = q0 + Q_BLOCK
        qb, kb, vb = q[:, q0:lk], k[:, :lk], v[:, :lk]
        qpos = q0 + jnp.arange(Q_BLOCK, dtype=jnp.int32)
        kpos = jnp.arange(lk, dtype=jnp.int32)
        rel = kpos[None, :] - qpos[:, None]
        bias = jnp.transpose(rel_bias[_t5_bucket(rel)].astype(jnp.float32), (2, 0, 1))
        allowed = (kpos[None, :] // CHUNK) <= (qpos[:, None] // CHUNK)
        s = jnp.einsum('bqhcd,bkhcd->bhcqk', qb, kb).astype(jnp.float32) * scale
        s = jnp.where(allowed, s + bias[None, :, None], NEG_INF)
        p = jax.nn.softmax(s, axis=-1)
        a = p[:, :, 0] - lam * p[:, :, 1]
        outs.append(jnp.einsum('bhqk,bkhe->bqhe', a.astype(vb.dtype), vb))
    return jnp.concatenate(outs, axis=1)


def _conv_module(u, conv_w, conv_b, ln_g, ln_b):
    a, g = jnp.split(u, 2, axis=-1)
    c = a * jax.nn.sigmoid(g)
    w = conv_w.astype(c.dtype)[:, None, :]
    c = lax.conv_general_dilated(c, w, window_strides=(1,), padding=[(CONV_K - 1, 0)],
                                 dimension_numbers=('NWC', 'WIO', 'NWC'),
                                 feature_group_count=D_CONV) + conv_b
    return jax.nn.silu(_layernorm(c, ln_g, ln_b))


def _cross_attention(q, mem_n, w_mem_kv):
    B, S = q.shape[:2]
    kv = (mem_n @ w_mem_kv).reshape(B, N_MEM, 2, N_HEADS_X, HEAD_DIM_X)
    s = jnp.einsum('bqhd,bkhd->bhqk', q, kv[:, :, 0]).astype(jnp.float32) * HEAD_DIM_X ** -0.5
    p = jax.nn.softmax(s, axis=-1).astype(q.dtype)
    return jnp.einsum('bhqk,bkhd->bqhd', p, kv[:, :, 1]).reshape(B, S, D_X)


def setup_inputs(seed: int = 0) -> dict:
    key = jax.random.key(seed)
    ks = jax.random.split(key, 24)
    f32 = jnp.float32
    L, D = DEPTH, D_MODEL
    nrm = lambda k, shape, s: jax.random.normal(k, shape, f32) * s
    return {
        "x": nrm(ks[0], (BATCH, SEQ, D), 1.0),
        "mem": nrm(ks[1], (BATCH, N_MEM, D), 1.0),
        "rel_bias": nrm(ks[2], (N_BUCKETS, N_HEADS_A), 0.5),
        "g_pre": 1.0 + nrm(ks[3], (L, D), 0.05),
        "g_mem": 1.0 + nrm(ks[4], (L, D), 0.05),
        "w_in": nrm(ks[5], (L, D, IN_WIDTH), D ** -0.5),
        "b_merge": nrm(ks[6], (L, N_BRANCH * D), 0.02),
        "lam_q1": nrm(ks[7], (L, HEAD_DIM_A), 0.1),
        "lam_k1": nrm(ks[8], (L, HEAD_DIM_A), 0.1),
        "lam_q2": nrm(ks[9], (L, HEAD_DIM_A), 0.1),
        "lam_k2": nrm(ks[10], (L, HEAD_DIM_A), 0.1),
        "g_subln": 1.0 + nrm(ks[11], (L, 2 * HEAD_DIM_A), 0.05),
        "w_oa": nrm(ks[12], (L, D_A, D), D_A ** -0.5),
        "conv_w": nrm(ks[13], (L, CONV_K, D_CONV), CONV_K ** -0.5),
        "conv_b": nrm(ks[14], (L, D_CONV), 0.02),
        "ln_g": 1.0 + nrm(ks[15], (L, D_CONV), 0.05),
        "ln_b": nrm(ks[16], (L, D_CONV), 0.02),
        "w_ob": nrm(ks[17], (L, D_CONV, D), D_CONV ** -0.5),
        "w_mem_kv": nrm(ks[18], (L, D, 2 * D_X), D ** -0.5),
        "w_oc": nrm(ks[19], (L, D_X, D), D_X ** -0.5),
        "w_out": nrm(ks[20], (L, D, D), D ** -0.5),
        "g_post": 1.0 + nrm(ks[21], (L, D), 0.05),
    }


def reference(x, mem, rel_bias, g_pre, g_mem, w_in, b_merge, lam_q1, lam_k1, lam_q2, lam_k2,
              g_subln, w_oa, conv_w, conv_b, ln_g, ln_b, w_ob, w_mem_kv, w_oc, w_out, g_post):
    B, S, D = x.shape
    for l in range(DEPTH):
        lam_init = 0.8 - 0.6 * math.exp(-0.3 * l)
        h = _rmsnorm(x, g_pre[l])
        proj = h @ w_in[l]
        qa, ka, va, za, ub, zb, qc, zc, gates = jnp.split(proj, IN_SPLITS, axis=-1)

        lam = (jnp.exp(jnp.sum(lam_q1[l].astype(jnp.float32) * lam_k1[l].astype(jnp.float32)))
               - jnp.exp(jnp.sum(lam_q2[l].astype(jnp.float32) * lam_k2[l].astype(jnp.float32)))
               + lam_init)
        oa = _diff_attention(qa.reshape(B, S, N_HEADS_A, 2, HEAD_DIM_A),
                             ka.reshape(B, S, N_HEADS_A, 2, HEAD_DIM_A),
                             va.reshape(B, S, N_HEADS_A, 2 * HEAD_DIM_A), rel_bias, lam)
        oa = (_rmsnorm(oa, g_subln[l]) * (1.0 - lam_init)).reshape(B, S, D_A)
        ya = (oa * jax.nn.silu(za)) @ w_oa[l]

        ob = _conv_module(ub, conv_w[l], conv_b[l], ln_g[l], ln_b[l])
        yb = (ob * jax.nn.silu(zb)) @ w_ob[l]

        oc = _cross_attention(qc.reshape(B, S, N_HEADS_X, HEAD_DIM_X), _rmsnorm(mem, g_mem[l]), w_mem_kv[l])
        yc = (oc * jax.nn.silu(zc)) @ w_oc[l]

        g = jax.nn.sigmoid(gates + b_merge[l]).reshape(B, S, N_BRANCH, D)
        y = (g[:, :, 0] * ya + g[:, :, 1] * yb + g[:, :, 2] * yc) @ w_out[l]
        x = x + _rmsnorm(y, g_post[l])
    return x
```

```cpp
#include <hip/hip_runtime.h>
#include <cstdio>
#include <cstdint>

#define LAS __attribute__((address_space(3)))
#define GAS __attribute__((address_space(1)))
typedef unsigned short bf16;
typedef short bf16x8 __attribute__((ext_vector_type(8)));
typedef short s16x4 __attribute__((ext_vector_type(4)));
typedef float f32x4 __attribute__((ext_vector_type(4)));
typedef float f32x2 __attribute__((ext_vector_type(2)));
typedef float f32x16 __attribute__((ext_vector_type(16)));
typedef unsigned u32x4 __attribute__((ext_vector_type(4)));
typedef unsigned u32x2 __attribute__((ext_vector_type(2)));
typedef GAS unsigned gu32;

#ifndef MK_N_LAUNCHES
#define MK_N_LAUNCHES 7
#endif
constexpr int N_PHASES = 7;

constexpr int BATCH = 16, SEQ = 2048, DM = 1024, MTOK = BATCH * SEQ;
constexpr int NMEM = 256, MMEM = BATCH * NMEM;
constexpr int INW = 12288;
constexpr float EPS = 1e-6f;
constexpr float LOG2E = 1.4426950408889634f;
constexpr float C2A = 0.125f * LOG2E;
constexpr float C2X = 0.0625f * LOG2E;
constexpr int NREL = 2112;

constexpr size_t MiB = 1u << 20;
constexpr size_t WS_CTL = 0, CTL_ZERO_BYTES = 1 * MiB;
constexpr size_t WS_WIN = 2 * MiB;
constexpr size_t WS_WOA = 26 * MiB, WS_WOB = 28 * MiB, WS_WOC = 30 * MiB, WS_WOUT = 32 * MiB;
constexpr size_t WS_WMKV = 34 * MiB;
constexpr size_t WS_MN = 38 * MiB;
constexpr size_t WS_KM = 46 * MiB;
constexpr size_t WS_VT = 54 * MiB;
constexpr size_t WS_TAB = 62 * MiB;
constexpr size_t WS_U0 = 64 * MiB, UB = 64 * MiB;
constexpr size_t WS_T = WS_U0 + 0 * UB;
constexpr size_t WS_G = WS_U0 + 3 * UB;
constexpr size_t WS_END = WS_U0 + 6 * UB;
constexpr size_t OUT_XN = 0, OUT_P = 64 * MiB;

constexpr int CW_TMO = 0;
constexpr int CW_BAR = 4096;

constexpr int RING_BYTES = 131072;
constexpr int LDSCTL_OFF = RING_BYTES, MISC_OFF = LDSCTL_OFF + 320;
constexpr int LSUM_OFF = RING_BYTES + 1024;
constexpr int LDS_BYTES = 147456;

__device__ __forceinline__ int fresh_tid() { int t = threadIdx.x; asm volatile("" : "+v"(t)); return t; }
#define LDS_WAIT() asm volatile("s_waitcnt lgkmcnt(0)" ::: "memory")
#define VM_WAIT() asm volatile("s_waitcnt vmcnt(0)" ::: "memory")
#define RLX_AGENT __ATOMIC_RELAXED, __HIP_MEMORY_SCOPE_AGENT

__device__ __forceinline__ unsigned f2bf(float f) { unsigned u = __builtin_bit_cast(unsigned, f); return (u + 0x7fffu + ((u >> 16) & 1u)) >> 16; }
__device__ __forceinline__ unsigned pk2(float lo, float hi) { return f2bf(lo) | (f2bf(hi) << 16); }
typedef __bf16 bf16x2_t __attribute__((ext_vector_type(2)));
__device__ __forceinline__ unsigned cvt_pk_bf16(float lo, float hi) { f32x2 v = {lo, hi}; bf16x2_t b = __builtin_convertvector(v, bf16x2_t); return __builtin_bit_cast(unsigned, b); }
__device__ __forceinline__ float bflo(unsigned w) { return __uint_as_float(w << 16); }
__device__ __forceinline__ float bfhi(unsigned w) { return __uint_as_float(w & 0xffff0000u); }
__device__ __forceinline__ float sigmoidf_(float v) { return __builtin_amdgcn_rcpf(1.0f + __builtin_amdgcn_exp2f(-v * LOG2E)); }
__device__ __forceinline__ float siluf_(float v) { return v * sigmoidf_(v); }
__device__ __forceinline__ float wave_sum(float v) {
#pragma unroll
    for (int o = 1; o < 64; o <<= 1) v += __shfl_xor(v, o);
    return v;
}

namespace pg8 {
constexpr int BM = 256, BK = 64, HALF = 128, HTB = HALF * BK * 2, NXCD = 8, WGM = 8;
__host__ __device__ __forceinline__ int lds_byte(int r, int c) { const int st = (r >> 4) * 2 + (c >> 5), rr = r & 15, cc = c & 31, ob = rr * 64 + cc * 2; return st * 1024 + (ob ^ (((ob >> 9) & 1) << 5)); }
__host__ __device__ __forceinline__ void stage_rc(int b, int& R, int& C) { const int st = b / 1024, sb = b % 1024, swz = sb ^ (((sb >> 9) & 1) << 5); R = (st >> 1) * 16 + swz / 64; C = (st & 1) * 32 + (swz % 64) / 2; }
__host__ __device__ __forceinline__ int perm32(int rho) { const int n = rho >> 4, i = rho & 15; return 8 * (i >> 2) + 4 * n + (i & 3); }

struct Unit { int pm, pn, kind; };
struct Ops { const char* A; const char* B; unsigned lda2, ldb2; };

__device__ __forceinline__ void tile_order(int L, int nM, int nN, int& pm, int& pn) {
    const int nwg = nM * nN; int wgid = L;
    { const int q = nwg / NXCD, r = nwg % NXCD, xcd = wgid % NXCD, off = wgid / NXCD; wgid = (xcd < r ? xcd * (q + 1) : r * (q + 1) + (xcd - r) * q) + off; }
    const int nig = WGM * nN, gid = wgid / nig, fm = gid * WGM, gsz = (nM - fm) < WGM ? (nM - fm) : WGM;
    pm = fm + ((wgid % nig) % gsz); pn = (wgid % nig) / gsz;
}

template <class Epi, class Sched>
__device__ __forceinline__ void gemm_phase(LAS unsigned char* lds, const int nt, const Sched& S, const Epi& E) {
    const int tid = fresh_tid(), wid = __builtin_amdgcn_readfirstlane(tid >> 6), lane = tid & 63, wr = wid >> 2, wc = wid & 3, fr = lane & 15, fq = lane >> 4;
    int sR[2], sRb[2], sC2[2];
#pragma unroll
    for (int i = 0; i < 2; ++i) { int R, C; stage_rc(tid * 16 + i * 8192, R, C); sR[i] = R; sRb[i] = (R & ~31) + perm32(R & 31); sC2[i] = C * 2; }
    const size_t kstep = (size_t)(BK * 2);
    const unsigned ldsw = (unsigned)wid * 1024u;
    const int aoff = lds_byte(wr * 64 + fr, fq * 8), boff = lds_byte(wc * 32 + fr, fq * 8);
#define PG8_SA(b, h) (((b) * 2 + (h)) * HTB)
#define PG8_SB(b, h) ((4 + (b) * 2 + (h)) * HTB)
#define PG8_STAGE(bufoff, gbase, v0, v1) do { \
        __builtin_amdgcn_global_load_lds((const unsigned*)((const char*)(gbase) + (v0)), (LAS unsigned*)(lds + (bufoff) + ldsw), 16, 0, 0); \
        __builtin_amdgcn_global_load_lds((const unsigned*)((const char*)(gbase) + (v1)), (LAS unsigned*)(lds + (bufoff) + ldsw + 8192), 16, 0, 0); } while (0)
#define PG8_LDA(dst, b, h) do { _Pragma("unroll") for (int m = 0; m < 4; ++m) _Pragma("unroll") for (int k = 0; k < 2; ++k) dst[m][k] = *(const LAS bf16x8*)(lds + PG8_SA(b, h) + aoff + m * 2048 + k * 1024); } while (0)
#define PG8_LDB(dst, b, h) do { _Pragma("unroll") for (int n = 0; n < 2; ++n) _Pragma("unroll") for (int k = 0; k < 2; ++k) dst[n][k] = *(const LAS bf16x8*)(lds + PG8_SB(b, h) + boff + n * 2048 + k * 1024); } while (0)
#define PG8_MMA(ai, bj, At, Bt) do { __builtin_amdgcn_s_setprio(1); _Pragma("unroll") for (int m = 0; m < 4; ++m) _Pragma("unroll") for (int n = 0; n < 2; ++n) _Pragma("unroll") for (int k = 0; k < 2; ++k) \
        acc[ai][bj][m][n] = __builtin_amdgcn_mfma_f32_16x16x32_bf16(Bt[n][k], At[m][k], acc[ai][bj][m][n], 0, 0, 0); __builtin_amdgcn_s_setprio(0); } while (0)
#define PG8_WAIT_V(n) asm volatile("s_waitcnt vmcnt(" #n ")" ::: "memory")
#define PG8_WAIT_L(n) asm volatile("s_waitcnt lgkmcnt(" #n ")" ::: "memory")
#define PG8_BAR __builtin_amdgcn_s_barrier()
#define PG8_SCHED __builtin_amdgcn_sched_barrier(0)
    Unit cur, nxt; int ui = 0;
    if (!S.next(0, cur)) return;
    Ops co, no; S.ops(cur, co);
    unsigned vA0 = sR[0] * co.lda2 + sC2[0], vA1 = sR[1] * co.lda2 + sC2[1], vB0 = sRb[0] * co.ldb2 + sC2[0], vB1 = sRb[1] * co.ldb2 + sC2[1];
    size_t hA = (size_t)HALF * co.lda2, hB = (size_t)HALF * co.ldb2;
    f32x4 acc[2][2][4][2];
#pragma unroll
    for (int a = 0; a < 2; ++a)
#pragma unroll
        for (int b = 0; b < 2; ++b)
#pragma unroll
            for (int m = 0; m < 4; ++m)
#pragma unroll
                for (int n = 0; n < 2; ++n) acc[a][b][m][n] = (f32x4){0.f, 0.f, 0.f, 0.f};
    bf16x8 At[4][2], B0[2][2], B1[2][2];
    const char* cA = co.A; const char* cB = co.B;
    PG8_STAGE(PG8_SB(0, 0), cB, vB0, vB1); PG8_STAGE(PG8_SB(0, 1), cB + hB, vB0, vB1); PG8_STAGE(PG8_SA(0, 0), cA, vA0, vA1); PG8_STAGE(PG8_SA(0, 1), cA + hA, vA0, vA1);
    if (wr == 1) PG8_BAR;
    PG8_WAIT_V(2); PG8_BAR;
    PG8_STAGE(PG8_SB(1, 0), cB + kstep, vB0, vB1); PG8_STAGE(PG8_SA(1, 0), cA + kstep, vA0, vA1); PG8_STAGE(PG8_SB(1, 1), cB + hB + kstep, vB0, vB1);
    PG8_WAIT_V(6); PG8_BAR;
    for (;;) {
        const bool has_next = S.next(ui + 1, nxt);
        if (has_next) S.ops(nxt, no); else no = co;
        const char* nA = no.A; const char* nB = no.B;
        const unsigned nvA0 = sR[0] * no.lda2 + sC2[0], nvA1 = sR[1] * no.lda2 + sC2[1], nvB0 = sRb[0] * no.ldb2 + sC2[0], nvB1 = sRb[1] * no.ldb2 + sC2[1];
        const size_t nhA = (size_t)HALF * no.lda2, nhB = (size_t)HALF * no.ldb2;
        for (int t = 0; t < nt; t += 2) {
            const bool last = (t == nt - 2);
            const char* a1 = cA + (size_t)(t + 1) * kstep;
            const char* a2 = last ? nA : cA + (size_t)(t + 2) * kstep; const char* b2 = last ? nB : cB + (size_t)(t + 2) * kstep;
            const char* a3 = a2 + kstep; const char* b3 = b2 + kstep;
            const unsigned xA0 = last ? nvA0 : vA0, xA1 = last ? nvA1 : vA1, xB0 = last ? nvB0 : vB0, xB1 = last ? nvB1 : vB1;
            const size_t xhA = last ? nhA : hA, xhB = last ? nhB : hB;
            PG8_LDB(B0, 0, 0); PG8_LDB(B1, 0, 1); PG8_SCHED; PG8_LDA(At, 0, 0); PG8_STAGE(PG8_SA(1, 1), a1 + hA, vA0, vA1);
            PG8_WAIT_V(8); PG8_WAIT_L(0); PG8_BAR; PG8_MMA(0, 0, At, B0); PG8_MMA(0, 1, At, B1); PG8_BAR; PG8_SCHED;
            PG8_LDA(At, 0, 1); PG8_STAGE(PG8_SB(0, 0), b2, xB0, xB1); PG8_STAGE(PG8_SB(0, 1), b2 + xhB, xB0, xB1); PG8_STAGE(PG8_SA(0, 0), a2, xA0, xA1);
            PG8_WAIT_V(8); PG8_WAIT_L(0); PG8_BAR; PG8_MMA(1, 0, At, B0); PG8_MMA(1, 1, At, B1); PG8_BAR; PG8_SCHED;
            PG8_LDB(B0, 1, 0); PG8_LDB(B1, 1, 1); PG8_SCHED; PG8_LDA(At, 1, 0); PG8_STAGE(PG8_SA(0, 1), a2 + xhA, xA0, xA1);
            PG8_WAIT_V(8); PG8_WAIT_L(0); PG8_BAR; PG8_MMA(0, 0, At, B0); PG8_MMA(0, 1, At, B1); PG8_BAR; PG8_SCHED;
            PG8_LDA(At, 1, 1); PG8_STAGE(PG8_SB(1, 0), b3, xB0, xB1); PG8_STAGE(PG8_SB(1, 1), b3 + xhB, xB0, xB1); PG8_STAGE(PG8_SA(1, 0), a3, xA0, xA1);
            PG8_WAIT_V(8); PG8_WAIT_L(0); PG8_BAR; PG8_MMA(1, 0, At, B0); PG8_MMA(1, 1, At, B1); PG8_BAR; PG8_SCHED;
        }
        if (wr == 0) PG8_BAR;
        { int le = lane; asm volatile("" : "+v"(le));
          E(acc, cur, wr, wc, le & 15, le >> 4, lds + RING_BYTES); }
        if (!has_next) break;
#pragma unroll
        for (int a = 0; a < 2; ++a)
#pragma unroll
            for (int b = 0; b < 2; ++b)
#pragma unroll
                for (int m = 0; m < 4; ++m)
#pragma unroll
                    for (int n = 0; n < 2; ++n) acc[a][b][m][n] = (f32x4){0.f, 0.f, 0.f, 0.f};
        cur = nxt; co = no; cA = nA; cB = nB; vA0 = nvA0; vA1 = nvA1; vB0 = nvB0; vB1 = nvB1; hA = nhA; hB = nhB; ++ui;
        if (wr == 1) PG8_BAR;
    }
    PG8_WAIT_V(0);
    PG8_BAR;
#undef PG8_SA
#undef PG8_SB
#undef PG8_STAGE
#undef PG8_LDA
#undef PG8_LDB
#undef PG8_MMA
#undef PG8_WAIT_V
#undef PG8_WAIT_L
#undef PG8_BAR
#undef PG8_SCHED
}

typedef f32x4 Acc[2][2][4][2];
__device__ __forceinline__ void store_plain(const Acc& acc, bf16* base, size_t ldc, float sc) {
#pragma unroll
    for (int ai = 0; ai < 2; ++ai)
#pragma unroll
        for (int m = 0; m < 4; ++m) { bf16* rowp = base + (size_t)(ai * HALF + m * 16) * ldc;
#pragma unroll
            for (int bj = 0; bj < 2; ++bj) { const f32x4 v0 = acc[ai][bj][m][0] * sc, v1 = acc[ai][bj][m][1] * sc;
                u32x4 w; w.x = cvt_pk_bf16(v0[0], v0[1]); w.y = cvt_pk_bf16(v0[2], v0[3]); w.z = cvt_pk_bf16(v1[0], v1[1]); w.w = cvt_pk_bf16(v1[2], v1[3]);
                *(u32x4*)(rowp + bj * HALF) = w; } }
}
}

#define XB_TMO      128
#define XB_XCNT(j)  (256  + 64 * (j))
#define XB_XSUB(j)  (1280 + 64 * (j))
#define XB_XGEN(j)  (2304 + 64 * (j))
#define XB_TOP      3328
#define XB_TOPGEN   3392
#define XCD_BAR_WORDS 3456
#define XB_SPIN_CAP (1u << 18)
__device__ __forceinline__ unsigned xb_ld(unsigned* p)              { return __hip_atomic_load(p, __ATOMIC_RELAXED, __HIP_MEMORY_SCOPE_AGENT); }
__device__ __forceinline__ unsigned xb_add(unsigned* p, unsigned v) { return __hip_atomic_fetch_add(p, v, __ATOMIC_RELAXED, __HIP_MEMORY_SCOPE_AGENT); }
__device__ __forceinline__ unsigned xb_xcc_id() { return (unsigned)__builtin_amdgcn_s_getreg((3 << 11) | 20) & 0xFu; }
#define XB_SPIN(cond, bar) do { unsigned _sp = 0; while (cond) { __builtin_amdgcn_s_sleep(1); \
    if ((++_sp & 255u) == 0u) { if (xb_ld(&(bar)[XB_TMO])) break; if (_sp > XB_SPIN_CAP) { atomicAdd(&(bar)[XB_TMO], 1u); break; } } } } while (0)
struct XcdBarrier { unsigned* bar; unsigned x; volatile LAS unsigned* st; };
__device__ __forceinline__ XcdBarrier xcd_barrier_post(unsigned* bar, volatile LAS unsigned* st) {
    XcdBarrier b; b.bar = bar; b.x = xb_xcc_id(); b.st = st;
    if (threadIdx.x == 0) (void)xb_add(&bar[XB_XCNT(b.x)], 1u);
    return b;
}
__device__ __forceinline__ void xcd_barrier_complete(unsigned* bar, unsigned x, unsigned& nloc, unsigned& nx) {
    const unsigned G = gridDim.x * gridDim.y * gridDim.z;
    unsigned sum, cnt, mine, sp = 0u;
    for (;;) {
        sum = 0u; cnt = 0u; mine = 0u;
#pragma unroll
        for (unsigned j = 0; j < 16; ++j) { const unsigned c = xb_ld(&bar[XB_XCNT(j)]); sum += c; cnt += (c > 0u) ? 1u : 0u; mine = (j == x) ? c : mine; }
        if (sum == G) break;
        __builtin_amdgcn_s_sleep(1);
        if ((++sp & 255u) == 0u) { if (xb_ld(&bar[XB_TMO])) break; if (sp > XB_SPIN_CAP) { atomicAdd(&bar[XB_TMO], 1u); break; } }
    }
    nloc = mine > 0u ? mine : 1u; nx = cnt > 0u ? cnt : 1u;
}
__device__ __forceinline__ void xcd_barrier(const XcdBarrier& b) {
    asm volatile("s_waitcnt vmcnt(0)" ::: "memory");
    __syncthreads();
    if (threadIdx.x == 0) {
        unsigned* bar = b.bar;
        __builtin_amdgcn_s_waitcnt(0);
        unsigned nloc = b.st[0], nx = b.st[1];
        if (nloc == 0u) { xcd_barrier_complete(bar, b.x, nloc, nx); b.st[0] = nloc; b.st[1] = nx; }
        const unsigned old = xb_add(&bar[XB_XSUB(b.x)], 1u);
        const unsigned gen = old / nloc;
        if (old + 1u == (gen + 1u) * nloc) {
            __builtin_amdgcn_fence(__ATOMIC_RELEASE, "agent");
            asm volatile("s_waitcnt vmcnt(0)" ::: "memory");
            const unsigned og = xb_add(&bar[XB_TOP], 1u);
            const unsigned tg = og / nx;
            if (og + 1u == (tg + 1u) * nx) xb_add(&bar[XB_TOPGEN], 1u);
            else XB_SPIN(xb_ld(&bar[XB_TOPGEN]) == tg, bar);
            __builtin_amdgcn_fence(__ATOMIC_ACQUIRE, "agent");
            xb_add(&bar[XB_XGEN(b.x)], 1u);
            asm volatile("s_waitcnt vmcnt(0)" ::: "memory");
        } else {
            XB_SPIN(xb_ld(&bar[XB_XGEN(b.x)]) == gen, bar);
            __builtin_amdgcn_fence(__ATOMIC_ACQUIRE, "agent");
            asm volatile("s_waitcnt vmcnt(0)" ::: "memory");
        }
    }
    __syncthreads();
}

struct Frame {
    LAS unsigned char* lds;
    int tid, lane, wave, vcu, G;
    float* out; unsigned char* ws;
};
struct Args { const float* in[22]; float* out; unsigned char* ws; int ph_lo, ph_hi; };
typedef __attribute__((address_space(4))) const Args* KArgs;
__device__ __forceinline__ KArgs kargs() { KArgs p = (KArgs)__builtin_amdgcn_kernarg_segment_ptr(); asm volatile("" : "+s"(p)); return p; }
#define INP(i) (kargs()->in[i])
enum { I_X = 0, I_MEM, I_RELB, I_GPRE, I_GMEM, I_WIN, I_BMERGE, I_LQ1, I_LK1, I_LQ2, I_LK2, I_GSUB, I_WOA, I_CONVW, I_CONVB, I_LNG, I_LNB, I_WOB, I_WMKV, I_WOC, I_WOUT, I_GPOST };

__device__ __forceinline__ int dest_row(int c) {
    if (c < 3072) return c;
    if (c < 4096) return 6144 + (c - 3072);
    if (c < 5120) { const int j = (c - 4096) >> 7, i = (c - 4096) & 127; return 3072 + 256 * j + i; }
    if (c < 6144) { const int j = (c - 5120) >> 7, i = (c - 5120) & 127; return 3072 + 256 * j + 128 + i; }
    if (c < 7168) return 7168 + (c - 6144);
    if (c < 8192) return 5120 + (c - 7168);
    return c;
}
__device__ __forceinline__ void p0_transpose_item(const float* W, int K, int N, bf16* WT, int k0, int n0, int drow0, LAS float* scr, int lane) {
#pragma unroll 8
    for (int i = 0; i < 32; ++i) { const int kk = 2 * i + (lane >> 5); scr[kk * 33 + (lane & 31)] = W[(size_t)(k0 + kk) * N + n0 + (lane & 31)]; }
    LDS_WAIT(); asm volatile("" ::: "memory");
    const int c = lane & 7;
#pragma unroll
    for (int j = 0; j < 4; ++j) { const int n = (lane >> 3) + 8 * j; const LAS float* s = scr + (8 * c) * 33 + n;
        u32x4 o; o.x = pk2(s[0 * 33], s[1 * 33]); o.y = pk2(s[2 * 33], s[3 * 33]); o.z = pk2(s[4 * 33], s[5 * 33]); o.w = pk2(s[6 * 33], s[7 * 33]);
        *(GAS u32x4*)(WT + (size_t)(drow0 + n) * K + k0 + 8 * c) = o; }
    LDS_WAIT(); asm volatile("" ::: "memory");
}
__device__ __forceinline__ void rms_row_to_bf16(const float* xrow, const float* g, bf16* orow, int lane) {
    const GAS f32x4* xr = (const GAS f32x4*)xrow + lane; const GAS f32x4* gr = (const GAS f32x4*)g + lane;
    f32x4 v[4]; float s = 0.f;
#pragma unroll
    for (int j = 0; j < 4; ++j) { v[j] = xr[64 * j]; s += (v[j].x * v[j].x + v[j].y * v[j].y) + (v[j].z * v[j].z + v[j].w * v[j].w); }
    const float rstd = 1.f / sqrtf(wave_sum(s) * (1.f / 1024.f) + EPS);
    GAS unsigned long long* o8 = (GAS unsigned long long*)orow + lane;
#pragma unroll
    for (int j = 0; j < 4; ++j) { const f32x4 gg = gr[64 * j]; o8[64 * j] = (unsigned long long)pk2(v[j].x * rstd * gg.x, v[j].y * rstd * gg.y) | ((unsigned long long)pk2(v[j].z * rstd * gg.z, v[j].w * rstd * gg.w) << 32); }
}
__device__ __forceinline__ int t5_bucket(int rel) {
    const int n = rel < 0 ? -rel : rel; int v;
    if (n < 8) v = n; else if (n < 12) v = 8; else if (n < 16) v = 9; else if (n < 23) v = 10; else if (n < 32) v = 11; else if (n < 46) v = 12; else if (n < 64) v = 13; else if (n < 91) v = 14; else v = 15;
    return (rel > 0 ? 16 : 0) + v;
}
__device__ __forceinline__ void p0_prologue(Frame& F) {
    LAS float* scr = (LAS float*)(F.lds + F.wave * 16384);
    const int gw = F.vcu * 8 + F.wave, NGW = F.G * 8;
    bf16* WIN = (bf16*)(F.ws + WS_WIN);
    constexpr int I_IN = 16 * (INW / 32), I_SQ = 16 * 32, I_KV = 16 * 64;
    constexpr int NITEMS = I_IN + 4 * I_SQ + I_KV;
    const float* p_win = INP(I_WIN); const float* p_woa = INP(I_WOA); const float* p_wob = INP(I_WOB); const float* p_woc = INP(I_WOC); const float* p_wout = INP(I_WOUT); const float* p_wmkv = INP(I_WMKV);
    for (int it = gw; it < NITEMS; it += NGW) {
        int r = it;
        if (r < I_IN) { const int nblk = INW / 32, kb = r / nblk, nb = r % nblk; p0_transpose_item(p_win, 1024, INW, WIN, 64 * kb, 32 * nb, dest_row(32 * nb), scr, F.lane); continue; } r -= I_IN;
        if (r < 4 * I_SQ) { const int w = r / I_SQ, q = r % I_SQ, kb = q / 32, nb = q % 32;
            const float* src = w == 0 ? p_woa : w == 1 ? p_wob : w == 2 ? p_woc : p_wout;
            bf16* dst = (bf16*)(F.ws + (w == 0 ? WS_WOA : w == 1 ? WS_WOB : w == 2 ? WS_WOC : WS_WOUT));
            p0_transpose_item(src, 1024, 1024, dst, 64 * kb, 32 * nb, 32 * nb, scr, F.lane); continue; } r -= 4 * I_SQ;
        { const int kb = r / 64, nb = r % 64; p0_transpose_item(p_wmkv, 1024, 2048, (bf16*)(F.ws + WS_WMKV), 64 * kb, 32 * nb, 32 * nb, scr, F.lane); }
    }
    bf16* XN = (bf16*)((unsigned char*)F.out + OUT_XN);
    { const float* xin = INP(I_X); const float* gpre = INP(I_GPRE);
      for (int m = gw; m < MTOK; m += NGW) rms_row_to_bf16(xin + (size_t)m * DM, gpre, XN + (size_t)m * DM, F.lane); }
    bf16* MN = (bf16*)(F.ws + WS_MN);
    { const float* min_ = INP(I_MEM); const float* gmem = INP(I_GMEM);
      for (int m = gw; m < MMEM; m += NGW) rms_row_to_bf16(min_ + (size_t)m * DM, gmem, MN + (size_t)m * DM, F.lane); }
    float* tab = (float*)(F.ws + WS_TAB);
    { const float* relb = INP(I_RELB);
      for (int i = F.vcu * 512 + F.tid; i < 8 * NREL; i += F.G * 512) { const int h = i / NREL, j = i % NREL; const int rel = j - 2047; tab[i] = relb[t5_bucket(rel) * 8 + h] * LOG2E; } }
}

namespace att {
constexpr int L_K = 0, L_V = 16384, L_BIAS = 49152, L_WS = 49152 + NREL * 4, L_ST = L_WS + 2048, L_END = L_ST + 65536;
static_assert(L_END <= RING_BYTES, "attention LDS");
__device__ __forceinline__ int crow(int r, int hi) { return (r & 3) + 8 * (r >> 2) + 4 * hi; }
__device__ __forceinline__ void glds16(const void* gsrc, unsigned lds_dst) { unsigned keep;
    asm volatile("s_mov_b32 %0, m0\n\ts_mov_b32 m0, %2\n\ts_nop 0\n\tglobal_load_lds_dwordx4 %1, off\n\ts_mov_b32 m0, %0" : "=&s"(keep) : "v"(gsrc), "s"(lds_dst) : "memory"); }
typedef short v4i16_t __attribute__((ext_vector_type(4)));
__device__ __forceinline__ s16x4 vtr(const LAS char* p) { return __builtin_bit_cast(s16x4, __builtin_amdgcn_ds_read_tr16_b64_v4i16((LAS v4i16_t*)p)); }
#define MFMA32(a, b, c) __builtin_amdgcn_mfma_f32_32x32x16_bf16(a, b, c, 0, 0, 0)

__device__ __forceinline__ void attn_unit(int b, int h, int qb, const bf16* Q, const bf16* K, const bf16* V, bf16* O, const float* tab, const float* gsub, float lam, LAS unsigned char* shm) {
    const int tid = fresh_tid(), lane = tid & 63, r32 = lane & 31, hi = lane >> 5; const int wid = __builtin_amdgcn_readfirstlane(tid >> 6);
    const long rowbase = (long)b * SEQ; const int q0 = qb * 256, NT = q0 / 64 + 4;
    const int qw = q0 + 32 * wid, ntw = qw / 64 + 1;
    const unsigned lds0 = (unsigned)(uintptr_t)shm;
    LAS float* biasl = (LAS float*)(shm + L_BIAS);
    LAS float* wsf = (LAS float*)(shm + L_WS) + wid * 64;
    LAS unsigned short* stg = (LAS unsigned short*)(shm + L_ST + wid * 8192);
    for (int i = tid; i < NREL; i += 512) biasl[i] = tab[h * NREL + i];
    const float c15 = tab[h * NREL + 0];
    const LAS char* kp0 = (const LAS char*)shm + L_K + hi * 1024 + r32 * 16;
    const LAS char* vp0 = (const LAS char*)shm + L_V + ((lane >> 4) & 1) * 32 + (lane & 3) * 8 + (4 * hi + ((lane & 15) >> 2)) * 64;
    f32x16 o[4];
    for (int c = 0; c < 2; ++c) {
        const bf16* Qw = Q + (rowbase + qw) * DM + h * 128 + c * 64;
        const bf16* ksrc = K + (rowbase + lane) * DM + h * 128 + c * 64 + wid * 8;
        const int p0i = wid * 2, p1i = wid * 2 + 1;
        const bf16* vsrc0 = V + (rowbase + 16 * (p0i & 3) + (lane >> 2)) * DM + h * 128 + (p0i >> 2) * 32 + (lane & 3) * 8;
        const bf16* vsrc1 = V + (rowbase + 16 * (p1i & 3) + (lane >> 2)) * DM + h * 128 + (p1i >> 2) * 32 + (lane & 3) * 8;
#define DMA_KV(t, slot) do { glds16(ksrc + (long)(t) * 64 * DM, (unsigned)__builtin_amdgcn_readfirstlane(lds0 + L_K + (slot) * 8192 + wid * 1024)); \
        glds16(vsrc0 + (long)(t) * 64 * DM, (unsigned)__builtin_amdgcn_readfirstlane(lds0 + L_V + (slot) * 16384 + p0i * 1024)); \
        glds16(vsrc1 + (long)(t) * 64 * DM, (unsigned)__builtin_amdgcn_readfirstlane(lds0 + L_V + (slot) * 16384 + p1i * 1024)); } while (0)
        DMA_KV(0, 0);
        bf16x8 qr[4];
#pragma unroll
        for (int d0 = 0; d0 < 4; ++d0) qr[d0] = *reinterpret_cast<const bf16x8*>(&Qw[(long)r32 * DM + d0 * 16 + hi * 8]);
        float m_run = -1e30f, l_run = 0.f;
#pragma unroll
        for (int d0 = 0; d0 < 4; ++d0) o[d0] = f32x16{};
        for (int t = 0; t < NT; ++t) {
            asm volatile("s_waitcnt vmcnt(0) lgkmcnt(0)\n\ts_barrier" ::: "memory");
            const int slot = t & 1;
            if (t + 1 < NT) DMA_KV(t + 1, slot ^ 1);
            if (t < ntw) {
                const LAS char* kp = kp0 + slot * 8192; const LAS char* vp = vp0 + slot * 16384;
                f32x16 p0 = f32x16{}, p1 = f32x16{};
#pragma unroll
                for (int d0 = 0; d0 < 4; ++d0) {
                    const bf16x8 k0 = *(const LAS bf16x8*)(kp + d0 * 2048), k1 = *(const LAS bf16x8*)(kp + d0 * 2048 + 512);
                    p0 = MFMA32(k0, qr[d0], p0); p1 = MFMA32(k1, qr[d0], p1);
                }
                if (64 * t + 63 - qw <= -91) {
#pragma unroll
                    for (int r = 0; r < 16; ++r) { p0[r] += c15; p1[r] += c15; }
                } else {
                    const int ib = 64 * t - qw - r32 + 2047 + 4 * hi;
#pragma unroll
                    for (int r = 0; r < 16; ++r) { const int kk = (r & 3) + 8 * (r >> 2); p0[r] += biasl[ib + kk]; p1[r] += biasl[ib + kk + 32]; }
                }
                float rm = p0[0];
#pragma unroll
                for (int r = 0; r < 16; ++r) { rm = fmaxf(rm, p0[r]); rm = fmaxf(rm, p1[r]); }
                rm = fmaxf(rm, __shfl_xor(rm, 32));
                const float m_new = fmaxf(m_run, rm), alpha = __builtin_amdgcn_exp2f(m_run - m_new);
                m_run = m_new;
                float rs = 0.f;
#pragma unroll
                for (int r = 0; r < 16; ++r) { p0[r] = __builtin_amdgcn_exp2f(p0[r] - m_new); p1[r] = __builtin_amdgcn_exp2f(p1[r] - m_new); }
                u32x4 pw[4];
#pragma unroll
                for (int ks = 0; ks < 2; ++ks)
#pragma unroll
                    for (int j = 0; j < 4; ++j) { pw[ks][j] = cvt_pk_bf16(p0[8 * ks + 2 * j], p0[8 * ks + 2 * j + 1]); pw[2 + ks][j] = cvt_pk_bf16(p1[8 * ks + 2 * j], p1[8 * ks + 2 * j + 1]); }
#pragma unroll
                for (int ks = 0; ks < 4; ++ks)
#pragma unroll
                    for (int j = 0; j < 4; ++j) rs += bflo(pw[ks][j]) + bfhi(pw[ks][j]);
                l_run = l_run * alpha + rs;
                if (__any(alpha != 1.0f)) {
                    if (hi == 0) wsf[r32] = alpha;
                    LDS_WAIT();
#pragma unroll
                    for (int r = 0; r < 16; ++r) { const float a = wsf[crow(r, hi)];
#pragma unroll
                        for (int d0 = 0; d0 < 4; ++d0) o[d0][r] *= a; }
                }
#pragma unroll
                for (int d0 = 0; d0 < 4; ++d0)
#pragma unroll
                    for (int ks = 0; ks < 4; ++ks) {
                        const s16x4 lo = vtr(vp + d0 * 4096 + ks * 1024), hh = vtr(vp + d0 * 4096 + ks * 1024 + 512);
                        const bf16x8 vb = (bf16x8){lo[0], lo[1], lo[2], lo[3], hh[0], hh[1], hh[2], hh[3]};
                        o[d0] = MFMA32(__builtin_bit_cast(bf16x8, pw[ks]), vb, o[d0]);
                    }
            }
        }
        asm volatile("s_waitcnt lgkmcnt(0)\n\ts_barrier" ::: "memory");
        l_run += __shfl_xor(l_run, 32);
        if (hi == 0) wsf[32 + r32] = l_run;
        LDS_WAIT();
        LAS unsigned* stash = (LAS unsigned*)stg;
        if (c == 0) {
#pragma unroll
            for (int r = 0; r < 16; r += 2) { const float rl0 = __builtin_amdgcn_rcpf(wsf[32 + crow(r, hi)]), rl1 = __builtin_amdgcn_rcpf(wsf[32 + crow(r + 1, hi)]);
#pragma unroll
                for (int d0 = 0; d0 < 4; ++d0) stash[(d0 * 8 + (r >> 1)) * 64 + lane] = cvt_pk_bf16(o[d0][r] * rl0, o[d0][r + 1] * rl1); }
        } else {
#pragma unroll
            for (int r = 0; r < 16; r += 2) { const float rl0 = __builtin_amdgcn_rcpf(wsf[32 + crow(r, hi)]), rl1 = __builtin_amdgcn_rcpf(wsf[32 + crow(r + 1, hi)]);
#pragma unroll
                for (int d0 = 0; d0 < 4; ++d0) { const unsigned w = stash[(d0 * 8 + (r >> 1)) * 64 + lane]; o[d0][r] = bflo(w) - lam * (o[d0][r] * rl0); o[d0][r + 1] = bfhi(w) - lam * (o[d0][r + 1] * rl1); } }
        }
        LDS_WAIT();
#undef DMA_KV
    }
    float gs[4];
#pragma unroll
    for (int d0 = 0; d0 < 4; ++d0) gs[d0] = gsub[32 * d0 + r32] * 0.8f;
#pragma unroll
    for (int r = 0; r < 16; ++r) {
        float ss = 0.f;
#pragma unroll
        for (int d0 = 0; d0 < 4; ++d0) ss += o[d0][r] * o[d0][r];
#pragma unroll
        for (int x = 1; x < 32; x <<= 1) ss += __shfl_xor(ss, x);
        const float rstd = 1.f / sqrtf(ss * (1.f / 128.f) + EPS);
        const int orow = crow(r, hi);
#pragma unroll
        for (int d0 = 0; d0 < 4; ++d0) stg[orow * 128 + d0 * 32 + r32] = (unsigned short)f2bf(o[d0][r] * rstd * gs[d0]);
    }
    LDS_WAIT();
    bf16* Ow = O + (rowbase + qw) * DM + h * 128;
#pragma unroll
    for (int i = 0; i < 8; ++i) { const int idx = i * 64 + lane, row = idx >> 4, ch = idx & 15; const u32x4 v = *(const LAS u32x4*)(stg + row * 128 + ch * 8); *(u32x4*)(Ow + (long)row * DM + ch * 8) = v; }
    asm volatile("s_waitcnt lgkmcnt(0)\n\ts_barrier" ::: "memory");
}
}

__device__ __forceinline__ void conv_unit(Frame& F, int tok0, const bf16* C, bf16* OB) {
    const int t = fresh_tid(), ch = 2 * t, lane = t & 63, wave = __builtin_amdgcn_readfirstlane(t >> 6);
    const float* cw = INP(I_CONVW); const float* cb = INP(I_CONVB); const float* lng = INP(I_LNG); const float* lnb = INP(I_LNB);
    LAS float* tile = (LAS float*)F.lds;
    float w0[31], w1[31];
#pragma unroll
    for (int j = 0; j < 31; ++j) { const f32x2 w = *(const f32x2*)(cw + j * 1024 + ch); w0[j] = w.x; w1[j] = w.y; }
    const f32x2 bb = *(const f32x2*)(cb + ch);
    const int s_in_batch0 = tok0 & (SEQ - 1);
    for (int k = 0; k < 8; ++k) {
        const int sb = s_in_batch0 + 16 * k;
        const bf16* base = C + (size_t)(tok0 + 16 * k) * DM + ch;
        float x0[46], x1[46];
#pragma unroll
        for (int i = 0; i < 46; ++i) { const int rel = i - 30; unsigned u = 0u; if (sb + rel >= 0) u = *(const unsigned*)(base + (long)rel * DM); x0[i] = bflo(u); x1[i] = bfhi(u); }
#pragma unroll
        for (int i = 0; i < 16; ++i) { float a0 = bb.x, a1 = bb.y;
#pragma unroll
            for (int j = 0; j < 31; ++j) { a0 += w0[j] * x0[i + j]; a1 += w1[j] * x1[i + j]; }
            *(LAS f32x2*)(tile + i * 1024 + ch) = (f32x2){a0, a1}; }
        LDS_WAIT(); __syncthreads();
#pragma unroll
        for (int q = 0; q < 2; ++q) { const int i = wave * 2 + q;
            f32x4 v[4]; float s = 0.f;
#pragma unroll
            for (int j = 0; j < 4; ++j) { v[j] = *(const LAS f32x4*)(tile + i * 1024 + lane * 4 + 256 * j); s += (v[j].x + v[j].y) + (v[j].z + v[j].w); }
            const float mean = wave_sum(s) * (1.f / 1024.f); float s2 = 0.f;
#pragma unroll
            for (int j = 0; j < 4; ++j) { v[j] = v[j] - mean; s2 += (v[j].x * v[j].x + v[j].y * v[j].y) + (v[j].z * v[j].z + v[j].w * v[j].w); }
            const float rstd = 1.f / sqrtf(wave_sum(s2) * (1.f / 1024.f) + EPS);
            bf16* orow = OB + (size_t)(tok0 + 16 * k + i) * DM;
#pragma unroll
            for (int j = 0; j < 4; ++j) { const int c0 = lane * 4 + 256 * j; const f32x4 g = *(const f32x4*)(lng + c0), bt = *(const f32x4*)(lnb + c0);
                f32x4 y = v[j] * rstd * g + bt; y.x = siluf_(y.x); y.y = siluf_(y.y); y.z = siluf_(y.z); y.w = siluf_(y.w);
                u32x2 w; w.x = pk2(y.x, y.y); w.y = pk2(y.z, y.w); *(u32x2*)(orow + c0) = w; }
        }
        LDS_WAIT(); __syncthreads();
    }
}

using pg8::Unit; using pg8::Ops; using pg8::Acc;
#define TBUF(ws, i) ((bf16*)((ws) + WS_T + (size_t)(i) * UB))
#define GBUF(ws, i) ((bf16*)((ws) + WS_G + (size_t)(i) * UB))
struct SchedP1 { int G, c; unsigned char* ws; unsigned char* out;
    __device__ __forceinline__ bool next(int i, Unit& u) const { const int L = i * G + c; if (L >= 3072 + 128) return false;
        if (L < 3072) { pg8::tile_order(L, 128, 24, u.pm, u.pn); u.kind = 0; } else if (L < 3136) { const int x = L - 3072; u.pm = x & 15; u.pn = x >> 4; u.kind = 1; } else { const int x = L - 3136; u.pm = x & 3; u.pn = x >> 2; u.kind = 2; } return true; }
    __device__ __forceinline__ void ops(const Unit& u, Ops& o) const { o.lda2 = 2048; o.ldb2 = 2048;
        const char* XN = (const char*)out + OUT_XN; const char* WIN = (const char*)ws + WS_WIN; const char* MN = (const char*)ws + WS_MN; const char* WMKV = (const char*)ws + WS_WMKV;
        if (u.kind == 0) { o.A = XN + (size_t)u.pm * 256 * 2048; o.B = WIN + (size_t)u.pn * 256 * 2048; }
        else if (u.kind == 1) { o.A = MN + (size_t)u.pm * 256 * 2048; o.B = WMKV + (size_t)u.pn * 256 * 2048; }
        else { o.A = WMKV + (size_t)(1024 + u.pm * 256) * 2048; o.B = MN + (size_t)u.pn * 256 * 2048; } }
};
struct EpiP1 { unsigned char* ws;
    __device__ __forceinline__ void operator()(const Acc& acc, const Unit& u, int wr, int wc, int fr, int fq, LAS unsigned char*) const {
        const int rl = wr * 64 + fr, cl = wc * 32 + 8 * fq;
        if (u.kind == 0) {
            const int pn = u.pn; const size_t row = (size_t)u.pm * 256 + rl;
            if (pn >= 12 && pn < 20) {
                bf16* base = GBUF(ws, 2) + row * DM + (pn - 12) * 128 + cl;
#pragma unroll
                for (int ai = 0; ai < 2; ++ai)
#pragma unroll
                    for (int m = 0; m < 4; ++m) { const f32x4 a0 = acc[ai][0][m][0], a1 = acc[ai][0][m][1], g0 = acc[ai][1][m][0], g1 = acc[ai][1][m][1]; float r[8];
#pragma unroll
                        for (int e = 0; e < 4; ++e) { r[e] = a0[e] * sigmoidf_(g0[e]); r[4 + e] = a1[e] * sigmoidf_(g1[e]); }
                        u32x4 w; w.x = cvt_pk_bf16(r[0], r[1]); w.y = cvt_pk_bf16(r[2], r[3]); w.z = cvt_pk_bf16(r[4], r[5]); w.w = cvt_pk_bf16(r[6], r[7]);
                        *(u32x4*)(base + (size_t)(ai * 128 + m * 16) * DM) = w; }
            } else {
                const int grp = pn < 12 ? (pn >> 2) : 3; const float sc = (grp == 0) ? C2A : 1.f; const int cc = (pn & 3) * 256;
                const size_t boff = (grp == 0) ? WS_T : (grp == 1) ? WS_G : (grp == 2) ? (WS_G + UB) : (WS_T + 2 * UB);
                pg8::store_plain(acc, (bf16*)(ws + boff) + row * DM + cc + cl, DM, sc);
            }
        } else if (u.kind == 1) pg8::store_plain(acc, (bf16*)(ws + WS_KM) + ((size_t)u.pm * 256 + rl) * 1024 + u.pn * 256 + cl, 1024, 1.f);
        else pg8::store_plain(acc, (bf16*)(ws + WS_VT) + ((size_t)u.pm * 256 + rl) * 4096 + u.pn * 256 + cl, 4096, 1.f);
    }
};
struct SchedX { int G, v; unsigned char* ws; unsigned char* out;
    __device__ __forceinline__ bool next(int i, Unit& u) const {
        const int cnt = (512 - v + G - 1) / G;
        if (i >= 2 * cnt) return false; const int j = i % cnt; u.kind = i / cnt; u.pm = v + j * G; u.pn = j & 1; return true; }
    __device__ __forceinline__ void ops(const Unit& u, Ops& o) const { const int p = u.pm, b = p >> 5, h = (p >> 3) & 3, qb = p & 7;
        if (u.kind == 0) { o.A = (const char*)TBUF(ws, 2) + ((size_t)(b * SEQ + qb * 256) * DM + h * 256) * 2; o.lda2 = 2048; o.B = (const char*)ws + WS_KM + ((size_t)(b * 256) * 1024 + h * 256) * 2; o.ldb2 = 2048; }
        else { o.A = (const char*)out + OUT_P + (size_t)p * 131072; o.lda2 = 512; o.B = (const char*)ws + WS_VT + ((size_t)(h * 256) * 4096 + b * 256) * 2; o.ldb2 = 8192; } }
};
struct EpiX { unsigned char* ws; unsigned char* out;
    __device__ __forceinline__ void operator()(const Acc& acc, const Unit& u, int wr, int wc, int fr, int fq, LAS unsigned char* ldst) const {
        const int rl = wr * 64 + fr, cl = wc * 32 + 8 * fq; const int p = u.pm;
        LAS float* lsum = (LAS float*)(ldst + (LSUM_OFF - RING_BYTES)) + u.pn * 1024;
        if (u.kind == 0) {
            bf16* base = (bf16*)(out + OUT_P) + (size_t)p * 65536 + (size_t)rl * 256 + cl;
#pragma unroll
            for (int ai = 0; ai < 2; ++ai)
#pragma unroll
                for (int m = 0; m < 4; ++m) { float rs = 0.f;
#pragma unroll
                    for (int bj = 0; bj < 2; ++bj) { const f32x4 v0 = acc[ai][bj][m][0], v1 = acc[ai][bj][m][1]; float e[8];
#pragma unroll
                        for (int k = 0; k < 4; ++k) { e[k] = __builtin_amdgcn_exp2f(v0[k] * C2X); e[4 + k] = __builtin_amdgcn_exp2f(v1[k] * C2X); }
                        u32x4 w; w.x = cvt_pk_bf16(e[0], e[1]); w.y = cvt_pk_bf16(e[2], e[3]); w.z = cvt_pk_bf16(e[4], e[5]); w.w = cvt_pk_bf16(e[6], e[7]);
                        rs += (bflo(w.x) + bfhi(w.x)) + (bflo(w.y) + bfhi(w.y)) + (bflo(w.z) + bfhi(w.z)) + (bflo(w.w) + bfhi(w.w));
                        *(u32x4*)(base + (size_t)(ai * 128 + m * 16) * 256 + bj * 128) = w; }
                    rs += __shfl_xor(rs, 16); rs += __shfl_xor(rs, 32);
                    if (fq == 0) lsum[(ai * 128 + m * 16 + rl) * 4 + wc] = rs; }
        } else {
            const int b = p >> 5, h = (p >> 3) & 3, qb = p & 7;
            bf16* base = TBUF(ws, 2) + ((size_t)(b * SEQ + qb * 256) + rl) * DM + h * 256 + cl;
#pragma unroll
            for (int ai = 0; ai < 2; ++ai)
#pragma unroll
                for (int m = 0; m < 4; ++m) { const f32x4 l4 = *(const LAS f32x4*)(lsum + (ai * 128 + m * 16 + rl) * 4); const float rcp = __builtin_amdgcn_rcpf((l4.x + l4.y) + (l4.z + l4.w));
#pragma unroll
                    for (int bj = 0; bj < 2; ++bj) { const f32x4 v0 = acc[ai][bj][m][0] * rcp, v1 = acc[ai][bj][m][1] * rcp;
                        u32x4 w; w.x = cvt_pk_bf16(v0[0], v0[1]); w.y = cvt_pk_bf16(v0[2], v0[3]); w.z = cvt_pk_bf16(v1[0], v1[1]); w.w = cvt_pk_bf16(v1[2], v1[3]);
                        *(u32x4*)(base + (size_t)(ai * 128 + m * 16) * DM + bj * 128) = w; } }
        }
    }
};
struct SchedP3 { int G, c; unsigned char* ws; unsigned char* out;
    __device__ __forceinline__ bool next(int i, Unit& u) const { const int L = i * G + c; if (L >= 3072) return false; pg8::tile_order(L, 128, 24, u.pm, u.pn); u.kind = 0; return true; }
    __device__ __forceinline__ void ops(const Unit& u, Ops& o) const { o.lda2 = 2048; o.ldb2 = 2048; o.A = (const char*)out + OUT_XN + (size_t)u.pm * 256 * 2048; o.B = (const char*)ws + WS_WIN + (size_t)(6144 + u.pn * 256) * 2048; }
};
struct EpiP3 { unsigned char* ws; const float* bmerge;
    __device__ __forceinline__ void operator()(const Acc& acc, const Unit& u, int wr, int wc, int fr, int fq, LAS unsigned char*) const {
        const int rl = wr * 64 + fr, cl = wc * 32 + 8 * fq; const int pn = u.pn; const size_t row = (size_t)u.pm * 256 + rl;
        if (pn < 12) {
            bf16* T = TBUF(ws, pn >> 2) + row * DM + (pn & 3) * 256 + cl;
#pragma unroll
            for (int ai = 0; ai < 2; ++ai)
#pragma unroll
                for (int m = 0; m < 4; ++m) {
#pragma unroll
                    for (int bj = 0; bj < 2; ++bj) { bf16* p = T + (size_t)(ai * 128 + m * 16) * DM + bj * 128; const u32x4 o = *(const u32x4*)p; const f32x4 z0 = acc[ai][bj][m][0], z1 = acc[ai][bj][m][1];
                        u32x4 w; w.x = cvt_pk_bf16(bflo(o.x) * siluf_(z0[0]), bfhi(o.x) * siluf_(z0[1])); w.y = cvt_pk_bf16(bflo(o.y) * siluf_(z0[2]), bfhi(o.y) * siluf_(z0[3]));
                        w.z = cvt_pk_bf16(bflo(o.z) * siluf_(z1[0]), bfhi(o.z) * siluf_(z1[1])); w.w = cvt_pk_bf16(bflo(o.w) * siluf_(z1[2]), bfhi(o.w) * siluf_(z1[3]));
                        *(u32x4*)p = w; }
                    asm volatile("" ::: "memory"); }
        } else {
            const int gi = (pn - 12) >> 2, cc = ((pn - 12) & 3) * 256 + cl;
            bf16* Gp = GBUF(ws, gi) + row * DM + cc; const float* bp = bmerge + gi * 1024 + cc;
            const f32x4 b00 = *(const f32x4*)(bp), b01 = *(const f32x4*)(bp + 4), b10 = *(const f32x4*)(bp + 128), b11 = *(const f32x4*)(bp + 132);
#pragma unroll
            for (int ai = 0; ai < 2; ++ai)
#pragma unroll
                for (int m = 0; m < 4; ++m)
#pragma unroll
                    for (int bj = 0; bj < 2; ++bj) { const f32x4 v0 = acc[ai][bj][m][0] + (bj ? b10 : b00), v1 = acc[ai][bj][m][1] + (bj ? b11 : b01);
                        u32x4 w; w.x = cvt_pk_bf16(sigmoidf_(v0[0]), sigmoidf_(v0[1])); w.y = cvt_pk_bf16(sigmoidf_(v0[2]), sigmoidf_(v0[3])); w.z = cvt_pk_bf16(sigmoidf_(v1[0]), sigmoidf_(v1[1])); w.w = cvt_pk_bf16(sigmoidf_(v1[2]), sigmoidf_(v1[3]));
                        *(u32x4*)(Gp + (size_t)(ai * 128 + m * 16) * DM + bj * 128) = w; }
        }
    }
};
struct SchedP4 { int G, v; unsigned char* ws;
    __device__ __forceinline__ bool next(int i, Unit& u) const { const int tile = v + (i / 3) * G; if (tile >= 512) return false; u.pm = tile >> 2; u.pn = tile & 3; u.kind = i % 3; return true; }
    __device__ __forceinline__ void ops(const Unit& u, Ops& o) const { o.lda2 = 2048; o.ldb2 = 2048;
        o.A = (const char*)TBUF(ws, u.kind) + (size_t)u.pm * 256 * 2048; o.B = (const char*)ws + WS_WOA + (size_t)u.kind * (2 * MiB) + (size_t)u.pn * 256 * 2048; }
};
struct EpiP4 { unsigned char* ws; unsigned char* out;
    __device__ __forceinline__ void operator()(const Acc& acc, const Unit& u, int wr, int wc, int fr, int fq, LAS unsigned char*) const {
        const int rl = wr * 64 + fr, cl = wc * 32 + 8 * fq; const size_t off = ((size_t)u.pm * 256 + rl) * DM + u.pn * 256 + cl;
        const bf16* Gp = GBUF(ws, u.kind) + off;
        const bf16* Ip = (const bf16*)(out + (u.kind == 1 ? OUT_P : OUT_XN)) + off; bf16* Op = (bf16*)(out + (u.kind == 1 ? OUT_XN : OUT_P)) + off;
        const bool has_in = u.kind != 0;
#ifndef BRMASK
#define BRMASK 7
#endif
        const float bsel = ((BRMASK >> u.kind) & 1) ? 1.f : 0.f;
#pragma unroll
        for (int ai = 0; ai < 2; ++ai)
#pragma unroll
            for (int m = 0; m < 4; ++m) {
#pragma unroll
                for (int bj = 0; bj < 2; ++bj) { const size_t o2 = (size_t)(ai * 128 + m * 16) * DM + bj * 128; const u32x4 g = *(const u32x4*)(Gp + o2); u32x4 in = (u32x4){0u, 0u, 0u, 0u}; if (has_in) in = *(const u32x4*)(Ip + o2);
                    const f32x4 v0 = acc[ai][bj][m][0] * bsel, v1 = acc[ai][bj][m][1] * bsel;
                    u32x4 w; w.x = cvt_pk_bf16(bflo(in.x) + bflo(g.x) * v0[0], bfhi(in.x) + bfhi(g.x) * v0[1]); w.y = cvt_pk_bf16(bflo(in.y) + bflo(g.y) * v0[2], bfhi(in.y) + bfhi(g.y) * v0[3]);
                    w.z = cvt_pk_bf16(bflo(in.z) + bflo(g.z) * v1[0], bfhi(in.z) + bfhi(g.z) * v1[1]); w.w = cvt_pk_bf16(bflo(in.w) + bflo(g.w) * v1[2], bfhi(in.w) + bfhi(g.w) * v1[3]);
                    *(u32x4*)(Op + o2) = w; }
                asm volatile("" ::: "memory"); }
    }
};
struct SchedP5 { int G, v; unsigned char* ws; unsigned char* out;
    __device__ __forceinline__ bool next(int i, Unit& u) const { const int tile = v + i * G; if (tile >= 512) return false; u.pm = tile >> 2; u.pn = tile & 3; u.kind = 0; return true; }
    __device__ __forceinline__ void ops(const Unit& u, Ops& o) const { o.lda2 = 2048; o.ldb2 = 2048; o.A = (const char*)out + OUT_P + (size_t)u.pm * 256 * 2048; o.B = (const char*)ws + WS_WOUT + (size_t)u.pn * 256 * 2048; }
};
struct EpiP5 { unsigned char* ws;
    __device__ __forceinline__ void operator()(const Acc& acc, const Unit& u, int wr, int wc, int fr, int fq, LAS unsigned char*) const {
        const int rl = wr * 64 + fr, cl = wc * 32 + 8 * fq; const size_t row0 = (size_t)u.pm * 256 + rl;
        pg8::store_plain(acc, TBUF(ws, 0) + row0 * DM + u.pn * 256 + cl, DM, 1.f);
        float* rsq = (float*)TBUF(ws, 1);
#pragma unroll
        for (int ai = 0; ai < 2; ++ai)
#pragma unroll
            for (int m = 0; m < 4; ++m) { float ss = 0.f;
#pragma unroll
                for (int bj = 0; bj < 2; ++bj)
#pragma unroll
                    for (int n = 0; n < 2; ++n) { const f32x4 v = acc[ai][bj][m][n]; ss += (v[0] * v[0] + v[1] * v[1]) + (v[2] * v[2] + v[3] * v[3]); }
                ss += __shfl_xor(ss, 16); ss += __shfl_xor(ss, 32);
                if (fq == 0) rsq[(row0 + ai * 128 + m * 16) * 16 + u.pn * 4 + wc] = ss; }
    }
};

#ifndef PHMASK
#define PHMASK 0x77f
#endif
__global__ void __launch_bounds__(512, 2) mk_fwd(Args args) {
    extern __shared__ __attribute__((aligned(16))) unsigned char lds[];
    Frame F;
    F.lds = (LAS unsigned char*)lds;
    F.tid = threadIdx.x; F.lane = F.tid & 63; F.wave = __builtin_amdgcn_readfirstlane(F.tid >> 6);
    F.G = gridDim.x; { const int bx = blockIdx.x; F.vcu = (F.G % 8 == 0) ? (bx % 8) * (F.G / 8) + bx / 8 : bx; }
    F.out = args.out; F.ws = args.ws;
    unsigned char* ws = args.ws; unsigned char* outb = (unsigned char*)args.out;
    gu32* ctl = (gu32*)(ws + WS_CTL);
    for (int u = F.tid; u < (LDS_BYTES - LDSCTL_OFF) / 4; u += 512) ((LAS unsigned*)(F.lds + LDSCTL_OFF))[u] = 0u;
    __syncthreads();
    volatile LAS unsigned* MISC = (volatile LAS unsigned*)(F.lds + MISC_OFF);
    XcdBarrier bar; bar.bar = (unsigned*)(ctl + CW_BAR); bar.x = 0; bar.st = nullptr;
    if (MK_N_LAUNCHES == 1) bar = xcd_barrier_post((unsigned*)(ctl + CW_BAR), MISC + 8);
    const int lo = args.ph_lo, hi = args.ph_hi;
#define IN(k) (((PHMASK >> (k)) & 1) && lo <= (k) && (k) < hi)
#define SEAM(k) do { if (lo <= (k) && (k) + 1 < hi) xcd_barrier(bar); } while (0)

    if (IN(0)) { p0_prologue(F); }
    SEAM(0);
    if (IN(1)) {
        SchedP1 S{F.G, (int)blockIdx.x, ws, outb}; EpiP1 E{ws};
        pg8::gemm_phase(F.lds, 16, S, E);
    }
    SEAM(1);
    if (IN(2)) {
        if ((PHMASK >> 8) & 1) { SchedX S{F.G, F.vcu, ws, outb}; EpiX E{ws, outb}; pg8::gemm_phase(F.lds, 4, S, E); }
        if ((PHMASK >> 9) & 1) {
            const float* lq1 = INP(I_LQ1); const float* lk1 = INP(I_LK1); const float* lq2 = INP(I_LQ2); const float* lk2 = INP(I_LK2);
            const float s1 = wave_sum(lq1[F.lane] * lk1[F.lane]), s2 = wave_sum(lq2[F.lane] * lk2[F.lane]);
            const float lam = expf(s1) - expf(s2) + 0.2f;
            const float* tab = (const float*)(ws + WS_TAB); const float* gsub = INP(I_GSUB);
            for (int v = F.vcu; v < 256; v += F.G) {
                const int bh = v >> 1, s = v & 1;
                for (int i = 0; i < 4; ++i) { const int qb = (i == 0) ? s : (i == 1) ? 3 - s : (i == 2) ? 4 + s : 7 - s;
                    att::attn_unit(bh >> 3, bh & 7, qb, TBUF(ws, 0), GBUF(ws, 0), GBUF(ws, 1), TBUF(ws, 0), tab, gsub, lam, F.lds); }
            }
        }
        __syncthreads();
        if ((PHMASK >> 10) & 1) for (int v = F.vcu; v < 256; v += F.G) conv_unit(F, v * 128, GBUF(ws, 2), TBUF(ws, 1));
    }
    SEAM(2);
    if (IN(3)) {
        SchedP3 S{F.G, (int)blockIdx.x, ws, outb}; EpiP3 E{ws, INP(I_BMERGE)};
        pg8::gemm_phase(F.lds, 16, S, E);
    }
    SEAM(3);
    if (IN(4)) {
        SchedP4 S{F.G, F.vcu, ws}; EpiP4 E{ws, outb};
        pg8::gemm_phase(F.lds, 16, S, E);
    }
    SEAM(4);
    if (IN(5)) {
        SchedP5 S{F.G, F.vcu, ws, outb}; EpiP5 E{ws};
        pg8::gemm_phase(F.lds, 16, S, E);
    }
    SEAM(5);
    if (IN(6)) {
        const int t6 = fresh_tid(), lane6 = t6 & 63; const int gw = F.vcu * 8 + __builtin_amdgcn_readfirstlane(t6 >> 6), NGW = F.G * 8;
        const float* gp = INP(I_GPOST); const float* xin = INP(I_X); const float* RSQ = (const float*)TBUF(ws, 1); const bf16* Yb = TBUF(ws, 0);
        for (int m = gw; m < MTOK; m += NGW) {
            float ss = (lane6 < 16) ? RSQ[(size_t)m * 16 + lane6] : 0.f;
            ss = wave_sum(ss);
            const float rstd = 1.f / sqrtf(ss * (1.f / 1024.f) + EPS);
            const bf16* yr = Yb + (size_t)m * DM; const float* xr = xin + (size_t)m * DM; float* orow = F.out + (size_t)m * DM;
#pragma unroll
            for (int j = 0; j < 4; ++j) { const int c0 = lane6 * 4 + 256 * j; const u32x2 yw = *(const u32x2*)(yr + c0); const f32x4 xv = *(const f32x4*)(xr + c0), g = *(const f32x4*)(gp + c0);
                f32x4 o; o.x = xv.x + bflo(yw.x) * rstd * g.x; o.y = xv.y + bfhi(yw.x) * rstd * g.y; o.z = xv.z + bflo(yw.y) * rstd * g.z; o.w = xv.w + bfhi(yw.y) * rstd * g.w;
                *(f32x4*)(orow + c0) = o; }
        }
    }
#ifndef DUMP
#define DUMP 0
#endif
    if (DUMP == 13 && lo <= 8 && 8 < hi) {
        const int t8 = fresh_tid();
        for (size_t i = (size_t)blockIdx.x * 512 + t8; i < (size_t)MTOK * DM / 2; i += (size_t)gridDim.x * 512) ((unsigned*)TBUF(ws, 1))[i] = ((const unsigned*)(outb + OUT_P))[i];
    }
    if (DUMP && lo <= 7 && 7 < hi) {
        const int t7 = fresh_tid();
        for (size_t i = (size_t)blockIdx.x * 512 + t7; i < (size_t)MTOK * DM / 2; i += (size_t)gridDim.x * 512) {
            float a = 0.f, b = 0.f;
#define ADDB(ptr) do { const unsigned w = ((const unsigned*)(ptr))[i]; a += bflo(w); b += bfhi(w); } while (0)
            if (DUMP == 1) { ADDB(TBUF(ws, 0)); ADDB(TBUF(ws, 2)); ADDB(GBUF(ws, 0)); ADDB(GBUF(ws, 1)); ADDB(GBUF(ws, 2)); const unsigned w = ((const unsigned*)(ws + WS_KM))[i & (4096 * 512 - 1)]; a += bflo(w); b += bfhi(w); const unsigned w2 = ((const unsigned*)(ws + WS_VT))[i & (4096 * 512 - 1)]; a += bflo(w2); b += bfhi(w2); }
            if (DUMP == 2) { ADDB(TBUF(ws, 0)); ADDB(TBUF(ws, 1)); ADDB(TBUF(ws, 2)); }
            if (DUMP == 3) { ADDB(TBUF(ws, 0)); ADDB(TBUF(ws, 1)); ADDB(TBUF(ws, 2)); ADDB(GBUF(ws, 0)); ADDB(GBUF(ws, 1)); ADDB(GBUF(ws, 2)); }
            if (DUMP == 4) { ADDB(ws + WS_G + 2 * UB - 0); }
            if (DUMP == 5) { ADDB(TBUF(ws, 0)); }
            if (DUMP == 10) { ADDB(TBUF(ws, 0)); }
            if (DUMP == 11 || DUMP == 13) { ADDB(TBUF(ws, 1)); }
            if (DUMP == 12) { ADDB(TBUF(ws, 2)); }
            ((f32x2*)F.out)[i] = (f32x2){a, b};
        }
    }
#undef IN
#undef SEAM
}

extern "C" void kernel_launch(void* const* d_in, const int* in_sizes, int n_in, void* d_out, int out_size, void* d_ws, size_t ws_size, hipStream_t stream) {
    static int grid = 0;
    if (grid == 0) {
        if (n_in != 22 || in_sizes[0] != MTOK * DM || out_size != MTOK * DM || ws_size < WS_END) { fprintf(stderr, "kernel_launch: unexpected shapes / workspace (n_in %d, ws %zu, need %zu)\n", n_in, ws_size, (size_t)WS_END); grid = -1; return; }
        int dev = 0, cus = 0;
        if (hipGetDevice(&dev) != hipSuccess || hipDeviceGetAttribute(&cus, hipDeviceAttributeMultiprocessorCount, dev) != hipSuccess) { grid = -1; return; }
        if (hipFuncSetAttribute((const void*)mk_fwd, hipFuncAttributeMaxDynamicSharedMemorySize, LDS_BYTES) != hipSuccess) { fprintf(stderr, "kernel_launch: hipFuncSetAttribute failed\n"); grid = -1; return; }
        int per_cu = 0;
        if (hipOccupancyMaxActiveBlocksPerMultiprocessor(&per_cu, (const void*)mk_fwd, 512, LDS_BYTES) != hipSuccess || per_cu < 1) fprintf(stderr, "kernel_launch: occupancy query says %d\n", per_cu);
        (void)hipGetLastError();
        grid = cus > 256 ? 256 : cus;
    }
    if (grid < 0) return;
    (void)hipMemsetAsync((char*)d_ws + WS_CTL, 0, CTL_ZERO_BYTES, stream);
    Args a{};
    for (int i = 0; i < 22; ++i) a.in[i] = (const float*)d_in[i];
    a.out = (float*)d_out; a.ws = (unsigned char*)d_ws;
    if (MK_N_LAUNCHES == 1) { a.ph_lo = 0; a.ph_hi = N_PHASES; hipLaunchKernelGGL(mk_fwd, dim3(grid), dim3(512), LDS_BYTES, stream, a); }
    else { const int np = DUMP ? (DUMP >= 10 ? 3 : DUMP + 1) : N_PHASES;
        for (int p = 0; p < np; ++p) { a.ph_lo = p; a.ph_hi = p + 1; hipLaunchKernelGGL(mk_fwd, dim3(grid), dim3(512), LDS_BYTES, stream, a); }
        if (DUMP == 13) { a.ph_lo = 8; a.ph_hi = 9; hipLaunchKernelGGL(mk_fwd, dim3(grid), dim3(512), LDS_BYTES, stream, a); }
        if (DUMP) { a.ph_lo = 7; a.ph_hi = 8; hipLaunchKernelGGL(mk_fwd, dim3(grid), dim3(512), LDS_BYTES, stream, a); } }
}
```

```cpp
#include <hip/hip_runtime.h>
#include <cstdio>
#include <cstdint>

#define LAS __attribute__((address_space(3)))
#define GAS __attribute__((address_space(1)))
typedef unsigned short bf16;
typedef short bf16x8 __attribute__((ext_vector_type(8)));
typedef short s16x4 __attribute__((ext_vector_type(4)));
typedef float f32x4 __attribute__((ext_vector_type(4)));
typedef float f32x2 __attribute__((ext_vector_type(2)));
typedef float f32x16 __attribute__((ext_vector_type(16)));
typedef unsigned u32x4 __attribute__((ext_vector_type(4)));
typedef unsigned u32x2 __attribute__((ext_vector_type(2)));
typedef GAS unsigned gu32;

#ifndef MK_N_LAUNCHES
#define MK_N_LAUNCHES 1
#endif
constexpr int N_PHASES = 7;

constexpr int BATCH = 16, SEQ = 2048, DM = 1024, MTOK = BATCH * SEQ;
constexpr int NMEM = 256, MMEM = BATCH * NMEM;
constexpr int INW = 12288;
constexpr float EPS = 1e-6f;
constexpr float LOG2E = 1.4426950408889634f;
constexpr float C2A = 0.125f * LOG2E;
constexpr float C2X = 0.0625f * LOG2E;
constexpr int NREL = 2112;

constexpr size_t MiB = 1u << 20;
constexpr size_t WS_CTL = 0, CTL_ZERO_BYTES = 1 * MiB;
constexpr size_t WS_WIN = 2 * MiB;
constexpr size_t WS_WOA = 26 * MiB, WS_WOB = 28 * MiB, WS_WOC = 30 * MiB, WS_WOUT = 32 * MiB;
constexpr size_t WS_WMKV = 34 * MiB;
constexpr size_t WS_MN = 38 * MiB;
constexpr size_t WS_KM = 46 * MiB;
constexpr size_t WS_VT = 54 * MiB;
constexpr size_t WS_TAB = 62 * MiB;
constexpr size_t WS_U0 = 64 * MiB, UB = 64 * MiB;
constexpr size_t WS_T = WS_U0 + 0 * UB;
constexpr size_t WS_G = WS_U0 + 3 * UB;
constexpr size_t WS_END = WS_U0 + 6 * UB;
constexpr size_t OUT_XN = 0, OUT_P = 64 * MiB;

constexpr int CW_TMO = 0;
constexpr int CW_BAR = 4096;

constexpr int RING_BYTES = 131072;
constexpr int LDSCTL_OFF = RING_BYTES, MISC_OFF = LDSCTL_OFF + 320;
constexpr int LSUM_OFF = RING_BYTES + 1024;
constexpr int LDS_BYTES = 147456;

__device__ __forceinline__ int fresh_tid() { int t = threadIdx.x; asm volatile("" : "+v"(t)); return t; }
#define LDS_WAIT() asm volatile("s_waitcnt lgkmcnt(0)" ::: "memory")
#define VM_WAIT() asm volatile("s_waitcnt vmcnt(0)" ::: "memory")
#define RLX_AGENT __ATOMIC_RELAXED, __HIP_MEMORY_SCOPE_AGENT

__device__ __forceinline__ unsigned f2bf(float f) { unsigned u = __builtin_bit_cast(unsigned, f); return (u + 0x7fffu + ((u >> 16) & 1u)) >> 16; }
__device__ __forceinline__ unsigned pk2(float lo, float hi) { return f2bf(lo) | (f2bf(hi) << 16); }
typedef __bf16 bf16x2_t __attribute__((ext_vector_type(2)));
__device__ __forceinline__ unsigned cvt_pk_bf16(float lo, float hi) { f32x2 v = {lo, hi}; bf16x2_t b = __builtin_convertvector(v, bf16x2_t); return __builtin_bit_cast(unsigned, b); }
__device__ __forceinline__ float bflo(unsigned w) { return __uint_as_float(w << 16); }
__device__ __forceinline__ float bfhi(unsigned w) { return __uint_as_float(w & 0xffff0000u); }
__device__ __forceinline__ float sigmoidf_(float v) { return __builtin_amdgcn_rcpf(1.0f + __builtin_amdgcn_exp2f(-v * LOG2E)); }
__device__ __forceinline__ float siluf_(float v) { return v * sigmoidf_(v); }
__device__ __forceinline__ float wave_sum(float v) {
#pragma unroll
    for (int o = 1; o < 64; o <<= 1) v += __shfl_xor(v, o);
    return v;
}

namespace pg8 {
constexpr int BM = 256, BK = 64, HALF = 128, HTB = HALF * BK * 2, NXCD = 8, WGM = 8;
__host__ __device__ __forceinline__ int lds_byte(int r, int c) { const int st = (r >> 4) * 2 + (c >> 5), rr = r & 15, cc = c & 31, ob = rr * 64 + cc * 2; return st * 1024 + (ob ^ (((ob >> 9) & 1) << 5)); }
__host__ __device__ __forceinline__ void stage_rc(int b, int& R, int& C) { const int st = b / 1024, sb = b % 1024, swz = sb ^ (((sb >> 9) & 1) << 5); R = (st >> 1) * 16 + swz / 64; C = (st & 1) * 32 + (swz % 64) / 2; }
__host__ __device__ __forceinline__ int perm32(int rho) { const int n = rho >> 4, i = rho & 15; return 8 * (i >> 2) + 4 * n + (i & 3); }

struct Unit { int pm, pn, kind; };
struct Ops { const char* A; const char* B; unsigned lda2, ldb2; };

__device__ __forceinline__ void tile_order(int L, int nM, int nN, int& pm, int& pn) {
    const int nwg = nM * nN; int wgid = L;
    { const int q = nwg / NXCD, r = nwg % NXCD, xcd = wgid % NXCD, off = wgid / NXCD; wgid = (xcd < r ? xcd * (q + 1) : r * (q + 1) + (xcd - r) * q) + off; }
    const int nig = WGM * nN, gid = wgid / nig, fm = gid * WGM, gsz = (nM - fm) < WGM ? (nM - fm) : WGM;
    pm = fm + ((wgid % nig) % gsz); pn = (wgid % nig) / gsz;
}

template <class Epi, class Sched>
__device__ __forceinline__ void gemm_phase(LAS unsigned char* lds, const int nt, const Sched& S, const Epi& E) {
    const int tid = fresh_tid(), wid = __builtin_amdgcn_readfirstlane(tid >> 6), lane = tid & 63, wr = wid >> 2, wc = wid & 3, fr = lane & 15, fq = lane >> 4;
    int sR[2], sRb[2], sC2[2];
#pragma unroll
    for (int i = 0; i < 2; ++i) { int R, C; stage_rc(tid * 16 + i * 8192, R, C); sR[i] = R; sRb[i] = (R & ~31) + perm32(R & 31); sC2[i] = C * 2; }
    const size_t kstep = (size_t)(BK * 2);
    const unsigned ldsw = (unsigned)wid * 1024u;
    const int aoff = lds_byte(wr * 64 + fr, fq * 8), boff = lds_byte(wc * 32 + fr, fq * 8);
#define PG8_SA(b, h) (((b) * 2 + (h)) * HTB)
#define PG8_SB(b, h) ((4 + (b) * 2 + (h)) * HTB)
#define PG8_STAGE(bufoff, gbase, v0, v1) do { \
        __builtin_amdgcn_global_load_lds((const unsigned*)((const char*)(gbase) + (v0)), (LAS unsigned*)(lds + (bufoff) + ldsw), 16, 0, 0); \
        __builtin_amdgcn_global_load_lds((const unsigned*)((const char*)(gbase) + (v1)), (LAS unsigned*)(lds + (bufoff) + ldsw + 8192), 16, 0, 0); } while (0)
#define PG8_LDA(dst, b, h) do { _Pragma("unroll") for (int m = 0; m < 4; ++m) _Pragma("unroll") for (int k = 0; k < 2; ++k) dst[m][k] = *(const LAS bf16x8*)(lds + PG8_SA(b, h) + aoff + m * 2048 + k * 1024); } while (0)
#define PG8_LDB(dst, b, h) do { _Pragma("unroll") for (int n = 0; n < 2; ++n) _Pragma("unroll") for (int k = 0; k < 2; ++k) dst[n][k] = *(const LAS bf16x8*)(lds + PG8_SB(b, h) + boff + n * 2048 + k * 1024); } while (0)
#define PG8_MMA(ai, bj, At, Bt) do { __builtin_amdgcn_s_setprio(1); _Pragma("unroll") for (int m = 0; m < 4; ++m) _Pragma("unroll") for (int n = 0; n < 2; ++n) _Pragma("unroll") for (int k = 0; k < 2; ++k) \
        acc[ai][bj][m][n] = __builtin_amdgcn_mfma_f32_16x16x32_bf16(Bt[n][k], At[m][k], acc[ai][bj][m][n], 0, 0, 0); __builtin_amdgcn_s_setprio(0); } while (0)
#define PG8_WAIT_V(n) asm volatile("s_waitcnt vmcnt(" #n ")" ::: "memory")
#define PG8_WAIT_L(n) asm volatile("s_waitcnt lgkmcnt(" #n ")" ::: "memory")
#define PG8_BAR __builtin_amdgcn_s_barrier()
#define PG8_SCHED __builtin_amdgcn_sched_barrier(0)
    Unit cur, nxt; int ui = 0;
    if (!S.next(0, cur)) return;
    Ops co, no; S.ops(cur, co);
    unsigned vA0 = sR[0] * co.lda2 + sC2[0], vA1 = sR[1] * co.lda2 + sC2[1], vB0 = sRb[0] * co.ldb2 + sC2[0], vB1 = sRb[1] * co.ldb2 + sC2[1];
    size_t hA = (size_t)HALF * co.lda2, hB = (size_t)HALF * co.ldb2;
    f32x4 acc[2][2][4][2];
#pragma unroll
    for (int a = 0; a < 2; ++a)
#pragma unroll
        for (int b = 0; b < 2; ++b)
#pragma unroll
            for (int m = 0; m < 4; ++m)
#pragma unroll
                for (int n = 0; n < 2; ++n) acc[a][b][m][n] = (f32x4){0.f, 0.f, 0.f, 0.f};
    bf16x8 At[4][2], B0[2][2], B1[2][2];
    const char* cA = co.A; const char* cB = co.B;
    PG8_STAGE(PG8_SB(0, 0), cB, vB0, vB1); PG8_STAGE(PG8_SB(0, 1), cB + hB, vB0, vB1); PG8_STAGE(PG8_SA(0, 0), cA, vA0, vA1); PG8_STAGE(PG8_SA(0, 1), cA + hA, vA0, vA1);
    if (wr == 1) PG8_BAR;
    PG8_WAIT_V(2); PG8_BAR;
    PG8_STAGE(PG8_SB(1, 0), cB + kstep, vB0, vB1); PG8_STAGE(PG8_SA(1, 0), cA + kstep, vA0, vA1); PG8_STAGE(PG8_SB(1, 1), cB + hB + kstep, vB0, vB1);
    PG8_WAIT_V(6); PG8_BAR;
    for (;;) {
        const bool has_next = S.next(ui + 1, nxt);
        if (has_next) S.ops(nxt, no); else no = co;
        const char* nA = no.A; const char* nB = no.B;
        const unsigned nvA0 = sR[0] * no.lda2 + sC2[0], nvA1 = sR[1] * no.lda2 + sC2[1], nvB0 = sRb[0] * no.ldb2 + sC2[0], nvB1 = sRb[1] * no.ldb2 + sC2[1];
        const size_t nhA = (size_t)HALF * no.lda2, nhB = (size_t)HALF * no.ldb2;
        for (int t = 0; t < nt; t += 2) {
            const bool last = (t == nt - 2);
            const char* a1 = cA + (size_t)(t + 1) * kstep;
            const char* a2 = last ? nA : cA + (size_t)(t + 2) * kstep; const char* b2 = last ? nB : cB + (size_t)(t + 2) * kstep;
            const char* a3 = a2 + kstep; const char* b3 = b2 + kstep;
            const unsigned xA0 = last ? nvA0 : vA0, xA1 = last ? nvA1 : vA1, xB0 = last ? nvB0 : vB0, xB1 = last ? nvB1 : vB1;
            const size_t xhA = last ? nhA : hA, xhB = last ? nhB : hB;
            PG8_LDB(B0, 0, 0); PG8_LDB(B1, 0, 1); PG8_SCHED; PG8_LDA(At, 0, 0); PG8_STAGE(PG8_SA(1, 1), a1 + hA, vA0, vA1);
            PG8_WAIT_V(8); PG8_WAIT_L(0); PG8_BAR; PG8_MMA(0, 0, At, B0); PG8_MMA(0, 1, At, B1); PG8_BAR; PG8_SCHED;
            PG8_LDA(At, 0, 1); PG8_STAGE(PG8_SB(0, 0), b2, xB0, xB1); PG8_STAGE(PG8_SB(0, 1), b2 + xhB, xB0, xB1); PG8_STAGE(PG8_SA(0, 0), a2, xA0, xA1);
            PG8_WAIT_V(8); PG8_WAIT_L(0); PG8_BAR; PG8_MMA(1, 0, At, B0); PG8_MMA(1, 1, At, B1); PG8_BAR; PG8_SCHED;
            PG8_LDB(B0, 1, 0); PG8_LDB(B1, 1, 1); PG8_SCHED; PG8_LDA(At, 1, 0); PG8_STAGE(PG8_SA(0, 1), a2 + xhA, xA0, xA1);
            PG8_WAIT_V(8); PG8_WAIT_L(0); PG8_BAR; PG8_MMA(0, 0, At, B0); PG8_MMA(0, 1, At, B1); PG8_BAR; PG8_SCHED;
            PG8_LDA(At, 1, 1); PG8_STAGE(PG8_SB(1, 0), b3, xB0, xB1); PG8_STAGE(PG8_SB(1, 1), b3 + xhB, xB0, xB1); PG8_STAGE(PG8_SA(1, 0), a3, xA0, xA1);
            PG8_WAIT_V(8); PG8_WAIT_L(0); PG8_BAR; PG8_MMA(1, 0, At, B0); PG8_MMA(1, 1, At, B1); PG8_BAR; PG8_SCHED;
        }
        if (wr == 0) PG8_BAR;
        { int le = lane; asm volatile("" : "+v"(le));
          E(acc, cur, wr, wc, le & 15, le >> 4, lds + RING_BYTES); }
        if (!has_next) break;
#pragma unroll
        for (int a = 0; a < 2; ++a)
#pragma unroll
            for (int b = 0; b < 2; ++b)
#pragma unroll
                for (int m = 0; m < 4; ++m)
#pragma unroll
                    for (int n = 0; n < 2; ++n) acc[a][b][m][n] = (f32x4){0.f, 0.f, 0.f, 0.f};
        cur = nxt; co = no; cA = nA; cB = nB; vA0 = nvA0; vA1 = nvA1; vB0 = nvB0; vB1 = nvB1; hA = nhA; hB = nhB; ++ui;
        if (wr == 1) PG8_BAR;
    }
    PG8_WAIT_V(0);
    PG8_BAR;
#undef PG8_SA
#undef PG8_SB
#undef PG8_STAGE
#undef PG8_LDA
#undef PG8_LDB
#undef PG8_MMA
#undef PG8_WAIT_V
#undef PG8_WAIT_L
#undef PG8_BAR
#undef PG8_SCHED
}

typedef f32x4 Acc[2][2][4][2];
__device__ __forceinline__ void store_plain(const Acc& acc, bf16* base, size_t ldc, float sc) {
#pragma unroll
    for (int ai = 0; ai < 2; ++ai)
#pragma unroll
        for (int m = 0; m < 4; ++m) { bf16* rowp = base + (size_t)(ai * HALF + m * 16) * ldc;
#pragma unroll
            for (int bj = 0; bj < 2; ++bj) { const f32x4 v0 = acc[ai][bj][m][0] * sc, v1 = acc[ai][bj][m][1] * sc;
                u32x4 w; w.x = cvt_pk_bf16(v0[0], v0[1]); w.y = cvt_pk_bf16(v0[2], v0[3]); w.z = cvt_pk_bf16(v1[0], v1[1]); w.w = cvt_pk_bf16(v1[2], v1[3]);
                *(u32x4*)(rowp + bj * HALF) = w; } }
}
}

#define XB_TMO      128
#define XB_XCNT(j)  (256  + 64 * (j))
#define XB_XSUB(j)  (1280 + 64 * (j))
#define XB_XGEN(j)  (2304 + 64 * (j))
#define XB_TOP      3328
#define XB_TOPGEN   3392
#define XCD_BAR_WORDS 3456
#define XB_SPIN_CAP (1u << 18)
__device__ __forceinline__ unsigned xb_ld(unsigned* p)              { return __hip_atomic_load(p, __ATOMIC_RELAXED, __HIP_MEMORY_SCOPE_AGENT); }
__device__ __forceinline__ unsigned xb_add(unsigned* p, unsigned v) { return __hip_atomic_fetch_add(p, v, __ATOMIC_RELAXED, __HIP_MEMORY_SCOPE_AGENT); }
__device__ __forceinline__ unsigned xb_xcc_id() { return (unsigned)__builtin_amdgcn_s_getreg((3 << 11) | 20) & 0xFu; }
#define XB_SPIN(cond, bar) do { unsigned _sp = 0; while (cond) { __builtin_amdgcn_s_sleep(1); \
    if ((++_sp & 255u) == 0u) { if (xb_ld(&(bar)[XB_TMO])) break; if (_sp > XB_SPIN_CAP) { atomicAdd(&(bar)[XB_TMO], 1u); break; } } } } while (0)
struct XcdBarrier { unsigned* bar; unsigned x; volatile LAS unsigned* st; };
__device__ __forceinline__ XcdBarrier xcd_barrier_post(unsigned* bar, volatile LAS unsigned* st) {
    XcdBarrier b; b.bar = bar; b.x = xb_xcc_id(); b.st = st;
    if (threadIdx.x == 0) (void)xb_add(&bar[XB_XCNT(b.x)], 1u);
    return b;
}
__device__ __forceinline__ void xcd_barrier_complete(unsigned* bar, unsigned x, unsigned& nloc, unsigned& nx) {
    const unsigned G = gridDim.x * gridDim.y * gridDim.z;
    unsigned sum, cnt, mine, sp = 0u;
    for (;;) {
        sum = 0u; cnt = 0u; mine = 0u;
#pragma unroll
        for (unsigned j = 0; j < 16; ++j) { const unsigned c = xb_ld(&bar[XB_XCNT(j)]); sum += c; cnt += (c > 0u) ? 1u : 0u; mine = (j == x) ? c : mine; }
        if (sum == G) break;
        __builtin_amdgcn_s_sleep(1);
        if ((++sp & 255u) == 0u) { if (xb_ld(&bar[XB_TMO])) break; if (sp > XB_SPIN_CAP) { atomicAdd(&bar[XB_TMO], 1u); break; } }
    }
    nloc = mine > 0u ? mine : 1u; nx = cnt > 0u ? cnt : 1u;
}
__device__ __forceinline__ void xcd_barrier(const XcdBarrier& b) {
    asm volatile("s_waitcnt vmcnt(0)" ::: "memory");
    __syncthreads();
    if (threadIdx.x == 0) {
        unsigned* bar = b.bar;
        __builtin_amdgcn_s_waitcnt(0);
        unsigned nloc = b.st[0], nx = b.st[1];
        if (nloc == 0u) { xcd_barrier_complete(bar, b.x, nloc, nx); b.st[0] = nloc; b.st[1] = nx; }
        const unsigned old = xb_add(&bar[XB_XSUB(b.x)], 1u);
        const unsigned gen = old / nloc;
        if (old + 1u == (gen + 1u) * nloc) {
            __builtin_amdgcn_fence(__ATOMIC_RELEASE, "agent");
            asm volatile("s_waitcnt vmcnt(0)" ::: "memory");
            const unsigned og = xb_add(&bar[XB_TOP], 1u);
            const unsigned tg = og / nx;
            if (og + 1u == (tg + 1u) * nx) xb_add(&bar[XB_TOPGEN], 1u);
            else XB_SPIN(xb_ld(&bar[XB_TOPGEN]) == tg, bar);
            __builtin_amdgcn_fence(__ATOMIC_ACQUIRE, "agent");
            xb_add(&bar[XB_XGEN(b.x)], 1u);
            asm volatile("s_waitcnt vmcnt(0)" ::: "memory");
        } else {
            XB_SPIN(xb_ld(&bar[XB_XGEN(b.x)]) == gen, bar);
            __builtin_amdgcn_fence(__ATOMIC_ACQUIRE, "agent");
            asm volatile("s_waitcnt vmcnt(0)" ::: "memory");
        }
    }
    __syncthreads();
}

struct Frame {
    LAS unsigned char* lds;
    int tid, lane, wave, vcu, G;
    float* out; unsigned char* ws;
};
struct Args { const float* in[22]; float* out; unsigned char* ws; int ph_lo, ph_hi; };
typedef __attribute__((address_space(4))) const Args* KArgs;
__device__ __forceinline__ KArgs kargs() { KArgs p = (KArgs)__builtin_amdgcn_kernarg_segment_ptr(); asm volatile("" : "+s"(p)); return p; }
#define INP(i) (kargs()->in[i])
enum { I_X = 0, I_MEM, I_RELB, I_GPRE, I_GMEM, I_WIN, I_BMERGE, I_LQ1, I_LK1, I_LQ2, I_LK2, I_GSUB, I_WOA, I_CONVW, I_CONVB, I_LNG, I_LNB, I_WOB, I_WMKV, I_WOC, I_WOUT, I_GPOST };

__device__ __forceinline__ int dest_row(int c) {
    if (c < 3072) return c;
    if (c < 4096) return 6144 + (c - 3072);
    if (c < 5120) { const int j = (c - 4096) >> 7, i = (c - 4096) & 127; return 3072 + 256 * j + i; }
    if (c < 6144) { const int j = (c - 5120) >> 7, i = (c - 5120) & 127; return 3072 + 256 * j + 128 + i; }
    if (c < 7168) return 7168 + (c - 6144);
    if (c < 8192) return 5120 + (c - 7168);
    return c;
}
__device__ __forceinline__ void p0_transpose_item(const float* W, int K, int N, bf16* WT, int k0, int n0, int drow0, LAS float* scr, int lane) {
#pragma unroll 8
    for (int i = 0; i < 32; ++i) { const int kk = 2 * i + (lane >> 5); scr[kk * 33 + (lane & 31)] = W[(size_t)(k0 + kk) * N + n0 + (lane & 31)]; }
    LDS_WAIT(); asm volatile("" ::: "memory");
    const int c = lane & 7;
#pragma unroll
    for (int j = 0; j < 4; ++j) { const int n = (lane >> 3) + 8 * j; const LAS float* s = scr + (8 * c) * 33 + n;
        u32x4 o; o.x = pk2(s[0 * 33], s[1 * 33]); o.y = pk2(s[2 * 33], s[3 * 33]); o.z = pk2(s[4 * 33], s[5 * 33]); o.w = pk2(s[6 * 33], s[7 * 33]);
        *(GAS u32x4*)(WT + (size_t)(drow0 + n) * K + k0 + 8 * c) = o; }
    LDS_WAIT(); asm volatile("" ::: "memory");
}
__device__ __forceinline__ void rms_row_to_bf16(const float* xrow, const float* g, bf16* orow, int lane) {
    const GAS f32x4* xr = (const GAS f32x4*)xrow + lane; const GAS f32x4* gr = (const GAS f32x4*)g + lane;
    f32x4 v[4]; float s = 0.f;
#pragma unroll
    for (int j = 0; j < 4; ++j) { v[j] = xr[64 * j]; s += (v[j].x * v[j].x + v[j].y * v[j].y) + (v[j].z * v[j].z + v[j].w * v[j].w); }
    const float rstd = 1.f / sqrtf(wave_sum(s) * (1.f / 1024.f) + EPS);
    GAS unsigned long long* o8 = (GAS unsigned long long*)orow + lane;
#pragma unroll
    for (int j = 0; j < 4; ++j) { const f32x4 gg = gr[64 * j]; o8[64 * j] = (unsigned long long)pk2(v[j].x * rstd * gg.x, v[j].y * rstd * gg.y) | ((unsigned long long)pk2(v[j].z * rstd * gg.z, v[j].w * rstd * gg.w) << 32); }
}
__device__ __forceinline__ int t5_bucket(int rel) {
    const int n = rel < 0 ? -rel : rel; int v;
    if (n < 8) v = n; else if (n < 12) v = 8; else if (n < 16) v = 9; else if (n < 23) v = 10; else if (n < 32) v = 11; else if (n < 46) v = 12; else if (n < 64) v = 13; else if (n < 91) v = 14; else v = 15;
    return (rel > 0 ? 16 : 0) + v;
}
__device__ __forceinline__ void p0_prologue(Frame& F) {
    LAS float* scr = (LAS float*)(F.lds + F.wave * 16384);
    const int gw = F.vcu * 8 + F.wave, NGW = F.G * 8;
    bf16* WIN = (bf16*)(F.ws + WS_WIN);
    constexpr int I_IN = 16 * (INW / 32), I_SQ = 16 * 32, I_KV = 16 * 64;
    constexpr int NITEMS = I_IN + 4 * I_SQ + I_KV;
    const float* p_win = INP(I_WIN); const float* p_woa = INP(I_WOA); const float* p_wob = INP(I_WOB); const float* p_woc = INP(I_WOC); const float* p_wout = INP(I_WOUT); const float* p_wmkv = INP(I_WMKV);
    for (int it = gw; it < NITEMS; it += NGW) {
        int r = it;
        if (r < I_IN) { const int nblk = INW / 32, kb = r / nblk, nb = r % nblk; p0_transpose_item(p_win, 1024, INW, WIN, 64 * kb, 32 * nb, dest_row(32 * nb), scr, F.lane); continue; } r -= I_IN;
        if (r < 4 * I_SQ) { const int w = r / I_SQ, q = r % I_SQ, kb = q / 32, nb = q % 32;
            const float* src = w == 0 ? p_woa : w == 1 ? p_wob : w == 2 ? p_woc : p_wout;
            bf16* dst = (bf16*)(F.ws + (w == 0 ? WS_WOA : w == 1 ? WS_WOB : w == 2 ? WS_WOC : WS_WOUT));
            p0_transpose_item(src, 1024, 1024, dst, 64 * kb, 32 * nb, 32 * nb, scr, F.lane); continue; } r -= 4 * I_SQ;
        { const int kb = r / 64, nb = r % 64; p0_transpose_item(p_wmkv, 1024, 2048, (bf16*)(F.ws + WS_WMKV), 64 * kb, 32 * nb, 32 * nb, scr, F.lane); }
    }
    bf16* XN = (bf16*)((unsigned char*)F.out + OUT_XN);
    { const float* xin = INP(I_X); const float* gpre = INP(I_GPRE);
      for (int m = gw; m < MTOK; m += NGW) rms_row_to_bf16(xin + (size_t)m * DM, gpre, XN + (size_t)m * DM, F.lane); }
    bf16* MN = (bf16*)(F.ws + WS_MN);
    { const float* min_ = INP(I_MEM); const float* gmem = INP(I_GMEM);
      for (int m = gw; m < MMEM; m += NGW) rms_row_to_bf16(min_ + (size_t)m * DM, gmem, MN + (size_t)m * DM, F.lane); }
    float* tab = (float*)(F.ws + WS_TAB);
    { const float* relb = INP(I_RELB);
      for (int i = F.vcu * 512 + F.tid; i < 8 * NREL; i += F.G * 512) { const int h = i / NREL, j = i % NREL; const int rel = j - 2047; tab[i] = relb[t5_bucket(rel) * 8 + h] * LOG2E; } }
}

namespace att {
constexpr int L_K = 0, L_V = 16384, L_BIAS = 49152, L_WS = 49152 + NREL * 4, L_ST = L_WS + 2048, L_END = L_ST + 65536;
static_assert(L_END <= RING_BYTES, "attention LDS");
__device__ __forceinline__ int crow(int r, int hi) { return (r & 3) + 8 * (r >> 2) + 4 * hi; }
__device__ __forceinline__ void glds16(const void* gsrc, unsigned lds_dst) { unsigned keep;
    asm volatile("s_mov_b32 %0, m0\n\ts_mov_b32 m0, %2\n\ts_nop 0\n\tglobal_load_lds_dwordx4 %1, off\n\ts_mov_b32 m0, %0" : "=&s"(keep) : "v"(gsrc), "s"(lds_dst) : "memory"); }
typedef short v4i16_t __attribute__((ext_vector_type(4)));
__device__ __forceinline__ s16x4 vtr(const LAS char* p) { return __builtin_bit_cast(s16x4, __builtin_amdgcn_ds_read_tr16_b64_v4i16((LAS v4i16_t*)p)); }
#define MFMA32(a, b, c) __builtin_amdgcn_mfma_f32_32x32x16_bf16(a, b, c, 0, 0, 0)

__device__ __forceinline__ void attn_unit(int b, int h, int qb, const bf16* Q, const bf16* K, const bf16* V, bf16* O, const float* tab, const float* gsub, float lam, LAS unsigned char* shm) {
    const int tid = fresh_tid(), lane = tid & 63, r32 = lane & 31, hi = lane >> 5; const int wid = __builtin_amdgcn_readfirstlane(tid >> 6);
    const long rowbase = (long)b * SEQ; const int q0 = qb * 256, NT = q0 / 64 + 4;
    const int qw = q0 + 32 * wid, ntw = qw / 64 + 1;
    const unsigned lds0 = (unsigned)(uintptr_t)shm;
    LAS float* biasl = (LAS float*)(shm + L_BIAS);
    LAS float* wsf = (LAS float*)(shm + L_WS) + wid * 64;
    LAS unsigned short* stg = (LAS unsigned short*)(shm + L_ST + wid * 8192);
    for (int i = tid; i < NREL; i += 512) biasl[i] = tab[h * NREL + i];
    const float c15 = tab[h * NREL + 0];
    const LAS char* kp0 = (const LAS char*)shm + L_K + hi * 1024 + r32 * 16;
    const LAS char* vp0 = (const LAS char*)shm + L_V + ((lane >> 4) & 1) * 32 + (lane & 3) * 8 + (4 * hi + ((lane & 15) >> 2)) * 64;
    f32x16 o[4];
    for (int c = 0; c < 2; ++c) {
        const bf16* Qw = Q + (rowbase + qw) * DM + h * 128 + c * 64;
        const bf16* ksrc = K + (rowbase + lane) * DM + h * 128 + c * 64 + wid * 8;
        const int p0i = wid * 2, p1i = wid * 2 + 1;
        const bf16* vsrc0 = V + (rowbase + 16 * (p0i & 3) + (lane >> 2)) * DM + h * 128 + (p0i >> 2) * 32 + (lane & 3) * 8;
        const bf16* vsrc1 = V + (rowbase + 16 * (p1i & 3) + (lane >> 2)) * DM + h * 128 + (p1i >> 2) * 32 + (lane & 3) * 8;
#define DMA_KV(t, slot) do { glds16(ksrc + (long)(t) * 64 * DM, (unsigned)__builtin_amdgcn_readfirstlane(lds0 + L_K + (slot) * 8192 + wid * 1024)); \
        glds16(vsrc0 + (long)(t) * 64 * DM, (unsigned)__builtin_amdgcn_readfirstlane(lds0 + L_V + (slot) * 16384 + p0i * 1024)); \
        glds16(vsrc1 + (long)(t) * 64 * DM, (unsigned)__builtin_amdgcn_readfirstlane(lds0 + L_V + (slot) * 16384 + p1i * 1024)); } while (0)
        DMA_KV(0, 0);
        bf16x8 qr[4];
#pragma unroll
        for (int d0 = 0; d0 < 4; ++d0) qr[d0] = *reinterpret_cast<const bf16x8*>(&Qw[(long)r32 * DM + d0 * 16 + hi * 8]);
        float m_run = -1e30f, l_run = 0.f;
#pragma unroll
        for (int d0 = 0; d0 < 4; ++d0) o[d0] = f32x16{};
        for (int t = 0; t < NT; ++t) {
            asm volatile("s_waitcnt vmcnt(0) lgkmcnt(0)\n\ts_barrier" ::: "memory");
            const int slot = t & 1;
            if (t + 1 < NT) DMA_KV(t + 1, slot ^ 1);
            if (t < ntw) {
                const LAS char* kp = kp0 + slot * 8192; const LAS char* vp = vp0 + slot * 16384;
                f32x16 p0 = f32x16{}, p1 = f32x16{};
#pragma unroll
                for (int d0 = 0; d0 < 4; ++d0) {
                    const bf16x8 k0 = *(const LAS bf16x8*)(kp + d0 * 2048), k1 = *(const LAS bf16x8*)(kp + d0 * 2048 + 512);
                    p0 = MFMA32(k0, qr[d0], p0); p1 = MFMA32(k1, qr[d0], p1);
                }
                if (64 * t + 63 - qw <= -91) {
#pragma unroll
                    for (int r = 0; r < 16; ++r) { p0[r] += c15; p1[r] += c15; }
                } else {
                    const int ib = 64 * t - qw - r32 + 2047 + 4 * hi;
#pragma unroll
                    for (int r = 0; r < 16; ++r) { const int kk = (r & 3) + 8 * (r >> 2); p0[r] += biasl[ib + kk]; p1[r] += biasl[ib + kk + 32]; }
                }
                float rm = p0[0];
#pragma unroll
                for (int r = 0; r < 16; ++r) { rm = fmaxf(rm, p0[r]); rm = fmaxf(rm, p1[r]); }
                rm = fmaxf(rm, __shfl_xor(rm, 32));
                const float m_new = fmaxf(m_run, rm), alpha = __builtin_amdgcn_exp2f(m_run - m_new);
                m_run = m_new;
                float rs = 0.f;
#pragma unroll
                for (int r = 0; r < 16; ++r) { p0[r] = __builtin_amdgcn_exp2f(p0[r] - m_new); p1[r] = __builtin_amdgcn_exp2f(p1[r] - m_new); }
                u32x4 pw[4];
#pragma unroll
                for (int ks = 0; ks < 2; ++ks)
#pragma unroll
                    for (int j = 0; j < 4; ++j) { pw[ks][j] = cvt_pk_bf16(p0[8 * ks + 2 * j], p0[8 * ks + 2 * j + 1]); pw[2 + ks][j] = cvt_pk_bf16(p1[8 * ks + 2 * j], p1[8 * ks + 2 * j + 1]); }
#pragma unroll
                for (int ks = 0; ks < 4; ++ks)
#pragma unroll
                    for (int j = 0; j < 4; ++j) rs += bflo(pw[ks][j]) + bfhi(pw[ks][j]);
                l_run = l_run * alpha + rs;
                if (__any(alpha != 1.0f)) {
                    if (hi == 0) wsf[r32] = alpha;
                    LDS_WAIT();
#pragma unroll
                    for (int r = 0; r < 16; ++r) { const float a = wsf[crow(r, hi)];
#pragma unroll
                        for (int d0 = 0; d0 < 4; ++d0) o[d0][r] *= a; }
                }
#pragma unroll
                for (int d0 = 0; d0 < 4; ++d0)
#pragma unroll
                    for (int ks = 0; ks < 4; ++ks) {
                        const s16x4 lo = vtr(vp + d0 * 4096 + ks * 1024), hh = vtr(vp + d0 * 4096 + ks * 1024 + 512);
                        const bf16x8 vb = (bf16x8){lo[0], lo[1], lo[2], lo[3], hh[0], hh[1], hh[2], hh[3]};
                        o[d0] = MFMA32(__builtin_bit_cast(bf16x8, pw[ks]), vb, o[d0]);
                    }
            }
        }
        asm volatile("s_waitcnt lgkmcnt(0)\n\ts_barrier" ::: "memory");
        l_run += __shfl_xor(l_run, 32);
        if (hi == 0) wsf[32 + r32] = l_run;
        LDS_WAIT();
        LAS unsigned* stash = (LAS unsigned*)stg;
        if (c == 0) {
#pragma unroll
            for (int r = 0; r < 16; r += 2) { const float rl0 = __builtin_amdgcn_rcpf(wsf[32 + crow(r, hi)]), rl1 = __builtin_amdgcn_rcpf(wsf[32 + crow(r + 1, hi)]);
#pragma unroll
                for (int d0 = 0; d0 < 4; ++d0) stash[(d0 * 8 + (r >> 1)) * 64 + lane] = cvt_pk_bf16(o[d0][r] * rl0, o[d0][r + 1] * rl1); }
        } else {
#pragma unroll
            for (int r = 0; r < 16; r += 2) { const float rl0 = __builtin_amdgcn_rcpf(wsf[32 + crow(r, hi)]), rl1 = __builtin_amdgcn_rcpf(wsf[32 + crow(r + 1, hi)]);
#pragma unroll
                for (int d0 = 0; d0 < 4; ++d0) { const unsigned w = stash[(d0 * 8 + (r >> 1)) * 64 + lane]; o[d0][r] = bflo(w) - lam * (o[d0][r] * rl0); o[d0][r + 1] = bfhi(w) - lam * (o[d0][r + 1] * rl1); } }
        }
        LDS_WAIT();
#undef DMA_KV
    }
    float gs[4];
#pragma unroll
    for (int d0 = 0; d0 < 4; ++d0) gs[d0] = gsub[32 * d0 + r32] * 0.8f;
#pragma unroll
    for (int r = 0; r < 16; ++r) {
        float ss = 0.f;
#pragma unroll
        for (int d0 = 0; d0 < 4; ++d0) ss += o[d0][r] * o[d0][r];
#pragma unroll
        for (int x = 1; x < 32; x <<= 1) ss += __shfl_xor(ss, x);
        const float rstd = 1.f / sqrtf(ss * (1.f / 128.f) + EPS);
        const int orow = crow(r, hi);
#pragma unroll
        for (int d0 = 0; d0 < 4; ++d0) stg[orow * 128 + d0 * 32 + r32] = (unsigned short)f2bf(o[d0][r] * rstd * gs[d0]);
    }
    LDS_WAIT();
    bf16* Ow = O + (rowbase + qw) * DM + h * 128;
#pragma unroll
    for (int i = 0; i < 8; ++i) { const int idx = i * 64 + lane, row = idx >> 4, ch = idx & 15; const u32x4 v = *(const LAS u32x4*)(stg + row * 128 + ch * 8); *(u32x4*)(Ow + (long)row * DM + ch * 8) = v; }
    asm volatile("s_waitcnt lgkmcnt(0)\n\ts_barrier" ::: "memory");
}
}

__device__ __forceinline__ void conv_unit(Frame& F, int tok0, const bf16* C, bf16* OB) {
    const int t = fresh_tid(), ch = 2 * t, lane = t & 63, wave = __builtin_amdgcn_readfirstlane(t >> 6);
    const float* cw = INP(I_CONVW); const float* cb = INP(I_CONVB); const float* lng = INP(I_LNG); const float* lnb = INP(I_LNB);
    LAS float* tile = (LAS float*)F.lds;
    float w0[31], w1[31];
#pragma unroll
    for (int j = 0; j < 31; ++j) { const f32x2 w = *(const f32x2*)(cw + j * 1024 + ch); w0[j] = w.x; w1[j] = w.y; }
    const f32x2 bb = *(const f32x2*)(cb + ch);
    const int s_in_batch0 = tok0 & (SEQ - 1);
    for (int k = 0; k < 8; ++k) {
        const int sb = s_in_batch0 + 16 * k;
        const bf16* base = C + (size_t)(tok0 + 16 * k) * DM + ch;
        float x0[46], x1[46];
#pragma unroll
        for (int i = 0; i < 46; ++i) { const int rel = i - 30; unsigned u = 0u; if (sb + rel >= 0) u = *(const unsigned*)(base + (long)rel * DM); x0[i] = bflo(u); x1[i] = bfhi(u); }
#pragma unroll
        for (int i = 0; i < 16; ++i) { float a0 = bb.x, a1 = bb.y;
#pragma unroll
            for (int j = 0; j < 31; ++j) { a0 += w0[j] * x0[i + j]; a1 += w1[j] * x1[i + j]; }
            *(LAS f32x2*)(tile + i * 1024 + ch) = (f32x2){a0, a1}; }
        LDS_WAIT(); __syncthreads();
#pragma unroll
        for (int q = 0; q < 2; ++q) { const int i = wave * 2 + q;
            f32x4 v[4]; float s = 0.f;
#pragma unroll
            for (int j = 0; j < 4; ++j) { v[j] = *(const LAS f32x4*)(tile + i * 1024 + lane * 4 + 256 * j); s += (v[j].x + v[j].y) + (v[j].z + v[j].w); }
            const float mean = wave_sum(s) * (1.f / 1024.f); float s2 = 0.f;
#pragma unroll
            for (int j = 0; j < 4; ++j) { v[j] = v[j] - mean; s2 += (v[j].x * v[j].x + v[j].y * v[j].y) + (v[j].z * v[j].z + v[j].w * v[j].w); }
            const float rstd = 1.f / sqrtf(wave_sum(s2) * (1.f / 1024.f) + EPS);
            bf16* orow = OB + (size_t)(tok0 + 16 * k + i) * DM;
#pragma unroll
            for (int j = 0; j < 4; ++j) { const int c0 = lane * 4 + 256 * j; const f32x4 g = *(const f32x4*)(lng + c0), bt = *(const f32x4*)(lnb + c0);
                f32x4 y = v[j] * rstd * g + bt; y.x = siluf_(y.x); y.y = siluf_(y.y); y.z = siluf_(y.z); y.w = siluf_(y.w);
                u32x2 w; w.x = pk2(y.x, y.y); w.y = pk2(y.z, y.w); *(u32x2*)(orow + c0) = w; }
        }
        LDS_WAIT(); __syncthreads();
    }
}

using pg8::Unit; using pg8::Ops; using pg8::Acc;
#define TBUF(ws, i) ((bf16*)((ws) + WS_T + (size_t)(i) * UB))
#define GBUF(ws, i) ((bf16*)((ws) + WS_G + (size_t)(i) * UB))
struct SchedP1 { int G, c; unsigned char* ws; unsigned char* out;
    __device__ __forceinline__ bool next(int i, Unit& u) const { const int L = i * G + c; if (L >= 3072 + 128) return false;
        if (L < 3072) { pg8::tile_order(L, 128, 24, u.pm, u.pn); u.kind = 0; } else if (L < 3136) { const int x = L - 3072; u.pm = x & 15; u.pn = x >> 4; u.kind = 1; } else { const int x = L - 3136; u.pm = x & 3; u.pn = x >> 2; u.kind = 2; } return true; }
    __device__ __forceinline__ void ops(const Unit& u, Ops& o) const { o.lda2 = 2048; o.ldb2 = 2048;
        const char* XN = (const char*)out + OUT_XN; const char* WIN = (const char*)ws + WS_WIN; const char* MN = (const char*)ws + WS_MN; const char* WMKV = (const char*)ws + WS_WMKV;
        if (u.kind == 0) { o.A = XN + (size_t)u.pm * 256 * 2048; o.B = WIN + (size_t)u.pn * 256 * 2048; }
        else if (u.kind == 1) { o.A = MN + (size_t)u.pm * 256 * 2048; o.B = WMKV + (size_t)u.pn * 256 * 2048; }
        else { o.A = WMKV + (size_t)(1024 + u.pm * 256) * 2048; o.B = MN + (size_t)u.pn * 256 * 2048; } }
};
struct EpiP1 { unsigned char* ws;
    __device__ __forceinline__ void operator()(const Acc& acc, const Unit& u, int wr, int wc, int fr, int fq, LAS unsigned char*) const {
        const int rl = wr * 64 + fr, cl = wc * 32 + 8 * fq;
        if (u.kind == 0) {
            const int pn = u.pn; const size_t row = (size_t)u.pm * 256 + rl;
            if (pn >= 12 && pn < 20) {
                bf16* base = GBUF(ws, 2) + row * DM + (pn - 12) * 128 + cl;
#pragma unroll
                for (int ai = 0; ai < 2; ++ai)
#pragma unroll
                    for (int m = 0; m < 4; ++m) { const f32x4 a0 = acc[ai][0][m][0], a1 = acc[ai][0][m][1], g0 = acc[ai][1][m][0], g1 = acc[ai][1][m][1]; float r[8];
#pragma unroll
                        for (int e = 0; e < 4; ++e) { r[e] = a0[e] * sigmoidf_(g0[e]); r[4 + e] = a1[e] * sigmoidf_(g1[e]); }
                        u32x4 w; w.x = cvt_pk_bf16(r[0], r[1]); w.y = cvt_pk_bf16(r[2], r[3]); w.z = cvt_pk_bf16(r[4], r[5]); w.w = cvt_pk_bf16(r[6], r[7]);
                        *(u32x4*)(base + (size_t)(ai * 128 + m * 16) * DM) = w; }
            } else {
                const int grp = pn < 12 ? (pn >> 2) : 3; const float sc = (grp == 0) ? C2A : 1.f; const int cc = (pn & 3) * 256;
                const size_t boff = (grp == 0) ? WS_T : (grp == 1) ? WS_G : (grp == 2) ? (WS_G + UB) : (WS_T + 2 * UB);
                pg8::store_plain(acc, (bf16*)(ws + boff) + row * DM + cc + cl, DM, sc);
            }
        } else if (u.kind == 1) pg8::store_plain(acc, (bf16*)(ws + WS_KM) + ((size_t)u.pm * 256 + rl) * 1024 + u.pn * 256 + cl, 1024, 1.f);
        else pg8::store_plain(acc, (bf16*)(ws + WS_VT) + ((size_t)u.pm * 256 + rl) * 4096 + u.pn * 256 + cl, 4096, 1.f);
    }
};
struct SchedX { int G, v; unsigned char* ws; unsigned char* out;
    __device__ __forceinline__ bool next(int i, Unit& u) const {
        const int cnt = (512 - v + G - 1) / G;
        if (i >= 2 * cnt) return false; const int j = i % cnt; u.kind = i / cnt; u.pm = v + j * G; u.pn = j & 1; return true; }
    __device__ __forceinline__ void ops(const Unit& u, Ops& o) const { const int p = u.pm, b = p >> 5, h = (p >> 3) & 3, qb = p & 7;
        if (u.kind == 0) { o.A = (const char*)TBUF(ws, 2) + ((size_t)(b * SEQ + qb * 256) * DM + h * 256) * 2; o.lda2 = 2048; o.B = (const char*)ws + WS_KM + ((size_t)(b * 256) * 1024 + h * 256) * 2; o.ldb2 = 2048; }
        else { o.A = (const char*)out + OUT_P + (size_t)p * 131072; o.lda2 = 512; o.B = (const char*)ws + WS_VT + ((size_t)(h * 256) * 4096 + b * 256) * 2; o.ldb2 = 8192; } }
};
struct EpiX { unsigned char* ws; unsigned char* out;
    __device__ __forceinline__ void operator()(const Acc& acc, const Unit& u, int wr, int wc, int fr, int fq, LAS unsigned char* ldst) const {
        const int rl = wr * 64 + fr, cl = wc * 32 + 8 * fq; const int p = u.pm;
        LAS float* lsum = (LAS float*)(ldst + (LSUM_OFF - RING_BYTES)) + u.pn * 1024;
        if (u.kind == 0) {
            bf16* base = (bf16*)(out + OUT_P) + (size_t)p * 65536 + (size_t)rl * 256 + cl;
#pragma unroll
            for (int ai = 0; ai < 2; ++ai)
#pragma unroll
                for (int m = 0; m < 4; ++m) { float rs = 0.f;
#pragma unroll
                    for (int bj = 0; bj < 2; ++bj) { const f32x4 v0 = acc[ai][bj][m][0], v1 = acc[ai][bj][m][1]; float e[8];
#pragma unroll
                        for (int k = 0; k < 4; ++k) { e[k] = __builtin_amdgcn_exp2f(v0[k] * C2X); e[4 + k] = __builtin_amdgcn_exp2f(v1[k] * C2X); }
                        u32x4 w; w.x = cvt_pk_bf16(e[0], e[1]); w.y = cvt_pk_bf16(e[2], e[3]); w.z = cvt_pk_bf16(e[4], e[5]); w.w = cvt_pk_bf16(e[6], e[7]);
                        rs += (bflo(w.x) + bfhi(w.x)) + (bflo(w.y) + bfhi(w.y)) + (bflo(w.z) + bfhi(w.z)) + (bflo(w.w) + bfhi(w.w));
                        *(u32x4*)(base + (size_t)(ai * 128 + m * 16) * 256 + bj * 128) = w; }
                    rs += __shfl_xor(rs, 16); rs += __shfl_xor(rs, 32);
                    if (fq == 0) lsum[(ai * 128 + m * 16 + rl) * 4 + wc] = rs; }
        } else {
            const int b = p >> 5, h = (p >> 3) & 3, qb = p & 7;
            bf16* base = TBUF(ws, 2) + ((size_t)(b * SEQ + qb * 256) + rl) * DM + h * 256 + cl;
#pragma unroll
            for (int ai = 0; ai < 2; ++ai)
#pragma unroll
                for (int m = 0; m < 4; ++m) { const f32x4 l4 = *(const LAS f32x4*)(lsum + (ai * 128 + m * 16 + rl) * 4); const float rcp = __builtin_amdgcn_rcpf((l4.x + l4.y) + (l4.z + l4.w));
#pragma unroll
                    for (int bj = 0; bj < 2; ++bj) { const f32x4 v0 = acc[ai][bj][m][0] * rcp, v1 = acc[ai][bj][m][1] * rcp;
                        u32x4 w; w.x = cvt_pk_bf16(v0[0], v0[1]); w.y = cvt_pk_bf16(v0[2], v0[3]); w.z = cvt_pk_bf16(v1[0], v1[1]); w.w = cvt_pk_bf16(v1[2], v1[3]);
                        *(u32x4*)(base + (size_t)(ai * 128 + m * 16) * DM + bj * 128) = w; } }
        }
    }
};
struct SchedP3 { int G, c; unsigned char* ws; unsigned char* out;
    __device__ __forceinline__ bool next(int i, Unit& u) const { const int L = i * G + c; if (L >= 3072) return false; pg8::tile_order(L, 128, 24, u.pm, u.pn); u.kind = 0; return true; }
    __device__ __forceinline__ void ops(const Unit& u, Ops& o) const { o.lda2 = 2048; o.ldb2 = 2048; o.A = (const char*)out + OUT_XN + (size_t)u.pm * 256 * 2048; o.B = (const char*)ws + WS_WIN + (size_t)(6144 + u.pn * 256) * 2048; }
};
struct EpiP3 { unsigned char* ws; const float* bmerge;
    __device__ __forceinline__ void operator()(const Acc& acc, const Unit& u, int wr, int wc, int fr, int fq, LAS unsigned char*) const {
        const int rl = wr * 64 + fr, cl = wc * 32 + 8 * fq; const int pn = u.pn; const size_t row = (size_t)u.pm * 256 + rl;
        if (pn < 12) {
            bf16* T = TBUF(ws, pn >> 2) + row * DM + (pn & 3) * 256 + cl;
#pragma unroll
            for (int ai = 0; ai < 2; ++ai)
#pragma unroll
                for (int m = 0; m < 4; ++m) {
#pragma unroll
                    for (int bj = 0; bj < 2; ++bj) { bf16* p = T + (size_t)(ai * 128 + m * 16) * DM + bj * 128; const u32x4 o = *(const u32x4*)p; const f32x4 z0 = acc[ai][bj][m][0], z1 = acc[ai][bj][m][1];
                        u32x4 w; w.x = cvt_pk_bf16(bflo(o.x) * siluf_(z0[0]), bfhi(o.x) * siluf_(z0[1])); w.y = cvt_pk_bf16(bflo(o.y) * siluf_(z0[2]), bfhi(o.y) * siluf_(z0[3]));
                        w.z = cvt_pk_bf16(bflo(o.z) * siluf_(z1[0]), bfhi(o.z) * siluf_(z1[1])); w.w = cvt_pk_bf16(bflo(o.w) * siluf_(z1[2]), bfhi(o.w) * siluf_(z1[3]));
                        *(u32x4*)p = w; }
                    asm volatile("" ::: "memory"); }
        } else {
            const int gi = (pn - 12) >> 2, cc = ((pn - 12) & 3) * 256 + cl;
            bf16* Gp = GBUF(ws, gi) + row * DM + cc; const float* bp = bmerge + gi * 1024 + cc;
            const f32x4 b00 = *(const f32x4*)(bp), b01 = *(const f32x4*)(bp + 4), b10 = *(const f32x4*)(bp + 128), b11 = *(const f32x4*)(bp + 132);
#pragma unroll
            for (int ai = 0; ai < 2; ++ai)
#pragma unroll
                for (int m = 0; m < 4; ++m)
#pragma unroll
                    for (int bj = 0; bj < 2; ++bj) { const f32x4 v0 = acc[ai][bj][m][0] + (bj ? b10 : b00), v1 = acc[ai][bj][m][1] + (bj ? b11 : b01);
                        u32x4 w; w.x = cvt_pk_bf16(sigmoidf_(v0[0]), sigmoidf_(v0[1])); w.y = cvt_pk_bf16(sigmoidf_(v0[2]), sigmoidf_(v0[3])); w.z = cvt_pk_bf16(sigmoidf_(v1[0]), sigmoidf_(v1[1])); w.w = cvt_pk_bf16(sigmoidf_(v1[2]), sigmoidf_(v1[3]));
                        *(u32x4*)(Gp + (size_t)(ai * 128 + m * 16) * DM + bj * 128) = w; }
        }
    }
};
struct SchedP4 { int G, v; unsigned char* ws;
    __device__ __forceinline__ bool next(int i, Unit& u) const { const int tile = v + (i / 3) * G; if (tile >= 512) return false; u.pm = tile >> 2; u.pn = tile & 3; u.kind = i % 3; return true; }
    __device__ __forceinline__ void ops(const Unit& u, Ops& o) const { o.lda2 = 2048; o.ldb2 = 2048;
        o.A = (const char*)TBUF(ws, u.kind) + (size_t)u.pm * 256 * 2048; o.B = (const char*)ws + WS_WOA + (size_t)u.kind * (2 * MiB) + (size_t)u.pn * 256 * 2048; }
};
struct EpiP4 { unsigned char* ws; unsigned char* out;
    __device__ __forceinline__ void operator()(const Acc& acc, const Unit& u, int wr, int wc, int fr, int fq, LAS unsigned char*) const {
        const int rl = wr * 64 + fr, cl = wc * 32 + 8 * fq; const size_t off = ((size_t)u.pm * 256 + rl) * DM + u.pn * 256 + cl;
        const bf16* Gp = GBUF(ws, u.kind) + off;
        const bf16* Ip = (const bf16*)(out + (u.kind == 1 ? OUT_P : OUT_XN)) + off; bf16* Op = (bf16*)(out + (u.kind == 1 ? OUT_XN : OUT_P)) + off;
        const bool has_in = u.kind != 0;
#ifndef BRMASK
#define BRMASK 7
#endif
        const float bsel = ((BRMASK >> u.kind) & 1) ? 1.f : 0.f;
#pragma unroll
        for (int ai = 0; ai < 2; ++ai)
#pragma unroll
            for (int m = 0; m < 4; ++m) {
#pragma unroll
                for (int bj = 0; bj < 2; ++bj) { const size_t o2 = (size_t)(ai * 128 + m * 16) * DM + bj * 128; const u32x4 g = *(const u32x4*)(Gp + o2); u32x4 in = (u32x4){0u, 0u, 0u, 0u}; if (has_in) in = *(const u32x4*)(Ip + o2);
                    const f32x4 v0 = acc[ai][bj][m][0] * bsel, v1 = acc[ai][bj][m][1] * bsel;
                    u32x4 w; w.x = cvt_pk_bf16(bflo(in.x) + bflo(g.x) * v0[0], bfhi(in.x) + bfhi(g.x) * v0[1]); w.y = cvt_pk_bf16(bflo(in.y) + bflo(g.y) * v0[2], bfhi(in.y) + bfhi(g.y) * v0[3]);
                    w.z = cvt_pk_bf16(bflo(in.z) + bflo(g.z) * v1[0], bfhi(in.z) + bfhi(g.z) * v1[1]); w.w = cvt_pk_bf16(bflo(in.w) + bflo(g.w) * v1[2], bfhi(in.w) + bfhi(g.w) * v1[3]);
                    *(u32x4*)(Op + o2) = w; }
                asm volatile("" ::: "memory"); }
    }
};
struct SchedP5 { int G, v; unsigned char* ws; unsigned char* out;
    __device__ __forceinline__ bool next(int i, Unit& u) const { const int tile = v + i * G; if (tile >= 512) return false; u.pm = tile >> 2; u.pn = tile & 3; u.kind = 0; return true; }
    __device__ __forceinline__ void ops(const Unit& u, Ops& o) const { o.lda2 = 2048; o.ldb2 = 2048; o.A = (const char*)out + OUT_P + (size_t)u.pm * 256 * 2048; o.B = (const char*)ws + WS_WOUT + (size_t)u.pn * 256 * 2048; }
};
struct EpiP5 { unsigned char* ws;
    __device__ __forceinline__ void operator()(const Acc& acc, const Unit& u, int wr, int wc, int fr, int fq, LAS unsigned char*) const {
        const int rl = wr * 64 + fr, cl = wc * 32 + 8 * fq; const size_t row0 = (size_t)u.pm * 256 + rl;
        pg8::store_plain(acc, TBUF(ws, 0) + row0 * DM + u.pn * 256 + cl, DM, 1.f);
        float* rsq = (float*)TBUF(ws, 1);
#pragma unroll
        for (int ai = 0; ai < 2; ++ai)
#pragma unroll
            for (int m = 0; m < 4; ++m) { float ss = 0.f;
#pragma unroll
                for (int bj = 0; bj < 2; ++bj)
#pragma unroll
                    for (int n = 0; n < 2; ++n) { const f32x4 v = acc[ai][bj][m][n]; ss += (v[0] * v[0] + v[1] * v[1]) + (v[2] * v[2] + v[3] * v[3]); }
                ss += __shfl_xor(ss, 16); ss += __shfl_xor(ss, 32);
                if (fq == 0) rsq[(row0 + ai * 128 + m * 16) * 16 + u.pn * 4 + wc] = ss; }
    }
};

#ifndef PHMASK
#define PHMASK 0x77f
#endif
__global__ void __launch_bounds__(512, 2) mk_fwd(Args args) {
    extern __shared__ __attribute__((aligned(16))) unsigned char lds[];
    Frame F;
    F.lds = (LAS unsigned char*)lds;
    F.tid = threadIdx.x; F.lane = F.tid & 63; F.wave = __builtin_amdgcn_readfirstlane(F.tid >> 6);
    F.G = gridDim.x; { const int bx = blockIdx.x; F.vcu = (F.G % 8 == 0) ? (bx % 8) * (F.G / 8) + bx / 8 : bx; }
    F.out = args.out; F.ws = args.ws;
    unsigned char* ws = args.ws; unsigned char* outb = (unsigned char*)args.out;
    gu32* ctl = (gu32*)(ws + WS_CTL);
    for (int u = F.tid; u < (LDS_BYTES - LDSCTL_OFF) / 4; u += 512) ((LAS unsigned*)(F.lds + LDSCTL_OFF))[u] = 0u;
    __syncthreads();
    volatile LAS unsigned* MISC = (volatile LAS unsigned*)(F.lds + MISC_OFF);
    XcdBarrier bar; bar.bar = (unsigned*)(ctl + CW_BAR); bar.x = 0; bar.st = nullptr;
    if (MK_N_LAUNCHES == 1) bar = xcd_barrier_post((unsigned*)(ctl + CW_BAR), MISC + 8);
    const int lo = args.ph_lo, hi = args.ph_hi;
#define IN(k) (((PHMASK >> (k)) & 1) && lo <= (k) && (k) < hi)
#define SEAM(k) do { if (lo <= (k) && (k) + 1 < hi) xcd_barrier(bar); } while (0)

    if (IN(0)) { p0_prologue(F); }
    SEAM(0);
    if (IN(1)) {
        SchedP1 S{F.G, (int)blockIdx.x, ws, outb}; EpiP1 E{ws};
        pg8::gemm_phase(F.lds, 16, S, E);
    }
    SEAM(1);
    if (IN(2)) {
        if ((PHMASK >> 8) & 1) { SchedX S{F.G, F.vcu, ws, outb}; EpiX E{ws, outb}; pg8::gemm_phase(F.lds, 4, S, E); }
        if ((PHMASK >> 9) & 1) {
            const float* lq1 = INP(I_LQ1); const float* lk1 = INP(I_LK1); const float* lq2 = INP(I_LQ2); const float* lk2 = INP(I_LK2);
            const float s1 = wave_sum(lq1[F.lane] * lk1[F.lane]), s2 = wave_sum(lq2[F.lane] * lk2[F.lane]);
            const float lam = expf(s1) - expf(s2) + 0.2f;
            const float* tab = (const float*)(ws + WS_TAB); const float* gsub = INP(I_GSUB);
            for (int v = F.vcu; v < 256; v += F.G) {
                const int bh = v >> 1, s = v & 1;
                for (int i = 0; i < 4; ++i) { const int qb = (i == 0) ? s : (i == 1) ? 3 - s : (i == 2) ? 4 + s : 7 - s;
                    att::attn_unit(bh >> 3, bh & 7, qb, TBUF(ws, 0), GBUF(ws, 0), GBUF(ws, 1), TBUF(ws, 0), tab, gsub, lam, F.lds); }
            }
        }
        __syncthreads();
        if ((PHMASK >> 10) & 1) for (int v = F.vcu; v < 256; v += F.G) conv_unit(F, v * 128, GBUF(ws, 2), TBUF(ws, 1));
    }
    SEAM(2);
    if (IN(3)) {
        SchedP3 S{F.G, (int)blockIdx.x, ws, outb}; EpiP3 E{ws, INP(I_BMERGE)};
        pg8::gemm_phase(F.lds, 16, S, E);
    }
    SEAM(3);
    if (IN(4)) {
        SchedP4 S{F.G, F.vcu, ws}; EpiP4 E{ws, outb};
        pg8::gemm_phase(F.lds, 16, S, E);
    }
    SEAM(4);
    if (IN(5)) {
        SchedP5 S{F.G, F.vcu, ws, outb}; EpiP5 E{ws};
        pg8::gemm_phase(F.lds, 16, S, E);
    }
    SEAM(5);
    if (IN(6)) {
        const int t6 = fresh_tid(), lane6 = t6 & 63; const int gw = F.vcu * 8 + __builtin_amdgcn_readfirstlane(t6 >> 6), NGW = F.G * 8;
        const float* gp = INP(I_GPOST); const float* xin = INP(I_X); const float* RSQ = (const float*)TBUF(ws, 1); const bf16* Yb = TBUF(ws, 0);
        for (int m = gw; m < MTOK; m += NGW) {
            float ss = (lane6 < 16) ? RSQ[(size_t)m * 16 + lane6] : 0.f;
            ss = wave_sum(ss);
            const float rstd = 1.f / sqrtf(ss * (1.f / 1024.f) + EPS);
            const bf16* yr = Yb + (size_t)m * DM; const float* xr = xin + (size_t)m * DM; float* orow = F.out + (size_t)m * DM;
#pragma unroll
            for (int j = 0; j < 4; ++j) { const int c0 = lane6 * 4 + 256 * j; const u32x2 yw = *(const u32x2*)(yr + c0); const f32x4 xv = *(const f32x4*)(xr + c0), g = *(const f32x4*)(gp + c0);
                f32x4 o; o.x = xv.x + bflo(yw.x) * rstd * g.x; o.y = xv.y + bfhi(yw.x) * rstd * g.y; o.z = xv.z + bflo(yw.y) * rstd * g.z; o.w = xv.w + bfhi(yw.y) * rstd * g.w;
                *(f32x4*)(orow + c0) = o; }
        }
    }
#ifndef DUMP
#define DUMP 0
#endif
    if (DUMP == 13 && lo <= 8 && 8 < hi) {
        const int t8 = fresh_tid();
        for (size_t i = (size_t)blockIdx.x * 512 + t8; i < (size_t)MTOK * DM / 2; i += (size_t)gridDim.x * 512) ((unsigned*)TBUF(ws, 1))[i] = ((const unsigned*)(outb + OUT_P))[i];
    }
    if (DUMP && lo <= 7 && 7 < hi) {
        const int t7 = fresh_tid();
        for (size_t i = (size_t)blockIdx.x * 512 + t7; i < (size_t)MTOK * DM / 2; i += (size_t)gridDim.x * 512) {
            float a = 0.f, b = 0.f;
#define ADDB(ptr) do { const unsigned w = ((const unsigned*)(ptr))[i]; a += bflo(w); b += bfhi(w); } while (0)
            if (DUMP == 1) { ADDB(TBUF(ws, 0)); ADDB(TBUF(ws, 2)); ADDB(GBUF(ws, 0)); ADDB(GBUF(ws, 1)); ADDB(GBUF(ws, 2)); const unsigned w = ((const unsigned*)(ws + WS_KM))[i & (4096 * 512 - 1)]; a += bflo(w); b += bfhi(w); const unsigned w2 = ((const unsigned*)(ws + WS_VT))[i & (4096 * 512 - 1)]; a += bflo(w2); b += bfhi(w2); }
            if (DUMP == 2) { ADDB(TBUF(ws, 0)); ADDB(TBUF(ws, 1)); ADDB(TBUF(ws, 2)); }
            if (DUMP == 3) { ADDB(TBUF(ws, 0)); ADDB(TBUF(ws, 1)); ADDB(TBUF(ws, 2)); ADDB(GBUF(ws, 0)); ADDB(GBUF(ws, 1)); ADDB(GBUF(ws, 2)); }
            if (DUMP == 4) { ADDB(ws + WS_G + 2 * UB - 0); }
            if (DUMP == 5) { ADDB(TBUF(ws, 0)); }
            if (DUMP == 10) { ADDB(TBUF(ws, 0)); }
            if (DUMP == 11 || DUMP == 13) { ADDB(TBUF(ws, 1)); }
            if (DUMP == 12) { ADDB(TBUF(ws, 2)); }
            ((f32x2*)F.out)[i] = (f32x2){a, b};
        }
    }
#undef IN
#undef SEAM
}

extern "C" void kernel_launch(void* const* d_in, const int* in_sizes, int n_in, void* d_out, int out_size, void* d_ws, size_t ws_size, hipStream_t stream) {
    static int grid = 0;
    if (grid == 0) {
        if (n_in != 22 || in_sizes[0] != MTOK * DM || out_size != MTOK * DM || ws_size < WS_END) { fprintf(stderr, "kernel_launch: unexpected shapes / workspace (n_in %d, ws %zu, need %zu)\n", n_in, ws_size, (size_t)WS_END); grid = -1; return; }
        int dev = 0, cus = 0;
        if (hipGetDevice(&dev) != hipSuccess || hipDeviceGetAttribute(&cus, hipDeviceAttributeMultiprocessorCount, dev) != hipSuccess) { grid = -1; return; }
        if (hipFuncSetAttribute((const void*)mk_fwd, hipFuncAttributeMaxDynamicSharedMemorySize, LDS_BYTES) != hipSuccess) { fprintf(stderr, "kernel_launch: hipFuncSetAttribute failed\n"); grid = -1; return; }
        int per_cu = 0;
        if (hipOccupancyMaxActiveBlocksPerMultiprocessor(&per_cu, (const void*)mk_fwd, 512, LDS_BYTES) != hipSuccess || per_cu < 1) fprintf(stderr, "kernel_launch: occupancy query says %d\n", per_cu);
        (void)hipGetLastError();
        grid = cus > 256 ? 256 : cus;
    }
    if (grid < 0) return;
    (void)hipMemsetAsync((char*)d_ws + WS_CTL, 0, CTL_ZERO_BYTES, stream);
    Args a{};
    for (int i = 0; i < 22; ++i) a.in[i] = (const float*)d_in[i];
    a.out = (float*)d_out; a.ws = (unsigned char*)d_ws;
    if (MK_N_LAUNCHES == 1) { a.ph_lo = 0; a.ph_hi = N_PHASES; hipLaunchKernelGGL(mk_fwd, dim3(grid), dim3(512), LDS_BYTES, stream, a); }
    else { const int np = DUMP ? (DUMP >= 10 ? 3 : DUMP + 1) : N_PHASES;
        for (int p = 0; p < np; ++p) { a.ph_lo = p; a.ph_hi = p + 1; hipLaunchKernelGGL(mk_fwd, dim3(grid), dim3(512), LDS_BYTES, stream, a); }
        if (DUMP == 13) { a.ph_lo = 8; a.ph_hi = 9; hipLaunchKernelGGL(mk_fwd, dim3(grid), dim3(512), LDS_BYTES, stream, a); }
        if (DUMP) { a.ph_lo = 7; a.ph_hi = 8; hipLaunchKernelGGL(mk_fwd, dim3(grid), dim3(512), LDS_BYTES, stream, a); } }
}
```

```cpp
#include <hip/hip_runtime.h>
#ifndef BADTEST
#define BADTEST 0
#endif
#include <cstdio>
#include <cstdint>

#define LAS __attribute__((address_space(3)))
#define GAS __attribute__((address_space(1)))
typedef unsigned short bf16;
typedef short bf16x8 __attribute__((ext_vector_type(8)));
typedef short s16x4 __attribute__((ext_vector_type(4)));
typedef float f32x4 __attribute__((ext_vector_type(4)));
typedef float f32x2 __attribute__((ext_vector_type(2)));
typedef float f32x16 __attribute__((ext_vector_type(16)));
typedef unsigned u32x4 __attribute__((ext_vector_type(4)));
typedef unsigned u32x2 __attribute__((ext_vector_type(2)));
typedef GAS unsigned gu32;

#ifndef MK_N_LAUNCHES
#define MK_N_LAUNCHES 1
#endif
constexpr int N_PHASES = 7;

constexpr int BATCH = 16, SEQ = 2048, DM = 1024, MTOK = BATCH * SEQ;
constexpr int NMEM = 256, MMEM = BATCH * NMEM;
constexpr int INW = 12288;
constexpr float EPS = 1e-6f;
constexpr float LOG2E = 1.4426950408889634f;
constexpr float C2A = 0.125f * LOG2E;
constexpr float C2X = 0.0625f * LOG2E;
constexpr int NREL = 2112;

constexpr size_t MiB = 1u << 20;
constexpr size_t WS_CTL = 0, CTL_ZERO_BYTES = 1 * MiB;
constexpr size_t WS_WIN = 2 * MiB;
constexpr size_t WS_WOA = 26 * MiB, WS_WOB = 28 * MiB, WS_WOC = 30 * MiB, WS_WOUT = 32 * MiB;
constexpr size_t WS_WMKV = 34 * MiB;
constexpr size_t WS_MN = 38 * MiB;
constexpr size_t WS_KM = 46 * MiB;
constexpr size_t WS_VT = 54 * MiB;
constexpr size_t WS_U0 = 64 * MiB, UB = 64 * MiB;
constexpr size_t WS_T = WS_U0 + 0 * UB;
constexpr size_t WS_G = WS_U0 + 3 * UB;
constexpr size_t WS_END = WS_U0 + 6 * UB;
constexpr size_t OUT_XN = 0, OUT_P = 64 * MiB;

constexpr int CW_TMO = 0;
constexpr int CW_BAR = 4096;

constexpr int RING_BYTES = 131072;
constexpr int LDS_BYTES = 163840;
constexpr int LDSCTL_OFF = LDS_BYTES - 512, MISC_OFF = LDSCTL_OFF + 320;
constexpr int LSUM_OFF = LDSCTL_OFF - 8192;
constexpr int PHASE_LDS = LSUM_OFF;

__device__ __forceinline__ int fresh_tid() { int t = threadIdx.x; asm volatile("" : "+v"(t)); return t; }
#define LDS_WAIT() asm volatile("s_waitcnt lgkmcnt(0)" ::: "memory")
#define VM_WAIT() asm volatile("s_waitcnt vmcnt(0)" ::: "memory")
#define RLX_AGENT __ATOMIC_RELAXED, __HIP_MEMORY_SCOPE_AGENT

__device__ __forceinline__ unsigned f2bf(float f) { unsigned u = __builtin_bit_cast(unsigned, f); return (u + 0x7fffu + ((u >> 16) & 1u)) >> 16; }
__device__ __forceinline__ unsigned pk2(float lo, float hi) { return f2bf(lo) | (f2bf(hi) << 16); }
typedef __bf16 bf16x2_t __attribute__((ext_vector_type(2)));
__device__ __forceinline__ unsigned cvt_pk_bf16(float lo, float hi) { f32x2 v = {lo, hi}; bf16x2_t b = __builtin_convertvector(v, bf16x2_t); return __builtin_bit_cast(unsigned, b); }
__device__ __forceinline__ float bflo(unsigned w) { return __uint_as_float(w << 16); }
__device__ __forceinline__ float bfhi(unsigned w) { return __uint_as_float(w & 0xffff0000u); }
__device__ __forceinline__ float sigmoidf_(float v) { return __builtin_amdgcn_rcpf(1.0f + __builtin_amdgcn_exp2f(-v * LOG2E)); }
__device__ __forceinline__ float siluf_(float v) { return v * sigmoidf_(v); }
__device__ __forceinline__ float wave_sum(float v) {
#define DPP_(ctrl) v += __builtin_bit_cast(float, __builtin_amdgcn_update_dpp(0, __builtin_bit_cast(int, v), ctrl, 0xf, 0xf, true))
    DPP_(0xB1); DPP_(0x4E); DPP_(0x141); DPP_(0x140);
#undef DPP_
    const int b = __builtin_bit_cast(int, v);
    return (__builtin_bit_cast(float, __builtin_amdgcn_readlane(b, 0)) + __builtin_bit_cast(float, __builtin_amdgcn_readlane(b, 16))) + (__builtin_bit_cast(float, __builtin_amdgcn_readlane(b, 32)) + __builtin_bit_cast(float, __builtin_amdgcn_readlane(b, 48)));
}

__device__ __forceinline__ int t5_bucket(int rel) {
    const int n = rel < 0 ? -rel : rel; int v;
    if (n < 8) v = n; else if (n < 12) v = 8; else if (n < 16) v = 9; else if (n < 23) v = 10; else if (n < 32) v = 11; else if (n < 46) v = 12; else if (n < 64) v = 13; else if (n < 91) v = 14; else v = 15;
    return (rel > 0 ? 16 : 0) + v;
}

#ifndef TIMEDUP
#define TIMEDUP -1
#endif
namespace pg8 {
constexpr int BM = 256, BK = 64, HALF = 128, HTB = HALF * BK * 2, NXCD = 8, WGM = 2;
__host__ __device__ __forceinline__ int lds_byte(int r, int c) { const int st = (r >> 4) * 2 + (c >> 5), rr = r & 15, cc = c & 31, ob = rr * 64 + cc * 2; return st * 1024 + (ob ^ (((ob >> 9) & 1) << 5)); }
__host__ __device__ __forceinline__ void stage_rc(int b, int& R, int& C) { const int st = b / 1024, sb = b % 1024, swz = sb ^ (((sb >> 9) & 1) << 5); R = (st >> 1) * 16 + swz / 64; C = (st & 1) * 32 + (swz % 64) / 2; }
__host__ __device__ __forceinline__ int perm32(int rho) { const int n = rho >> 4, i = rho & 15; return 8 * (i >> 2) + 4 * n + (i & 3); }

struct Unit { int pm, pn, kind; };
struct Ops { const char* A; const char* B; unsigned lda2, ldb2; };

__device__ __forceinline__ void tile_order(int L, int nM, int nN, int& pm, int& pn) {
    const int nwg = nM * nN; int wgid = L;
    { const int q = nwg / NXCD, r = nwg % NXCD, xcd = wgid % NXCD, off = wgid / NXCD; wgid = (xcd < r ? xcd * (q + 1) : r * (q + 1) + (xcd - r) * q) + off; }
    const int nig = WGM * nN, gid = wgid / nig, fm = gid * WGM, gsz = (nM - fm) < WGM ? (nM - fm) : WGM;
    pm = fm + ((wgid % nig) % gsz); pn = (wgid % nig) / gsz;
}

template <class Epi, class Sched>
__device__ __forceinline__ void gemm_phase(LAS unsigned char* lds, const int nt, const Sched& S, const Epi& E) {
    const int tid = fresh_tid(), wid = __builtin_amdgcn_readfirstlane(tid >> 6), lane = tid & 63, wr = wid >> 2, wc = wid & 3, fr = lane & 15, fq = lane >> 4;
    int sR[2], sRb[2], sC2[2];
#pragma unroll
    for (int i = 0; i < 2; ++i) { int R, C; stage_rc(tid * 16 + i * 8192, R, C); sR[i] = R; sRb[i] = (R & ~31) + perm32(R & 31); sC2[i] = C * 2; }
    const size_t kstep = (size_t)(BK * 2);
    const unsigned ldsw = (unsigned)wid * 1024u;
    const int aoff = lds_byte(wr * 64 + fr, fq * 8), boff = lds_byte(wc * 32 + fr, fq * 8);
#define PG8_SA(b, h) (((b) * 2 + (h)) * HTB)
#define PG8_SB(b, h) ((4 + (b) * 2 + (h)) * HTB)
#define PG8_STAGE(bufoff, gbase, v0, v1) do { \
        __builtin_amdgcn_global_load_lds((const unsigned*)((const char*)(gbase) + (v0)), (LAS unsigned*)(lds + (bufoff) + ldsw), 16, 0, 0); \
        __builtin_amdgcn_global_load_lds((const unsigned*)((const char*)(gbase) + (v1)), (LAS unsigned*)(lds + (bufoff) + ldsw + 8192), 16, 0, 0); } while (0)
#define PG8_LDA(dst, b, h) do { _Pragma("unroll") for (int m = 0; m < 4; ++m) _Pragma("unroll") for (int k = 0; k < 2; ++k) dst[m][k] = *(const LAS bf16x8*)(lds + PG8_SA(b, h) + aoff + m * 2048 + k * 1024); } while (0)
#define PG8_LDB(dst, b, h) do { _Pragma("unroll") for (int n = 0; n < 2; ++n) _Pragma("unroll") for (int k = 0; k < 2; ++k) dst[n][k] = *(const LAS bf16x8*)(lds + PG8_SB(b, h) + boff + n * 2048 + k * 1024); } while (0)
#define PG8_MMA(ai, bj, At, Bt) do { __builtin_amdgcn_s_setprio(1); _Pragma("unroll") for (int m = 0; m < 4; ++m) _Pragma("unroll") for (int n = 0; n < 2; ++n) _Pragma("unroll") for (int k = 0; k < 2; ++k) \
        acc[ai][bj][m][n] = __builtin_amdgcn_mfma_f32_16x16x32_bf16(Bt[n][k], At[m][k], acc[ai][bj][m][n], 0, 0, 0); __builtin_amdgcn_s_setprio(0); } while (0)
#define PG8_WAIT_V(n) asm volatile("s_waitcnt vmcnt(" #n ")" ::: "memory")
#define PG8_WAIT_L(n) asm volatile("s_waitcnt lgkmcnt(" #n ")" ::: "memory")
#define PG8_BAR __builtin_amdgcn_s_barrier()
#define PG8_SCHED __builtin_amdgcn_sched_barrier(0)
    Unit cur, nxt; int ui = 0;
    if (!S.next(0, cur)) return;
    Ops co, no; S.ops(cur, co);
    unsigned vA0 = sR[0] * co.lda2 + sC2[0], vA1 = sR[1] * co.lda2 + sC2[1], vB0 = sRb[0] * co.ldb2 + sC2[0], vB1 = sRb[1] * co.ldb2 + sC2[1];
    size_t hA = (size_t)HALF * co.lda2, hB = (size_t)HALF * co.ldb2;
    f32x4 acc[2][2][4][2];
#pragma unroll
    for (int a = 0; a < 2; ++a)
#pragma unroll
        for (int b = 0; b < 2; ++b)
#pragma unroll
            for (int m = 0; m < 4; ++m)
#pragma unroll
                for (int n = 0; n < 2; ++n) acc[a][b][m][n] = (f32x4){0.f, 0.f, 0.f, 0.f};
    bf16x8 At[4][2], B0[2][2], B1[2][2];
    const char* cA = co.A; const char* cB = co.B;
    PG8_STAGE(PG8_SB(0, 0), cB, vB0, vB1); PG8_STAGE(PG8_SB(0, 1), cB + hB, vB0, vB1); PG8_STAGE(PG8_SA(0, 0), cA, vA0, vA1); PG8_STAGE(PG8_SA(0, 1), cA + hA, vA0, vA1);
    if (wr == 1) PG8_BAR;
    PG8_WAIT_V(2); PG8_BAR;
    PG8_STAGE(PG8_SB(1, 0), cB + kstep, vB0, vB1); PG8_STAGE(PG8_SA(1, 0), cA + kstep, vA0, vA1); PG8_STAGE(PG8_SB(1, 1), cB + hB + kstep, vB0, vB1);
    PG8_WAIT_V(6); PG8_BAR;
    for (;;) {
        const bool has_next = S.next(ui + 1, nxt);
        if (has_next) S.ops(nxt, no); else no = co;
        const char* nA = no.A; const char* nB = no.B;
        const unsigned nvA0 = sR[0] * no.lda2 + sC2[0], nvA1 = sR[1] * no.lda2 + sC2[1], nvB0 = sRb[0] * no.ldb2 + sC2[0], nvB1 = sRb[1] * no.ldb2 + sC2[1];
        const size_t nhA = (size_t)HALF * no.lda2, nhB = (size_t)HALF * no.ldb2;
        for (int t = 0; t < nt; t += 2) {
            const bool last = (t == nt - 2);
            const char* a1 = cA + (size_t)(t + 1) * kstep;
            const char* a2 = last ? nA : cA + (size_t)(t + 2) * kstep; const char* b2 = last ? nB : cB + (size_t)(t + 2) * kstep;
            const char* a3 = a2 + kstep; const char* b3 = b2 + kstep;
            const unsigned xA0 = last ? nvA0 : vA0, xA1 = last ? nvA1 : vA1, xB0 = last ? nvB0 : vB0, xB1 = last ? nvB1 : vB1;
            const size_t xhA = last ? nhA : hA, xhB = last ? nhB : hB;
            PG8_LDB(B0, 0, 0); PG8_LDB(B1, 0, 1); PG8_SCHED; PG8_LDA(At, 0, 0); PG8_STAGE(PG8_SA(1, 1), a1 + hA, vA0, vA1);
            PG8_WAIT_V(8); PG8_WAIT_L(0); PG8_BAR; PG8_MMA(0, 0, At, B0); PG8_MMA(0, 1, At, B1); PG8_BAR; PG8_SCHED;
            PG8_LDA(At, 0, 1); PG8_STAGE(PG8_SB(0, 0), b2, xB0, xB1); PG8_STAGE(PG8_SB(0, 1), b2 + xhB, xB0, xB1); PG8_STAGE(PG8_SA(0, 0), a2, xA0, xA1);
            PG8_WAIT_V(8); PG8_WAIT_L(0); PG8_BAR; PG8_MMA(1, 0, At, B0); PG8_MMA(1, 1, At, B1); PG8_BAR; PG8_SCHED;
            PG8_LDB(B0, 1, 0); PG8_LDB(B1, 1, 1); PG8_SCHED; PG8_LDA(At, 1, 0); PG8_STAGE(PG8_SA(0, 1), a2 + xhA, xA0, xA1);
            PG8_WAIT_V(8); PG8_WAIT_L(0); PG8_BAR; PG8_MMA(0, 0, At, B0); PG8_MMA(0, 1, At, B1); PG8_BAR; PG8_SCHED;
            PG8_LDA(At, 1, 1); PG8_STAGE(PG8_SB(1, 0), b3, xB0, xB1); PG8_STAGE(PG8_SB(1, 1), b3 + xhB, xB0, xB1); PG8_STAGE(PG8_SA(1, 0), a3, xA0, xA1);
            PG8_WAIT_V(8); PG8_WAIT_L(0); PG8_BAR; PG8_MMA(1, 0, At, B0); PG8_MMA(1, 1, At, B1); PG8_BAR; PG8_SCHED;
        }
        if (wr == 0) PG8_BAR;
        { int le = lane; asm volatile("" : "+v"(le));
          E(acc, cur, wr, wc, le & 15, le >> 4, lds + RING_BYTES); }
        if (!has_next) break;
        if (!E.keep(cur)) {
#pragma unroll
        for (int a = 0; a < 2; ++a)
#pragma unroll
            for (int b = 0; b < 2; ++b)
#pragma unroll
                for (int m = 0; m < 4; ++m)
#pragma unroll
                    for (int n = 0; n < 2; ++n) acc[a][b][m][n] = (f32x4){0.f, 0.f, 0.f, 0.f};
        }
        cur = nxt; co = no; cA = nA; cB = nB; vA0 = nvA0; vA1 = nvA1; vB0 = nvB0; vB1 = nvB1; hA = nhA; hB = nhB; ++ui;
        if (wr == 1) PG8_BAR;
    }
    PG8_WAIT_V(0);
    PG8_BAR;
#undef PG8_SA
#undef PG8_SB
#undef PG8_STAGE
#undef PG8_LDA
#undef PG8_LDB
#undef PG8_MMA
#undef PG8_WAIT_V
#undef PG8_WAIT_L
#undef PG8_BAR
#undef PG8_SCHED
}

typedef f32x4 Acc[2][2][4][2];
__device__ __forceinline__ void store_plain(const Acc& acc, bf16* base, size_t ldc, float sc) {
#pragma unroll
    for (int ai = 0; ai < 2; ++ai)
#pragma unroll
        for (int m = 0; m < 4; ++m) { bf16* rowp = base + (size_t)(ai * HALF + m * 16) * ldc;
#pragma unroll
            for (int bj = 0; bj < 2; ++bj) { const f32x4 v0 = acc[ai][bj][m][0] * sc, v1 = acc[ai][bj][m][1] * sc;
                u32x4 w; w.x = cvt_pk_bf16(v0[0], v0[1]); w.y = cvt_pk_bf16(v0[2], v0[3]); w.z = cvt_pk_bf16(v1[0], v1[1]); w.w = cvt_pk_bf16(v1[2], v1[3]);
                *(u32x4*)(rowp + bj * HALF) = w; } }
}
}

#define XB_TMO      128
#define XB_XCNT(j)  (256  + 64 * (j))
#define XB_XSUB(j)  (1280 + 64 * (j))
#define XB_XGEN(j)  (2304 + 64 * (j))
#define XB_TOP      3328
#define XB_TOPGEN   3392
#define XCD_BAR_WORDS 3456
#define XB_SPIN_CAP (1u << 18)
__device__ __forceinline__ unsigned xb_ld(unsigned* p)              { return __hip_atomic_load(p, __ATOMIC_RELAXED, __HIP_MEMORY_SCOPE_AGENT); }
__device__ __forceinline__ unsigned xb_add(unsigned* p, unsigned v) { return __hip_atomic_fetch_add(p, v, __ATOMIC_RELAXED, __HIP_MEMORY_SCOPE_AGENT); }
__device__ __forceinline__ unsigned xb_xcc_id() { return (unsigned)__builtin_amdgcn_s_getreg((3 << 11) | 20) & 0xFu; }
#define XB_SPIN(cond, bar) do { unsigned _sp = 0; while (cond) { __builtin_amdgcn_s_sleep(1); \
    if ((++_sp & 255u) == 0u) { if (xb_ld(&(bar)[XB_TMO])) break; if (_sp > XB_SPIN_CAP) { atomicAdd(&(bar)[XB_TMO], 1u); break; } } } } while (0)
struct XcdBarrier { unsigned* bar; unsigned x; volatile LAS unsigned* st; };
__device__ __forceinline__ XcdBarrier xcd_barrier_post(unsigned* bar, volatile LAS unsigned* st) {
    XcdBarrier b; b.bar = bar; b.x = xb_xcc_id(); b.st = st;
    if (threadIdx.x == 0) (void)xb_add(&bar[XB_XCNT(b.x)], 1u);
    return b;
}
__device__ __forceinline__ void xcd_barrier_complete(unsigned* bar, unsigned x, unsigned& nloc, unsigned& nx) {
    const unsigned G = gridDim.x * gridDim.y * gridDim.z;
    unsigned sum, cnt, mine, sp = 0u;
    for (;;) {
        sum = 0u; cnt = 0u; mine = 0u;
#pragma unroll
        for (unsigned j = 0; j < 16; ++j) { const unsigned c = xb_ld(&bar[XB_XCNT(j)]); sum += c; cnt += (c > 0u) ? 1u : 0u; mine = (j == x) ? c : mine; }
        if (sum == G) break;
        __builtin_amdgcn_s_sleep(1);
        if ((++sp & 255u) == 0u) { if (xb_ld(&bar[XB_TMO])) break; if (sp > XB_SPIN_CAP) { atomicAdd(&bar[XB_TMO], 1u); break; } }
    }
    nloc = mine > 0u ? mine : 1u; nx = cnt > 0u ? cnt : 1u;
}
__device__ __forceinline__ void xcd_barrier(const XcdBarrier& b) {
    asm volatile("s_waitcnt vmcnt(0)" ::: "memory");
    __syncthreads();
    if (threadIdx.x == 0) {
        unsigned* bar = b.bar;
        __builtin_amdgcn_s_waitcnt(0);
        unsigned nloc = b.st[0], nx = b.st[1];
        if (nloc == 0u) { xcd_barrier_complete(bar, b.x, nloc, nx); b.st[0] = nloc; b.st[1] = nx; }
        const unsigned old = xb_add(&bar[XB_XSUB(b.x)], 1u);
        const unsigned gen = old / nloc;
        if (old + 1u == (gen + 1u) * nloc) {
            __builtin_amdgcn_fence(__ATOMIC_RELEASE, "agent");
            asm volatile("s_waitcnt vmcnt(0)" ::: "memory");
            const unsigned og = xb_add(&bar[XB_TOP], 1u);
            const unsigned tg = og / nx;
            if (og + 1u == (tg + 1u) * nx) xb_add(&bar[XB_TOPGEN], 1u);
            else XB_SPIN(xb_ld(&bar[XB_TOPGEN]) == tg, bar);
            __builtin_amdgcn_fence(__ATOMIC_ACQUIRE, "agent");
            xb_add(&bar[XB_XGEN(b.x)], 1u);
            asm volatile("s_waitcnt vmcnt(0)" ::: "memory");
        } else {
            XB_SPIN(xb_ld(&bar[XB_XGEN(b.x)]) == gen, bar);
            __builtin_amdgcn_fence(__ATOMIC_ACQUIRE, "agent");
            asm volatile("s_waitcnt vmcnt(0)" ::: "memory");
        }
    }
    __syncthreads();
}

struct Frame {
    LAS unsigned char* lds;
    int tid, lane, wave, vcu, G;
    float* out; unsigned char* ws;
};
struct Args { const float* in[22]; float* out; unsigned char* ws; int ph_lo, ph_hi; };
typedef __attribute__((address_space(4))) const Args* KArgs;
__device__ __forceinline__ KArgs kargs() { KArgs p = (KArgs)__builtin_amdgcn_kernarg_segment_ptr(); asm volatile("" : "+s"(p)); return p; }
#define INP(i) (kargs()->in[i])
enum { I_X = 0, I_MEM, I_RELB, I_GPRE, I_GMEM, I_WIN, I_BMERGE, I_LQ1, I_LK1, I_LQ2, I_LK2, I_GSUB, I_WOA, I_CONVW, I_CONVB, I_LNG, I_LNB, I_WOB, I_WMKV, I_WOC, I_WOUT, I_GPOST };

__device__ __forceinline__ int dest_row(int c) {
    if (c < 3072) return c;
    if (c < 4096) return 6144 + (c - 3072);
    if (c < 5120) { const int j = (c - 4096) >> 7, i = (c - 4096) & 127; return 3072 + 256 * j + i; }
    if (c < 6144) { const int j = (c - 5120) >> 7, i = (c - 5120) & 127; return 3072 + 256 * j + 128 + i; }
    if (c < 7168) return 7168 + (c - 6144);
    if (c < 8192) return 5120 + (c - 7168);
    return c;
}
__device__ __forceinline__ void p0_transpose_item(const float* W, int K, int N, bf16* WT, int k0, int n0, int drow0, LAS float* scr, int lane) {
    { const int r = lane >> 3, c4 = (lane & 7) * 4; f32x4 v[8];
#pragma unroll
      for (int p = 0; p < 8; ++p) v[p] = *(const GAS f32x4*)(W + (size_t)(k0 + 8 * p + r) * N + n0 + c4);
#pragma unroll
      for (int p = 0; p < 8; ++p) { LAS float* d = scr + (8 * p + r) * 33 + c4; d[0] = v[p].x; d[1] = v[p].y; d[2] = v[p].z; d[3] = v[p].w; } }
    LDS_WAIT(); asm volatile("" ::: "memory");
    const int c = lane & 7;
#pragma unroll
    for (int j = 0; j < 4; ++j) { const int n = (lane >> 3) + 8 * j; const LAS float* s = scr + (8 * c) * 33 + n;
        u32x4 o; o.x = pk2(s[0 * 33], s[1 * 33]); o.y = pk2(s[2 * 33], s[3 * 33]); o.z = pk2(s[4 * 33], s[5 * 33]); o.w = pk2(s[6 * 33], s[7 * 33]);
        *(GAS u32x4*)(WT + (size_t)(drow0 + n) * K + k0 + 8 * c) = o; }
    LDS_WAIT(); asm volatile("" ::: "memory");
}
template <int NR> __device__ __forceinline__ void rms_rows_to_bf16(const float* x, const float* g, bf16* o, size_t m0, size_t stride, size_t mend, int lane) {
    const GAS f32x4* gr = (const GAS f32x4*)g + lane;
    f32x4 v[NR][4];
#pragma unroll
    for (int r = 0; r < NR; ++r) { const size_t m = m0 + r * stride; if (m < mend) { const GAS f32x4* xr = (const GAS f32x4*)(x + m * DM) + lane;
#pragma unroll
            for (int j = 0; j < 4; ++j) v[r][j] = xr[64 * j]; } else {
#pragma unroll
            for (int j = 0; j < 4; ++j) v[r][j] = (f32x4){0.f, 0.f, 0.f, 0.f}; } }
    f32x4 gg[4];
#pragma unroll
    for (int j = 0; j < 4; ++j) gg[j] = gr[64 * j];
#pragma unroll
    for (int r = 0; r < NR; ++r) { const size_t m = m0 + r * stride; float s = 0.f;
#pragma unroll
        for (int j = 0; j < 4; ++j) s += (v[r][j].x * v[r][j].x + v[r][j].y * v[r][j].y) + (v[r][j].z * v[r][j].z + v[r][j].w * v[r][j].w);
        const float rstd = 1.f / sqrtf(wave_sum(s) * (1.f / 1024.f) + EPS);
        if (m < mend) { GAS unsigned long long* o8 = (GAS unsigned long long*)(o + m * DM) + lane;
#pragma unroll
            for (int j = 0; j < 4; ++j) o8[64 * j] = (unsigned long long)pk2(v[r][j].x * rstd * gg[j].x, v[r][j].y * rstd * gg[j].y) | ((unsigned long long)pk2(v[r][j].z * rstd * gg[j].z, v[r][j].w * rstd * gg[j].w) << 32); } }
}
__device__ __forceinline__ void p0_transposes(Frame& F, bool late, int gw, int NGW) {
    LAS float* scr = (LAS float*)(F.lds + F.wave * 16384);
    bf16* WIN = (bf16*)(F.ws + WS_WIN);
    constexpr int I_INH = 16 * 192, I_SQ = 16 * 32, I_KV = 16 * 64;
    const int NITEMS = late ? I_INH + 4 * I_SQ : I_INH + I_KV;
    const float* p_win = INP(I_WIN); const float* p_woa = INP(I_WOA); const float* p_wob = INP(I_WOB); const float* p_woc = INP(I_WOC); const float* p_wout = INP(I_WOUT); const float* p_wmkv = INP(I_WMKV);
    for (int it = gw; it < NITEMS; it += NGW) {
        int r = it;
        if (r < I_INH) { const int kb = r / 192, e = r % 192;
            const int nb = late ? (e < 32 ? 96 + e : e < 64 ? 160 + e : 192 + e) : (e < 96 ? e : e < 160 ? e + 32 : e + 64);
            p0_transpose_item(p_win, 1024, INW, WIN, 64 * kb, 32 * nb, dest_row(32 * nb), scr, F.lane); continue; } r -= I_INH;
        if (late) { const int w = r / I_SQ, q = r % I_SQ, kb = q / 32, nb = q % 32;
            const float* src = w == 0 ? p_woa : w == 1 ? p_wob : w == 2 ? p_woc : p_wout;
            bf16* dst = (bf16*)(F.ws + (w == 0 ? WS_WOA : w == 1 ? WS_WOB : w == 2 ? WS_WOC : WS_WOUT));
            p0_transpose_item(src, 1024, 1024, dst, 64 * kb, 32 * nb, 32 * nb, scr, F.lane); continue; }
        { const int kb = r / 64, nb = r % 64; p0_transpose_item(p_wmkv, 1024, 2048, (bf16*)(F.ws + WS_WMKV), 64 * kb, 32 * nb, 32 * nb, scr, F.lane); }
    }
}
__device__ __forceinline__ void p0_prologue(Frame& F) {
    const int gw = F.vcu * 8 + F.wave, NGW = F.G * 8;
    p0_transposes(F, false, gw, NGW);
    bf16* XN = (bf16*)((unsigned char*)F.out + OUT_XN);
    { const float* xin = INP(I_X); const float* gpre = INP(I_GPRE);
      for (size_t m = gw; m < MTOK; m += (size_t)4 * NGW) rms_rows_to_bf16<4>(xin, gpre, XN, m, NGW, MTOK, F.lane); }
    bf16* MN = (bf16*)(F.ws + WS_MN);
    { const float* min_ = INP(I_MEM); const float* gmem = INP(I_GMEM);
      for (size_t m = gw; m < MMEM; m += (size_t)2 * NGW) rms_rows_to_bf16<2>(min_, gmem, MN, m, NGW, MMEM, F.lane); }
}

namespace att {
constexpr int L_K = 0, L_V = 16384, L_BIAS = 49152, L_WS = 49152 + NREL * 4, L_ST = L_WS + 2048, L_END = L_ST + 65536;
static_assert(L_END <= RING_BYTES, "attention LDS");
__device__ __forceinline__ int crow(int r, int hi) { return (r & 3) + 8 * (r >> 2) + 4 * hi; }
__device__ __forceinline__ void glds16(const void* gsrc, unsigned lds_dst) { unsigned keep;
    asm volatile("s_mov_b32 %0, m0\n\ts_mov_b32 m0, %2\n\ts_nop 0\n\tglobal_load_lds_dwordx4 %1, off\n\ts_mov_b32 m0, %0" : "=&s"(keep) : "v"(gsrc), "s"(lds_dst) : "memory"); }
typedef short v4i16_t __attribute__((ext_vector_type(4)));
__device__ __forceinline__ s16x4 vtr(const LAS char* p) { return __builtin_bit_cast(s16x4, __builtin_amdgcn_ds_read_tr16_b64_v4i16((LAS v4i16_t*)p)); }
#define MFMA32(a, b, c) __builtin_amdgcn_mfma_f32_32x32x16_bf16(a, b, c, 0, 0, 0)

__device__ __forceinline__ void attn_unit(int b, int h, int qb, const bf16* Q, const bf16* K, const bf16* V, bf16* O, const float* tab, const float* gsub, float lam, LAS unsigned char* shm) {
    const int tid = fresh_tid(), lane = tid & 63, r32 = lane & 31, hi = lane >> 5; const int wid = __builtin_amdgcn_readfirstlane(tid >> 6);
    const long rowbase = (long)b * SEQ; const int q0 = qb * 256, NT = q0 / 64 + 4;
    const int qw = q0 + 32 * wid, ntw = qw / 64 + 1;
    const unsigned lds0 = (unsigned)(uintptr_t)shm;
    LAS float* biasl = (LAS float*)(shm + L_BIAS);
    LAS float* wsf = (LAS float*)(shm + L_WS) + wid * 64;
    LAS unsigned short* stg = (LAS unsigned short*)(shm + L_ST + wid * 8192);
    for (int i = tid; i < NREL; i += 512) biasl[i] = tab[t5_bucket(i - 2047) * 8 + h] * LOG2E;
    const float c15 = tab[15 * 8 + h] * LOG2E;
    const LAS char* kp0 = (const LAS char*)shm + L_K + hi * 1024 + r32 * 16;
    const LAS char* vp0 = (const LAS char*)shm + L_V + ((lane >> 4) & 1) * 32 + (lane & 3) * 8 + (4 * hi + ((lane & 15) >> 2)) * 64;
    f32x16 o[4];
    for (int c = 0; c < 2; ++c) {
        const bf16* Qw = Q + (rowbase + qw) * DM + h * 128 + c * 64;
        const bf16* ksrc = K + (rowbase + lane) * DM + h * 128 + c * 64 + wid * 8;
        const int p0i = wid * 2, p1i = wid * 2 + 1;
        const bf16* vsrc0 = V + (rowbase + 16 * (p0i & 3) + (lane >> 2)) * DM + h * 128 + (p0i >> 2) * 32 + (lane & 3) * 8;
        const bf16* vsrc1 = V + (rowbase + 16 * (p1i & 3) + (lane >> 2)) * DM + h * 128 + (p1i >> 2) * 32 + (lane & 3) * 8;
#define DMA_KV(t, slot) do { glds16(ksrc + (long)(t) * 64 * DM, (unsigned)__builtin_amdgcn_readfirstlane(lds0 + L_K + (slot) * 8192 + wid * 1024)); \
        glds16(vsrc0 + (long)(t) * 64 * DM, (unsigned)__builtin_amdgcn_readfirstlane(lds0 + L_V + (slot) * 16384 + p0i * 1024)); \
        glds16(vsrc1 + (long)(t) * 64 * DM, (unsigned)__builtin_amdgcn_readfirstlane(lds0 + L_V + (slot) * 16384 + p1i * 1024)); } while (0)
        DMA_KV(0, 0);
        bf16x8 qr[4];
#pragma unroll
        for (int d0 = 0; d0 < 4; ++d0) qr[d0] = *reinterpret_cast<const bf16x8*>(&Qw[(long)r32 * DM + d0 * 16 + hi * 8]);
        asm volatile("" :: "v"(qr[0]), "v"(qr[1]), "v"(qr[2]), "v"(qr[3]));
        float m_run = -1e30f, l_run = 0.f;
#pragma unroll
        for (int d0 = 0; d0 < 4; ++d0) o[d0] = f32x16{};
        for (int t = 0; t < NT; ++t) {
            asm volatile("s_waitcnt vmcnt(0) lgkmcnt(0)\n\ts_barrier" ::: "memory");
            const int slot = t & 1;
            if (t + 1 < NT) DMA_KV(t + 1, slot ^ 1);
            if (t < ntw) {
                const LAS char* kp = kp0 + slot * 8192; const LAS char* vp = vp0 + slot * 16384;
                f32x16 p0 = f32x16{}, p1 = f32x16{};
#pragma unroll
                for (int d0 = 0; d0 < 4; ++d0) {
                    const bf16x8 k0 = *(const LAS bf16x8*)(kp + d0 * 2048), k1 = *(const LAS bf16x8*)(kp + d0 * 2048 + 512);
                    p0 = MFMA32(k0, qr[d0], p0); p1 = MFMA32(k1, qr[d0], p1);
                }
                if (64 * t + 63 - qw <= -91) {
#pragma unroll
                    for (int r = 0; r < 16; ++r) { p0[r] += c15; p1[r] += c15; }
                } else {
                    const int ib = 64 * t - qw - r32 + 2047 + 4 * hi;
#pragma unroll
                    for (int r = 0; r < 16; ++r) { const int kk = (r & 3) + 8 * (r >> 2); p0[r] += biasl[ib + kk]; p1[r] += biasl[ib + kk + 32]; }
                }
                float rm = p0[0];
#pragma unroll
                for (int r = 0; r < 16; ++r) { rm = fmaxf(rm, p0[r]); rm = fmaxf(rm, p1[r]); }
                rm = fmaxf(rm, __shfl_xor(rm, 32));
                const float m_new = fmaxf(m_run, rm), alpha = __builtin_amdgcn_exp2f(m_run - m_new);
                m_run = m_new;
                float rs = 0.f;
#pragma unroll
                for (int r = 0; r < 16; ++r) { p0[r] = __builtin_amdgcn_exp2f(p0[r] - m_new); p1[r] = __builtin_amdgcn_exp2f(p1[r] - m_new); }
                u32x4 pw[4];
#pragma unroll
                for (int ks = 0; ks < 2; ++ks)
#pragma unroll
                    for (int j = 0; j < 4; ++j) { pw[ks][j] = cvt_pk_bf16(p0[8 * ks + 2 * j], p0[8 * ks + 2 * j + 1]); pw[2 + ks][j] = cvt_pk_bf16(p1[8 * ks + 2 * j], p1[8 * ks + 2 * j + 1]); }
#pragma unroll
                for (int ks = 0; ks < 4; ++ks)
#pragma unroll
                    for (int j = 0; j < 4; ++j) rs += bflo(pw[ks][j]) + bfhi(pw[ks][j]);
                l_run = l_run * alpha + rs;
                if (__any(alpha != 1.0f)) {
                    if (hi == 0) wsf[r32] = alpha;
                    LDS_WAIT();
#pragma unroll
                    for (int r = 0; r < 16; ++r) { const float a = wsf[crow(r, hi)];
#pragma unroll
                        for (int d0 = 0; d0 < 4; ++d0) o[d0][r] *= a; }
                }
#pragma unroll
                for (int d0 = 0; d0 < 4; ++d0)
#pragma unroll
                    for (int ks = 0; ks < 4; ++ks) {
                        const s16x4 lo = vtr(vp + d0 * 4096 + ks * 1024), hh = vtr(vp + d0 * 4096 + ks * 1024 + 512);
                        const bf16x8 vb = (bf16x8){lo[0], lo[1], lo[2], lo[3], hh[0], hh[1], hh[2], hh[3]};
                        o[d0] = MFMA32(__builtin_bit_cast(bf16x8, pw[ks]), vb, o[d0]);
                    }
            }
        }
        asm volatile("s_waitcnt lgkmcnt(0)\n\ts_barrier" ::: "memory");
        l_run += __shfl_xor(l_run, 32);
        if (hi == 0) wsf[32 + r32] = l_run;
        LDS_WAIT();
        LAS unsigned* stash = (LAS unsigned*)stg;
        if (c == 0) {
#pragma unroll
            for (int r = 0; r < 16; r += 2) { const float rl0 = __builtin_amdgcn_rcpf(wsf[32 + crow(r, hi)]), rl1 = __builtin_amdgcn_rcpf(wsf[32 + crow(r + 1, hi)]);
#pragma unroll
                for (int d0 = 0; d0 < 4; ++d0) stash[(d0 * 8 + (r >> 1)) * 64 + lane] = cvt_pk_bf16(o[d0][r] * rl0, o[d0][r + 1] * rl1); }
        } else {
#pragma unroll
            for (int r = 0; r < 16; r += 2) { const float rl0 = __builtin_amdgcn_rcpf(wsf[32 + crow(r, hi)]), rl1 = __builtin_amdgcn_rcpf(wsf[32 + crow(r + 1, hi)]);
#pragma unroll
                for (int d0 = 0; d0 < 4; ++d0) { const unsigned w = stash[(d0 * 8 + (r >> 1)) * 64 + lane]; o[d0][r] = bflo(w) - lam * (o[d0][r] * rl0); o[d0][r + 1] = bfhi(w) - lam * (o[d0][r + 1] * rl1); } }
        }
        LDS_WAIT();
#undef DMA_KV
    }
    float gs[4];
#pragma unroll
    for (int d0 = 0; d0 < 4; ++d0) gs[d0] = gsub[32 * d0 + r32] * 0.8f;
#pragma unroll
    for (int r = 0; r < 16; ++r) {
        float ss = 0.f;
#pragma unroll
        for (int d0 = 0; d0 < 4; ++d0) ss += o[d0][r] * o[d0][r];
#pragma unroll
        for (int x = 1; x < 32; x <<= 1) ss += __shfl_xor(ss, x);
        const float rstd = 1.f / sqrtf(ss * (1.f / 128.f) + EPS);
        const int orow = crow(r, hi);
#pragma unroll
        for (int d0 = 0; d0 < 4; ++d0) stg[orow * 128 + d0 * 32 + r32] = (unsigned short)f2bf(o[d0][r] * rstd * gs[d0]);
    }
    LDS_WAIT();
    bf16* Ow = O + (rowbase + qw) * DM + h * 128;
#pragma unroll
    for (int i = 0; i < 8; ++i) { const int idx = i * 64 + lane, row = idx >> 4, ch = idx & 15; const u32x4 v = *(const LAS u32x4*)(stg + row * 128 + ch * 8); *(u32x4*)(Ow + (long)row * DM + ch * 8) = v; }
    asm volatile("s_waitcnt lgkmcnt(0)\n\ts_barrier" ::: "memory");
}
}

namespace att2 {
using att::crow; using att::glds16; using att::vtr;
constexpr int NSK = 3, NSV = 3;
constexpr int L_K = 0, L_V = NSK * 8192, L_BIAS = L_V + NSV * 16384, L_WS = L_BIAS + NREL * 4, L_FLAG = L_WS + 2048, L_ST = L_FLAG + 64, L_END = L_ST + 65536;
static_assert(L_END <= PHASE_LDS, "attention LDS");
__device__ __forceinline__ bool attn_unit(int b, int h, int qb, const bf16* Q, const bf16* K, const bf16* V, bf16* O, const float* tab, const float* gsub, float lam, LAS unsigned char* shm) {
    const int tid = fresh_tid(), lane = tid & 63, r32 = lane & 31, hi = lane >> 5; const int wid = __builtin_amdgcn_readfirstlane(tid >> 6);
    const long rowbase = (long)b * SEQ; const int q0 = qb * 256, NT = q0 / 64 + 4;
    const int grp = wid >> 2, blk = (wid & 3) * 2 + grp;
    const int qw = q0 + 32 * blk, ntw = qw / 64 + 1;
    const unsigned lds0 = (unsigned)(uintptr_t)shm;
    LAS float* biasl = (LAS float*)(shm + L_BIAS);
    LAS float* wsf = (LAS float*)(shm + L_WS) + wid * 64;
    LAS unsigned short* stg = (LAS unsigned short*)(shm + L_ST + wid * 8192);
    LAS unsigned* flag = (LAS unsigned*)(shm + L_FLAG);
    { const float b15 = tab[15 * 8 + h]; for (int i = tid; i < NREL; i += 512) biasl[i] = (tab[t5_bucket(i - 2047) * 8 + h] - b15) * LOG2E; }
    if (tid == 0) flag[0] = 0u;
    const LAS char* kp0 = (const LAS char*)shm + L_K + hi * 1024 + r32 * 16;
    const LAS char* vp0 = (const LAS char*)shm + L_V + ((lane >> 4) & 1) * 32 + (lane & 3) * 8 + (4 * hi + ((lane & 15) >> 2)) * 64;
    f32x16 o[4]; bool bad = false;
    for (int c = 0; c < 2; ++c) {
        const bf16* Qw = Q + (rowbase + qw) * DM + h * 128 + c * 64;
        const bf16* ksrc = K + (rowbase + lane) * DM + h * 128 + c * 64 + wid * 8;
        const int p0i = wid * 2, p1i = wid * 2 + 1;
        const bf16* vsrc0 = V + (rowbase + 16 * (p0i & 3) + (lane >> 2)) * DM + h * 128 + (p0i >> 2) * 32 + (lane & 3) * 8;
        const bf16* vsrc1 = V + (rowbase + 16 * (p1i & 3) + (lane >> 2)) * DM + h * 128 + (p1i >> 2) * 32 + (lane & 3) * 8;
#define DMA_K(t, slot) glds16(ksrc + (long)(t) * 64 * DM, (unsigned)__builtin_amdgcn_readfirstlane(lds0 + L_K + (slot) * 8192 + wid * 1024))
#define DMA_V(t, slot) do { glds16(vsrc0 + (long)(t) * 64 * DM, (unsigned)__builtin_amdgcn_readfirstlane(lds0 + L_V + (slot) * 16384 + p0i * 1024)); \
        glds16(vsrc1 + (long)(t) * 64 * DM, (unsigned)__builtin_amdgcn_readfirstlane(lds0 + L_V + (slot) * 16384 + p1i * 1024)); } while (0)
        DMA_K(0, 0); DMA_V(0, 0); DMA_K(1, 1);
        bf16x8 qr[4];
#pragma unroll
        for (int d0 = 0; d0 < 4; ++d0) qr[d0] = *reinterpret_cast<const bf16x8*>(&Qw[(long)r32 * DM + d0 * 16 + hi * 8]);
        asm volatile("" :: "v"(qr[0]), "v"(qr[1]), "v"(qr[2]), "v"(qr[3]));
        float l_run = 0.f;
#pragma unroll
        for (int d0 = 0; d0 < 4; ++d0) o[d0] = f32x16{};
        u32x4 pw[4];
#pragma unroll
        for (int ks = 0; ks < 4; ++ks) pw[ks] = (u32x4){0u, 0u, 0u, 0u};
        for (int hs = 0; hs <= 2 * NT + 1; ++hs) {
            const int g = hs >> 1;
            if ((hs & 1) == 0) {
#define WB(N) asm volatile("s_waitcnt vmcnt(" #N ") lgkmcnt(0)\n\ts_barrier" ::: "memory")
                if (g + 1 < NT) WB(1); else WB(0);
#undef WB
                if (g + 1 < NT) DMA_V(g + 1, (g + 1) % 3);
                if (g + 2 < NT) DMA_K(g + 2, (g + 2) % 3);
            }
            const int j = hs - grp;
            if (j >= 0) {
                const int t = j >> 1;
                if (t < ntw) {
                    if ((j & 1) == 0) {
                        const LAS char* kp = kp0 + (t % 3) * 8192;
                        bf16x8 kf[8];
#pragma unroll
                        for (int d0 = 0; d0 < 4; ++d0) { kf[2 * d0] = *(const LAS bf16x8*)(kp + d0 * 2048); kf[2 * d0 + 1] = *(const LAS bf16x8*)(kp + d0 * 2048 + 512); }
                        __builtin_amdgcn_sched_barrier(0);
                        __builtin_amdgcn_s_setprio(1);
                        f32x16 p0 = MFMA32(kf[0], qr[0], (f32x16){}), p1 = MFMA32(kf[1], qr[0], (f32x16){});
#pragma unroll
                        for (int d0 = 1; d0 < 4; ++d0) { p0 = MFMA32(kf[2 * d0], qr[d0], p0); p1 = MFMA32(kf[2 * d0 + 1], qr[d0], p1); }
                        __builtin_amdgcn_s_setprio(0);
                        if (64 * t + 63 - qw > -91) {
                            const int ib = 64 * t - qw - r32 + 2047 + 4 * hi;
#pragma unroll
                            for (int r = 0; r < 16; ++r) { const int kk = (r & 3) + 8 * (r >> 2); p0[r] += biasl[ib + kk]; p1[r] += biasl[ib + kk + 32]; } }
                        float rs = 0.f;
#pragma unroll
                        for (int r = 0; r < 16; ++r) { p0[r] = __builtin_amdgcn_exp2f(p0[r]); p1[r] = __builtin_amdgcn_exp2f(p1[r]); }
#pragma unroll
                        for (int r = 0; r < 16; ++r) rs += p0[r] + p1[r];
                        l_run += rs;
#pragma unroll
                        for (int ks = 0; ks < 2; ++ks)
#pragma unroll
                            for (int q = 0; q < 4; ++q) { pw[ks][q] = cvt_pk_bf16(p0[8 * ks + 2 * q], p0[8 * ks + 2 * q + 1]); pw[2 + ks][q] = cvt_pk_bf16(p1[8 * ks + 2 * q], p1[8 * ks + 2 * q + 1]); }
                    } else {
                        const LAS char* vp = vp0 + (t % 3) * 16384;
                        s16x4 va[8], vb[8];
#define RDV(dst, d0) do { _Pragma("unroll") for (int ks = 0; ks < 4; ++ks) { dst[2 * ks] = vtr(vp + (d0) * 4096 + ks * 1024); dst[2 * ks + 1] = vtr(vp + (d0) * 4096 + ks * 1024 + 512); } } while (0)
#define PVB(src, d0) do { _Pragma("unroll") for (int ks = 0; ks < 4; ++ks) { const bf16x8 vv = (bf16x8){src[2 * ks][0], src[2 * ks][1], src[2 * ks][2], src[2 * ks][3], src[2 * ks + 1][0], src[2 * ks + 1][1], src[2 * ks + 1][2], src[2 * ks + 1][3]}; \
                            o[d0] = MFMA32(__builtin_bit_cast(bf16x8, pw[ks]), vv, o[d0]); } } while (0)
                        RDV(va, 0); RDV(vb, 1); __builtin_amdgcn_sched_barrier(0);
                        PVB(va, 0); __builtin_amdgcn_sched_barrier(0);
                        RDV(va, 2); __builtin_amdgcn_sched_barrier(0);
                        PVB(vb, 1); __builtin_amdgcn_sched_barrier(0);
                        RDV(vb, 3); __builtin_amdgcn_sched_barrier(0);
                        PVB(va, 2); __builtin_amdgcn_sched_barrier(0);
                        PVB(vb, 3);
#undef RDV
#undef PVB
                    }
                }
            }
        }
        asm volatile("s_waitcnt lgkmcnt(0)\n\ts_barrier" ::: "memory");
        l_run += __shfl_xor(l_run, 32);
        bad = bad || (BADTEST == 1 ? false : BADTEST == 2 ? !(l_run == l_run) : BADTEST == 3 ? !(l_run > 1e-30f) : BADTEST == 4 ? !(l_run < 1e30f) : !(l_run > 1e-30f && l_run < 1e30f));
        if (hi == 0) wsf[32 + r32] = l_run;
        LDS_WAIT();
        LAS unsigned* stash = (LAS unsigned*)stg;
        if (c == 0) {
#pragma unroll
            for (int r = 0; r < 16; r += 2) { const float rl0 = __builtin_amdgcn_rcpf(wsf[32 + crow(r, hi)]), rl1 = __builtin_amdgcn_rcpf(wsf[32 + crow(r + 1, hi)]);
#pragma unroll
                for (int d0 = 0; d0 < 4; ++d0) stash[(d0 * 8 + (r >> 1)) * 64 + lane] = cvt_pk_bf16(o[d0][r] * rl0, o[d0][r + 1] * rl1); }
        } else {
#pragma unroll
            for (int r = 0; r < 16; r += 2) { const float rl0 = __builtin_amdgcn_rcpf(wsf[32 + crow(r, hi)]), rl1 = __builtin_amdgcn_rcpf(wsf[32 + crow(r + 1, hi)]);
#pragma unroll
                for (int d0 = 0; d0 < 4; ++d0) { const unsigned w = stash[(d0 * 8 + (r >> 1)) * 64 + lane]; o[d0][r] = bflo(w) - lam * (o[d0][r] * rl0); o[d0][r + 1] = bfhi(w) - lam * (o[d0][r + 1] * rl1); } }
        }
        LDS_WAIT();
#undef DMA_K
#undef DMA_V
    }
    if (__any(bad) && lane == 0) flag[0] = 1u;
    asm volatile("s_waitcnt lgkmcnt(0)\n\ts_barrier" ::: "memory");
    const bool redo = flag[0] != 0u;
    if (!redo) {
        float gs[4];
#pragma unroll
        for (int d0 = 0; d0 < 4; ++d0) gs[d0] = gsub[32 * d0 + r32] * 0.8f;
#pragma unroll
        for (int r = 0; r < 16; ++r) {
            float ss = 0.f;
#pragma unroll
            for (int d0 = 0; d0 < 4; ++d0) ss += o[d0][r] * o[d0][r];
#pragma unroll
            for (int x = 1; x < 32; x <<= 1) ss += __shfl_xor(ss, x);
            const float rstd = 1.f / sqrtf(ss * (1.f / 128.f) + EPS);
            const int orow = crow(r, hi);
#pragma unroll
            for (int d0 = 0; d0 < 4; ++d0) stg[orow * 128 + d0 * 32 + r32] = (unsigned short)f2bf(o[d0][r] * rstd * gs[d0]);
        }
        LDS_WAIT();
        bf16* Ow = O + (rowbase + qw) * DM + h * 128;
#pragma unroll
        for (int i = 0; i < 8; ++i) { const int idx = i * 64 + lane, row = idx >> 4, ch = idx & 15; const u32x4 v = *(const LAS u32x4*)(stg + row * 128 + ch * 8); *(u32x4*)(Ow + (long)row * DM + ch * 8) = v; }
    }
    asm volatile("s_waitcnt lgkmcnt(0)\n\ts_barrier" ::: "memory");
    return redo;
}
}

namespace att3 {
using att::crow; using att::vtr;
__device__ __forceinline__ void glds16s(const void* sbase, unsigned voff, unsigned lds_dst) { unsigned keep;
    asm volatile("s_mov_b32 %0, m0\n\ts_mov_b32 m0, %3\n\ts_nop 0\n\tglobal_load_lds_dwordx4 %1, %2\n\ts_mov_b32 m0, %0" : "=&s"(keep) : "v"(voff), "s"(sbase), "s"(lds_dst) : "memory"); }
constexpr int L_K = 0, L_V = 3 * 8192, L_BIAS = L_V + 3 * 16384, L_WS = L_BIAS + NREL * 4, L_FLAG = L_WS + 2048, L_GS = L_FLAG + 64, L_ST = L_GS + 512, L_END = L_ST + 65536;
static_assert(L_END <= PHASE_LDS, "attention LDS");
__device__ __forceinline__ bool attn_unit(int b, int h, int qb, int qb_next, bool first, bool build_tab, bf16x8 (&qr)[4], const bf16* Q, const bf16* K, const bf16* V, bf16* O, const float* tab, const float* gsub, float lam, LAS unsigned char* shm) {
    const int tid = fresh_tid(), lane = tid & 63, r32 = lane & 31, hi = lane >> 5; const int wid = __builtin_amdgcn_readfirstlane(tid >> 6);
    const long rowbase = (long)b * SEQ; const int q0 = qb * 256, NT = q0 / 64 + 4;
    const int blk = (((wid >> 2) ? 3 - ((wid & 3) >> 1) : ((wid & 3) >> 1)) << 1) + (wid & 1);
    const int qw = q0 + 32 * blk, ntw = qw / 64 + 1;
    const unsigned lds0 = (unsigned)(uintptr_t)shm;
    LAS float* biasl = (LAS float*)(shm + L_BIAS);
    LAS float* wsf = (LAS float*)(shm + L_WS) + wid * 64;
    LAS unsigned short* stg = (LAS unsigned short*)(shm + L_ST + wid * 8192);
    LAS unsigned* flag = (LAS unsigned*)(shm + L_FLAG);
    if (first) asm volatile("s_waitcnt vmcnt(0) lgkmcnt(0)\n\ts_barrier" ::: "memory");
    if (build_tab) { const float b15 = tab[15 * 8 + h]; for (int i = tid; i < NREL; i += 512) biasl[i] = (tab[t5_bucket(i - 2047) * 8 + h] - b15) * LOG2E;
                     if (tid < 128) ((LAS float*)(shm + L_GS))[tid] = gsub[tid] * 0.8f; }
    if (tid == 0) flag[0] = 0u;
    const LAS char* kp0 = (const LAS char*)shm + L_K + hi * 1024 + r32 * 16;
    const LAS char* vp0 = (const LAS char*)shm + L_V + ((lane >> 4) & 1) * 32 + (lane & 3) * 8 + (4 * hi + ((lane & 15) >> 2)) * 64;
    const int ibase = -qw - r32 + 2047 + 4 * hi;
    f32x16 o[4]; bool bad = false;
#define SBV __builtin_amdgcn_sched_barrier(0x406)
#define WB(N) asm volatile("s_waitcnt vmcnt(" #N ") lgkmcnt(0)\n\ts_barrier" ::: "memory")
#define QKT(P0, P1, t) do { int so_ = ((t) % 3) * 8192; asm volatile("" : "+s"(so_)); const LAS char* kp_ = kp0 + so_; bf16x8 kf[8]; \
        _Pragma("unroll") for (int d0 = 0; d0 < 4; ++d0) { kf[2 * d0] = *(const LAS bf16x8*)(kp_ + d0 * 2048); kf[2 * d0 + 1] = *(const LAS bf16x8*)(kp_ + d0 * 2048 + 512); } \
        __builtin_amdgcn_sched_barrier(0);     \
        P0 = MFMA32(kf[0], qr[0], (f32x16){}); P1 = MFMA32(kf[1], qr[0], (f32x16){}); \
        _Pragma("unroll") for (int d0 = 1; d0 < 4; ++d0) { P0 = MFMA32(kf[2 * d0], qr[d0], P0); P1 = MFMA32(kf[2 * d0 + 1], qr[d0], P1); } \
        if (64 * (t) + 63 - qw > -91) { const int ib = 64 * (t) + ibase; \
            _Pragma("unroll") for (int r = 0; r < 16; ++r) { const int kk = (r & 3) + 8 * (r >> 2); P0[r] += biasl[ib + kk]; P1[r] += biasl[ib + kk + 32]; } } } while (0)
#define SOFTMAX(P0, P1, PW) do { float rs = 0.f; \
        _Pragma("unroll") for (int r = 0; r < 16; ++r) { P0[r] = __builtin_amdgcn_exp2f(P0[r]); P1[r] = __builtin_amdgcn_exp2f(P1[r]); } \
        _Pragma("unroll") for (int r = 0; r < 16; ++r) rs += P0[r] + P1[r]; \
        l_run += rs; \
        _Pragma("unroll") for (int ks = 0; ks < 2; ++ks) _Pragma("unroll") for (int q = 0; q < 4; ++q) { PW[ks][q] = cvt_pk_bf16(P0[8 * ks + 2 * q], P0[8 * ks + 2 * q + 1]); PW[2 + ks][q] = cvt_pk_bf16(P1[8 * ks + 2 * q], P1[8 * ks + 2 * q + 1]); } } while (0)
#define RDV(dst, d0) do { _Pragma("unroll") for (int ks = 0; ks < 4; ++ks) { dst[2 * ks] = vtr(vp + (d0) * 4096 + ks * 1024); dst[2 * ks + 1] = vtr(vp + (d0) * 4096 + ks * 1024 + 512); } } while (0)
#define PVB(src, d0) do { _Pragma("unroll") for (int ks = 0; ks < 4; ++ks) { const bf16x8 vv = (bf16x8){src[2 * ks][0], src[2 * ks][1], src[2 * ks][2], src[2 * ks][3], src[2 * ks + 1][0], src[2 * ks + 1][1], src[2 * ks + 1][2], src[2 * ks + 1][3]}; \
        o[d0] = MFMA32(__builtin_bit_cast(bf16x8, pw[ks]), vv, o[d0]); } } while (0)
#define PV(t) do { int so_ = ((t) % 3) * 16384; asm volatile("" : "+s"(so_)); const LAS char* vp = vp0 + so_; s16x4 va[8]; \
        RDV(va, 0); SBV; PVB(va, 0); SBV; RDV(va, 1); SBV; PVB(va, 1); SBV; RDV(va, 2); SBV; PVB(va, 2); SBV; RDV(va, 3); SBV; PVB(va, 3); } while (0)
    for (int c = 0; c < 2; ++c) {
        const bf16* Qw = Q + (rowbase + qw) * DM + h * 128 + c * 64;
        const bf16* kbase = K + rowbase * DM + h * 128 + c * 64;
        const bf16* vbase = V + rowbase * DM + h * 128;
        const int p0i = wid * 2, p1i = wid * 2 + 1;
#define LANE_() ({ int l_ = lane; asm volatile("" : "+v"(l_)); l_; })
#define KVO() ((unsigned)((LANE_() * DM + wid * 8) * 2))
#define VVO(pi) ({ const int l2_ = LANE_(); (unsigned)(((16 * ((pi) & 3) + (l2_ >> 2)) * DM + ((pi) >> 2) * 32 + (l2_ & 3) * 8) * 2); })
#define DMA_KB(kb, t) glds16s((kb) + (size_t)(t) * 64 * DM, KVO(), (unsigned)__builtin_amdgcn_readfirstlane(lds0 + L_K + ((t) % 3) * 8192 + wid * 1024))
#define DMA_VB(vb, t) do { glds16s((vb) + (size_t)(t) * 64 * DM, VVO(p0i), (unsigned)__builtin_amdgcn_readfirstlane(lds0 + L_V + ((t) % 3) * 16384 + p0i * 1024)); \
        glds16s((vb) + (size_t)(t) * 64 * DM, VVO(p1i), (unsigned)__builtin_amdgcn_readfirstlane(lds0 + L_V + ((t) % 3) * 16384 + p1i * 1024)); } while (0)
#define DMA_K(t) DMA_KB(kbase, t)
#define DMA_V(t) DMA_VB(vbase, t)
#define PROLOGUE(kb, vb, qp) do { DMA_KB(kb, 0); DMA_VB(vb, 0); DMA_KB(kb, 1); DMA_VB(vb, 1); DMA_KB(kb, 2); \
        { const int lq_ = LANE_(); _Pragma("unroll") for (int d0 = 0; d0 < 4; ++d0) qr[d0] = *reinterpret_cast<const bf16x8*>(&(qp)[(long)(lq_ & 31) * DM + d0 * 16 + (lq_ >> 5) * 8]); } } while (0)
        if (c == 0 && first) PROLOGUE(kbase, vbase, Qw);
        asm volatile("" :: "v"(qr[0]), "v"(qr[1]), "v"(qr[2]), "v"(qr[3]));
        float l_run = 0.f;
#pragma unroll
        for (int d0 = 0; d0 < 4; ++d0) o[d0] = f32x16{};
        u32x4 pw[4];
        WB(0);
        { f32x16 s0, s1; QKT(s0, s1, 0); SOFTMAX(s0, s1, pw); }
        for (int t = 0; t < NT; ++t) {
            if (t + 2 < NT) WB(3); else if (t + 1 < NT) WB(2); else WB(0);
            if (t + 2 < NT) DMA_V(t + 2);
            if (t + 3 < NT) DMA_K(t + 3);
            if (t < ntw) {
                if (t + 1 < ntw) {
                    f32x16 n0, n1; u32x4 pwn[4];
                    QKT(n0, n1, t + 1);
                    __builtin_amdgcn_sched_barrier(0);
                    {
                        int so_ = (t % 3) * 16384; asm volatile("" : "+s"(so_)); const LAS char* vp = vp0 + so_;
                        s16x4 vl[4], vh[4]; float rs = 0.f;
#define VRD_(i) do { vl[(i) & 3] = vtr(vp + ((i) >> 2) * 4096 + ((i) & 3) * 1024); vh[(i) & 3] = vtr(vp + ((i) >> 2) * 4096 + ((i) & 3) * 1024 + 512); } while (0)
#define VFR_(i) (bf16x8){vl[(i) & 3][0], vl[(i) & 3][1], vl[(i) & 3][2], vl[(i) & 3][3], vh[(i) & 3][0], vh[(i) & 3][1], vh[(i) & 3][2], vh[(i) & 3][3]}
#define PIN_(x) asm volatile("" : "+v"(x))
#define GAP_(i, N, j) do { if ((i) + 2 < 16) VRD_((i) + 2); \
                            o[(i) >> 2] = MFMA32(__builtin_bit_cast(bf16x8, pw[(i) & 3]), VFR_(i), o[(i) >> 2]); PIN_(o[(i) >> 2]); \
                            N[j] = __builtin_amdgcn_exp2f(N[j]); N[(j) + 1] = __builtin_amdgcn_exp2f(N[(j) + 1]); PIN_(N); \
                            __builtin_amdgcn_sched_barrier(0); } while (0)
#define FIN_(i, N, j) do { rs += N[j] + N[(j) + 1]; pwn[(i) >> 2][(i) & 3] = cvt_pk_bf16(N[j], N[(j) + 1]); PIN_(rs); PIN_(pwn[(i) >> 2]); } while (0)
                        VRD_(0); VRD_(1); __builtin_amdgcn_sched_barrier(0);
                        GAP_(0, n0, 0);
                        FIN_(0, n0, 0);  GAP_(1, n0, 2);
                        FIN_(1, n0, 2);  GAP_(2, n0, 4);
                        FIN_(2, n0, 4);  GAP_(3, n0, 6);
                        FIN_(3, n0, 6);  GAP_(4, n0, 8);
                        FIN_(4, n0, 8);  GAP_(5, n0, 10);
                        FIN_(5, n0, 10); GAP_(6, n0, 12);
                        FIN_(6, n0, 12); GAP_(7, n0, 14);
                        FIN_(7, n0, 14); GAP_(8, n1, 0);
                        FIN_(8, n1, 0);  GAP_(9, n1, 2);
                        FIN_(9, n1, 2);  GAP_(10, n1, 4);
                        FIN_(10, n1, 4); GAP_(11, n1, 6);
                        FIN_(11, n1, 6); GAP_(12, n1, 8);
                        FIN_(12, n1, 8); GAP_(13, n1, 10);
                        FIN_(13, n1, 10); GAP_(14, n1, 12);
                        FIN_(14, n1, 12); GAP_(15, n1, 14);
                        FIN_(15, n1, 14);
                        l_run += rs;
#undef VRD_
#undef VFR_
#undef PIN_
#undef GAP_
#undef FIN_
                    }
#pragma unroll
                    for (int ks = 0; ks < 4; ++ks) pw[ks] = pwn[ks];
                } else { PV(t); }
            }
        }
        asm volatile("s_waitcnt lgkmcnt(0)\n\ts_barrier" ::: "memory");
        if (c == 0) PROLOGUE(kbase + 64, vbase, Qw + 64);
        else if (qb_next >= 0) { const bf16* Qn = Q + (rowbase + qb_next * 256 + 32 * blk) * DM + h * 128; PROLOGUE(kbase - 64, vbase, Qn); }
        l_run += __shfl_xor(l_run, 32);
        bad = bad || !(l_run > 1e-30f && l_run < 1e30f);
        if (hi == 0) wsf[32 + r32] = l_run;
        LDS_WAIT();
        LAS unsigned* stash = (LAS unsigned*)stg;
#pragma unroll
        for (int d0 = 0; d0 < 4; ++d0) {
            asm volatile("" : "+v"(o[d0]));
            if (c == 0) {
#pragma unroll
                for (int r = 0; r < 16; r += 2) { const float rl0 = __builtin_amdgcn_rcpf(wsf[32 + crow(r, hi)]), rl1 = __builtin_amdgcn_rcpf(wsf[32 + crow(r + 1, hi)]);
                    stash[(d0 * 8 + (r >> 1)) * 64 + lane] = cvt_pk_bf16(o[d0][r] * rl0, o[d0][r + 1] * rl1); }
            } else {
#pragma unroll
                for (int r = 0; r < 16; r += 2) { const float rl0 = __builtin_amdgcn_rcpf(wsf[32 + crow(r, hi)]) * lam, rl1 = __builtin_amdgcn_rcpf(wsf[32 + crow(r + 1, hi)]) * lam;
                    const unsigned w = stash[(d0 * 8 + (r >> 1)) * 64 + lane]; o[d0][r] = bflo(w) - o[d0][r] * rl0; o[d0][r + 1] = bfhi(w) - o[d0][r + 1] * rl1; }
            }
            asm volatile("" : "+v"(o[d0]));
        }
        LDS_WAIT();
#undef PROLOGUE
#undef DMA_K
#undef DMA_V
#undef DMA_KB
#undef DMA_VB
#undef LANE_
#undef KVO
#undef VVO
    }
#undef SBV
#undef WB
#undef QKT
#undef SOFTMAX
#undef RDV
#undef PVB
#undef PV
    if (__any(bad) && lane == 0) flag[0] = 1u;
    asm volatile("s_waitcnt lgkmcnt(0)\n\ts_barrier" ::: "memory");
    const bool redo = flag[0] != 0u;
    if (!redo) {
        const LAS float* gsl = (const LAS float*)(shm + L_GS);
        float gs[4];
#pragma unroll
        for (int d0 = 0; d0 < 4; ++d0) gs[d0] = gsl[32 * d0 + r32];
        float ss[16];
#pragma unroll
        for (int r = 0; r < 16; ++r) ss[r] = (o[0][r] * o[0][r] + o[1][r] * o[1][r]) + (o[2][r] * o[2][r] + o[3][r] * o[3][r]);
#define DPPADD_(ctrl) do { _Pragma("unroll") for (int r = 0; r < 16; ++r) ss[r] += __builtin_bit_cast(float, __builtin_amdgcn_update_dpp(0, __builtin_bit_cast(int, ss[r]), ctrl, 0xf, 0xf, true)); } while (0)
        DPPADD_(0xB1); DPPADD_(0x4E); DPPADD_(0x141); DPPADD_(0x140);
#undef DPPADD_
        float sx[16];
#pragma unroll
        for (int r = 0; r < 16; ++r) sx[r] = __builtin_bit_cast(float, __builtin_amdgcn_ds_swizzle(__builtin_bit_cast(int, ss[r]), (16 << 10) | 0x1f));
#pragma unroll
        for (int r = 0; r < 16; ++r) {
            const float rstd = __builtin_amdgcn_rsqf((ss[r] + sx[r]) * (1.f / 128.f) + EPS);
            const int orow = crow(r, hi);
            const unsigned w01 = cvt_pk_bf16(o[0][r] * rstd * gs[0], o[1][r] * rstd * gs[1]), w23 = cvt_pk_bf16(o[2][r] * rstd * gs[2], o[3][r] * rstd * gs[3]);
            stg[orow * 128 + r32] = (unsigned short)w01; stg[orow * 128 + 32 + r32] = (unsigned short)(w01 >> 16);
            stg[orow * 128 + 64 + r32] = (unsigned short)w23; stg[orow * 128 + 96 + r32] = (unsigned short)(w23 >> 16);
        }
        LDS_WAIT();
        bf16* Ow = O + (rowbase + qw) * DM + h * 128;
#pragma unroll
        for (int i = 0; i < 8; ++i) { const int idx = i * 64 + lane, row = idx >> 4, ch = idx & 15; const u32x4 v = *(const LAS u32x4*)(stg + row * 128 + ch * 8); *(u32x4*)(Ow + (long)row * DM + ch * 8) = v; }
    }
    asm volatile("s_waitcnt lgkmcnt(0)\n\ts_barrier" ::: "memory");
    return redo;
}
}

__device__ __forceinline__ void conv_unit(Frame& F, int tok0, const bf16* C, bf16* OB) {
    constexpr int CT = 32, NP = CT + 30;
    const int t = fresh_tid(), ch = 2 * t, lane = t & 63, wave = __builtin_amdgcn_readfirstlane(t >> 6);
    const float* cw = INP(I_CONVW); const float* cb = INP(I_CONVB); const float* lng = INP(I_LNG); const float* lnb = INP(I_LNB);
    LAS float* tile = (LAS float*)F.lds;
    unsigned wq0[16], wq1[16];
#pragma unroll
    for (int m = 0; m < 16; ++m) { const f32x2 wa = *(const f32x2*)(cw + (2 * m) * 1024 + ch); f32x2 wb = (f32x2){0.f, 0.f}; if (2 * m + 1 < 31) wb = *(const f32x2*)(cw + (2 * m + 1) * 1024 + ch);
        wq0[m] = cvt_pk_bf16(wa.x, wb.x); wq1[m] = cvt_pk_bf16(wa.y, wb.y); }
    const f32x2 bb = *(const f32x2*)(cb + ch);
    const int s_in_batch0 = tok0 & (SEQ - 1);
    const char* cbase = (const char*)(C + (size_t)tok0 * DM); const unsigned voff = (unsigned)ch * 2u;
#define PAIR0_(lo, hi) __builtin_amdgcn_perm(hi, lo, 0x05040100u)
#define PAIR1_(lo, hi) __builtin_amdgcn_perm(hi, lo, 0x07060302u)
#define DOT2_(a, b, c) __builtin_amdgcn_fdot2_f32_bf16(__builtin_bit_cast(bf16x2_t, a), __builtin_bit_cast(bf16x2_t, b), c, false)
    unsigned p0[NP], p1[NP], raw[CT], wlast;
    { unsigned w[NP];
#pragma unroll
      for (int i = 0; i < NP; ++i) { const int rel = i - 30; unsigned u = 0u; if (s_in_batch0 + rel >= 0) u = *(const unsigned*)(cbase + (long)rel * (DM * 2) + voff); w[i] = u; }
#pragma unroll
      for (int i = 0; i < NP - 1; ++i) { p0[i] = PAIR0_(w[i], w[i + 1]); p1[i] = PAIR1_(w[i], w[i + 1]); }
      p0[NP - 1] = w[NP - 1] & 0xffffu; p1[NP - 1] = w[NP - 1] >> 16; wlast = w[NP - 1]; }
#pragma unroll 1
    for (int k = 0; k < 128 / CT; ++k) {
#pragma unroll
        for (int i = 0; i < CT; ++i) { float a0 = bb.x, a1 = bb.y;
#pragma unroll
            for (int m = 0; m < 16; ++m) { a0 = DOT2_(p0[i + 2 * m], wq0[m], a0); a1 = DOT2_(p1[i + 2 * m], wq1[m], a1); }
            *(LAS f32x2*)(tile + i * 1024 + ch) = (f32x2){a0, a1};
            if ((i & 3) == 3) __builtin_amdgcn_sched_barrier(0); }
        {
#pragma unroll
            for (int i = 0; i < 29; ++i) { p0[i] = p0[i + CT]; p1[i] = p1[i + CT]; }
            const int r0 = CT * (k + 1);
            unsigned vo = voff; asm volatile("" : "+v"(vo));
#pragma unroll
            for (int i = 0; i < CT; ++i) { int rr = r0 + i; if (tok0 + rr > MTOK - 1) rr = MTOK - 1 - tok0; raw[i] = *(const unsigned*)(cbase + (long)rr * (DM * 2) + vo); } }
        LDS_WAIT(); __syncthreads();
        int lane_n; asm volatile("v_mbcnt_lo_u32_b32 %0, -1, 0\n\tv_mbcnt_hi_u32_b32 %0, -1, %0" : "=v"(lane_n));
        {
            constexpr int TQ = CT / 8;
            f32x4 v[TQ][4], lg[4], lb[4]; float mean[TQ], rstd[TQ];
#pragma unroll
            for (int j = 0; j < 4; ++j) { lg[j] = *(const f32x4*)(lng + lane_n * 4 + 256 * j); lb[j] = *(const f32x4*)(lnb + lane_n * 4 + 256 * j); }
#pragma unroll
            for (int q = 0; q < TQ; ++q) { const int i = wave * TQ + q; float s = 0.f;
#pragma unroll
                for (int j = 0; j < 4; ++j) { v[q][j] = *(const LAS f32x4*)(tile + i * 1024 + lane_n * 4 + 256 * j); s += (v[q][j].x + v[q][j].y) + (v[q][j].z + v[q][j].w); }
                mean[q] = s; }
#pragma unroll
            for (int q = 0; q < TQ; ++q) mean[q] = wave_sum(mean[q]) * (1.f / 1024.f);
#pragma unroll
            for (int q = 0; q < TQ; ++q) { float s2 = 0.f;
#pragma unroll
                for (int j = 0; j < 4; ++j) { v[q][j] = v[q][j] - mean[q]; s2 += (v[q][j].x * v[q][j].x + v[q][j].y * v[q][j].y) + (v[q][j].z * v[q][j].z + v[q][j].w * v[q][j].w); }
                rstd[q] = s2; }
#pragma unroll
            for (int q = 0; q < TQ; ++q) rstd[q] = __builtin_amdgcn_rsqf(wave_sum(rstd[q]) * (1.f / 1024.f) + EPS);
#pragma unroll
            for (int q = 0; q < TQ; ++q) { const int i = wave * TQ + q; bf16* orow = OB + (size_t)(tok0 + CT * k + i) * DM;
#pragma unroll
                for (int j = 0; j < 4; ++j) { const int c0 = lane_n * 4 + 256 * j;
                    f32x4 y = v[q][j] * rstd[q] * lg[j] + lb[j]; y.x = siluf_(y.x); y.y = siluf_(y.y); y.z = siluf_(y.z); y.w = siluf_(y.w);
                    u32x2 w; w.x = pk2(y.x, y.y); w.y = pk2(y.z, y.w); *(u32x2*)(orow + c0) = w; } }
        }
#pragma unroll
        for (int i = 0; i < CT; ++i) asm volatile("" : "+v"(raw[i]));
        p0[29] = PAIR0_(wlast, raw[0]); p1[29] = PAIR1_(wlast, raw[0]);
#pragma unroll
        for (int i = 0; i < CT - 1; ++i) { p0[30 + i] = PAIR0_(raw[i], raw[i + 1]); p1[30 + i] = PAIR1_(raw[i], raw[i + 1]); }
        p0[NP - 1] = raw[CT - 1] & 0xffffu; p1[NP - 1] = raw[CT - 1] >> 16; wlast = raw[CT - 1];
        LDS_WAIT(); __syncthreads();
    }
#undef PAIR0_
#undef PAIR1_
#undef DOT2_
}

using pg8::Unit; using pg8::Ops; using pg8::Acc;
#define TBUF(ws, i) ((bf16*)((ws) + WS_T + (size_t)(i) * UB))
#define GBUF(ws, i) ((bf16*)((ws) + WS_G + (size_t)(i) * UB))
struct SchedP1 { int G, c; unsigned char* ws; unsigned char* out;
    __device__ __forceinline__ bool next(int i, Unit& u) const { const int L = i * G + c; if (L >= 3072 + 128) return false;
        if (L < 3072) { pg8::tile_order(L, 128, 24, u.pm, u.pn); u.kind = 0; } else if (L < 3136) { const int x = L - 3072; u.pm = x & 15; u.pn = x >> 4; u.kind = 1; } else { const int x = L - 3136; u.pm = x & 3; u.pn = x >> 2; u.kind = 2; } return true; }
    __device__ __forceinline__ void ops(const Unit& u, Ops& o) const { o.lda2 = 2048; o.ldb2 = 2048;
        const char* XN = (const char*)out + OUT_XN; const char* WIN = (const char*)ws + WS_WIN; const char* MN = (const char*)ws + WS_MN; const char* WMKV = (const char*)ws + WS_WMKV;
        if (u.kind == 0) { o.A = XN + (size_t)u.pm * 256 * 2048; o.B = WIN + (size_t)u.pn * 256 * 2048; }
        else if (u.kind == 1) { o.A = MN + (size_t)u.pm * 256 * 2048; o.B = WMKV + (size_t)u.pn * 256 * 2048; }
        else { o.A = WMKV + (size_t)(1024 + u.pm * 256) * 2048; o.B = MN + (size_t)u.pn * 256 * 2048; } }
};
struct EpiP1 { unsigned char* ws;
    __device__ __forceinline__ bool keep(const Unit&) const { return false; }
    __device__ __forceinline__ void operator()(const Acc& acc, const Unit& u, int wr, int wc, int fr, int fq, LAS unsigned char*) const {
        const int rl = wr * 64 + fr, cl = wc * 32 + 8 * fq;
        if (u.kind == 0) {
            const int pn = u.pn; const size_t row = (size_t)u.pm * 256 + rl;
            if (pn >= 12 && pn < 20) {
                bf16* base = GBUF(ws, 2) + row * DM + (pn - 12) * 128 + cl;
#pragma unroll
                for (int ai = 0; ai < 2; ++ai)
#pragma unroll
                    for (int m = 0; m < 4; ++m) { const f32x4 a0 = acc[ai][0][m][0], a1 = acc[ai][0][m][1], g0 = acc[ai][1][m][0], g1 = acc[ai][1][m][1]; float r[8];
#pragma unroll
                        for (int e = 0; e < 4; ++e) { r[e] = a0[e] * sigmoidf_(g0[e]); r[4 + e] = a1[e] * sigmoidf_(g1[e]); }
                        u32x4 w; w.x = cvt_pk_bf16(r[0], r[1]); w.y = cvt_pk_bf16(r[2], r[3]); w.z = cvt_pk_bf16(r[4], r[5]); w.w = cvt_pk_bf16(r[6], r[7]);
                        *(u32x4*)(base + (size_t)(ai * 128 + m * 16) * DM) = w; }
            } else {
                const int grp = pn < 12 ? (pn >> 2) : 3; const float sc = (grp == 0) ? C2A : 1.f; const int cc = (pn & 3) * 256;
                const size_t boff = (grp == 0) ? WS_T : (grp == 1) ? WS_G : (grp == 2) ? (WS_G + UB) : (WS_T + 2 * UB);
                pg8::store_plain(acc, (bf16*)(ws + boff) + row * DM + cc + cl, DM, sc);
            }
        } else if (u.kind == 1) pg8::store_plain(acc, (bf16*)(ws + WS_KM) + ((size_t)u.pm * 256 + rl) * 1024 + u.pn * 256 + cl, 1024, 1.f);
        else pg8::store_plain(acc, (bf16*)(ws + WS_VT) + ((size_t)u.pm * 256 + rl) * 4096 + u.pn * 256 + cl, 4096, 1.f);
    }
};
struct SchedX { int G, v; unsigned char* ws; unsigned char* out;
    __device__ __forceinline__ bool next(int i, Unit& u) const {
        const int cnt = (512 - v + G - 1) / G;
        if (i >= 2 * cnt) return false; const int j = i % cnt; u.kind = i / cnt; u.pm = v + j * G; u.pn = j & 1; return true; }
    __device__ __forceinline__ void ops(const Unit& u, Ops& o) const { const int p = u.pm, b = p >> 5, h = (p >> 3) & 3, qb = p & 7;
        if (u.kind == 0) { o.A = (const char*)TBUF(ws, 2) + ((size_t)(b * SEQ + qb * 256) * DM + h * 256) * 2; o.lda2 = 2048; o.B = (const char*)ws + WS_KM + ((size_t)(b * 256) * 1024 + h * 256) * 2; o.ldb2 = 2048; }
        else { o.A = (const char*)out + OUT_P + (size_t)p * 131072; o.lda2 = 512; o.B = (const char*)ws + WS_VT + ((size_t)(h * 256) * 4096 + b * 256) * 2; o.ldb2 = 8192; } }
};
struct EpiX { unsigned char* ws; unsigned char* out; size_t oc_redirect;
    __device__ __forceinline__ bool keep(const Unit&) const { return false; }
    __device__ __forceinline__ void operator()(const Acc& acc, const Unit& u, int wr, int wc, int fr, int fq, LAS unsigned char* ldst) const {
        const int rl = wr * 64 + fr, cl = wc * 32 + 8 * fq; const int p = u.pm;
        LAS float* lsum = (LAS float*)(ldst + (LSUM_OFF - RING_BYTES)) + u.pn * 1024;
        if (u.kind == 0) {
            bf16* base = (bf16*)(out + OUT_P) + (size_t)p * 65536 + (size_t)rl * 256 + cl;
#pragma unroll
            for (int ai = 0; ai < 2; ++ai)
#pragma unroll
                for (int m = 0; m < 4; ++m) { float rs = 0.f;
#pragma unroll
                    for (int bj = 0; bj < 2; ++bj) { const f32x4 v0 = acc[ai][bj][m][0], v1 = acc[ai][bj][m][1]; float e[8];
#pragma unroll
                        for (int k = 0; k < 4; ++k) { e[k] = __builtin_amdgcn_exp2f(v0[k] * C2X); e[4 + k] = __builtin_amdgcn_exp2f(v1[k] * C2X); }
                        u32x4 w; w.x = cvt_pk_bf16(e[0], e[1]); w.y = cvt_pk_bf16(e[2], e[3]); w.z = cvt_pk_bf16(e[4], e[5]); w.w = cvt_pk_bf16(e[6], e[7]);
                        rs += (bflo(w.x) + bfhi(w.x)) + (bflo(w.y) + bfhi(w.y)) + (bflo(w.z) + bfhi(w.z)) + (bflo(w.w) + bfhi(w.w));
                        *(u32x4*)(base + (size_t)(ai * 128 + m * 16) * 256 + bj * 128) = w; }
                    rs += __shfl_xor(rs, 16); rs += __shfl_xor(rs, 32);
                    if (fq == 0) lsum[(ai * 128 + m * 16 + rl) * 4 + wc] = rs; }
        } else {
            const int b = p >> 5, h = (p >> 3) & 3, qb = p & 7;
            bf16* base = (bf16*)((unsigned char*)TBUF(ws, 2) + oc_redirect) + ((size_t)(b * SEQ + qb * 256) + rl) * DM + h * 256 + cl;
#pragma unroll
            for (int ai = 0; ai < 2; ++ai)
#pragma unroll
                for (int m = 0; m < 4; ++m) { const f32x4 l4 = *(const LAS f32x4*)(lsum + (ai * 128 + m * 16 + rl) * 4); const float rcp = __builtin_amdgcn_rcpf((l4.x + l4.y) + (l4.z + l4.w));
#pragma unroll
                    for (int bj = 0; bj < 2; ++bj) { const f32x4 v0 = acc[ai][bj][m][0] * rcp, v1 = acc[ai][bj][m][1] * rcp;
                        u32x4 w; w.x = cvt_pk_bf16(v0[0], v0[1]); w.y = cvt_pk_bf16(v0[2], v0[3]); w.z = cvt_pk_bf16(v1[0], v1[1]); w.w = cvt_pk_bf16(v1[2], v1[3]);
                        *(u32x4*)(base + (size_t)(ai * 128 + m * 16) * DM + bj * 128) = w; } }
        }
    }
};
struct SchedP3 { int G, c; unsigned char* ws; unsigned char* out;
    __device__ __forceinline__ bool next(int i, Unit& u) const { const int L = i * G + c; if (L >= 3072) return false; pg8::tile_order(L, 128, 24, u.pm, u.pn); u.kind = 0; return true; }
    __device__ __forceinline__ void ops(const Unit& u, Ops& o) const { o.lda2 = 2048; o.ldb2 = 2048; o.A = (const char*)out + OUT_XN + (size_t)u.pm * 256 * 2048; o.B = (const char*)ws + WS_WIN + (size_t)(6144 + u.pn * 256) * 2048; }
};
struct EpiP3 { unsigned char* ws; const float* bmerge; int rep;
    __device__ __forceinline__ bool keep(const Unit&) const { return false; }
    __device__ __forceinline__ void operator()(const Acc& acc, const Unit& u, int wr, int wc, int fr, int fq, LAS unsigned char*) const {
        const int rl = wr * 64 + fr, cl = wc * 32 + 8 * fq; const int pn = u.pn; const size_t row = (size_t)u.pm * 256 + rl;
        if (pn < 12) {
            bf16* T = TBUF(ws, pn >> 2) + row * DM + (pn & 3) * 256 + cl;
            bf16* Tw = rep ? (bf16*)(ws + WS_END) + (row * DM + (pn & 3) * 256 + cl) : T;
#define O2_(c) ((size_t)(((c) >> 3) * 128 + (((c) >> 1) & 3) * 16) * DM + ((c) & 1) * 128)
            u32x4 oq[16];
#pragma unroll
            for (int c = 0; c < 16; ++c) oq[c] = *(const u32x4*)(T + O2_(c));
            asm volatile("" ::: "memory");
#pragma unroll
            for (int c = 0; c < 16; ++c) { const int ai = c >> 3, m = (c >> 1) & 3, bj = c & 1;
                const u32x4 o = oq[c];
                const f32x4 z0 = acc[ai][bj][m][0], z1 = acc[ai][bj][m][1];
                u32x4 w; w.x = cvt_pk_bf16(bflo(o.x) * siluf_(z0[0]), bfhi(o.x) * siluf_(z0[1])); w.y = cvt_pk_bf16(bflo(o.y) * siluf_(z0[2]), bfhi(o.y) * siluf_(z0[3]));
                w.z = cvt_pk_bf16(bflo(o.z) * siluf_(z1[0]), bfhi(o.z) * siluf_(z1[1])); w.w = cvt_pk_bf16(bflo(o.w) * siluf_(z1[2]), bfhi(o.w) * siluf_(z1[3]));
                *(u32x4*)(Tw + O2_(c)) = w; asm volatile("" ::: "memory"); }
#undef O2_
        } else {
            const int gi = (pn - 12) >> 2, cc = ((pn - 12) & 3) * 256 + cl;
            bf16* Gp = GBUF(ws, gi) + row * DM + cc; const float* bp = bmerge + gi * 1024 + cc;
            const f32x4 b00 = *(const f32x4*)(bp), b01 = *(const f32x4*)(bp + 4), b10 = *(const f32x4*)(bp + 128), b11 = *(const f32x4*)(bp + 132);
#pragma unroll
            for (int ai = 0; ai < 2; ++ai)
#pragma unroll
                for (int m = 0; m < 4; ++m)
#pragma unroll
                    for (int bj = 0; bj < 2; ++bj) { const f32x4 v0 = acc[ai][bj][m][0] + (bj ? b10 : b00), v1 = acc[ai][bj][m][1] + (bj ? b11 : b01);
#define SG_(x) __builtin_bit_cast(float, max(__builtin_bit_cast(unsigned, sigmoidf_(x)), 0x0DA24260u))
                        u32x4 w; w.x = cvt_pk_bf16(SG_(v0[0]), SG_(v0[1])); w.y = cvt_pk_bf16(SG_(v0[2]), SG_(v0[3])); w.z = cvt_pk_bf16(SG_(v1[0]), SG_(v1[1])); w.w = cvt_pk_bf16(SG_(v1[2]), SG_(v1[3]));
#undef SG_
                        *(u32x4*)(Gp + (size_t)(ai * 128 + m * 16) * DM + bj * 128) = w; }
        }
    }
};
struct SchedP4 { int G, v; unsigned char* ws;
    __device__ __forceinline__ bool next(int i, Unit& u) const { const int tile = v + (i / 3) * G; if (tile >= 512) return false; u.pm = tile >> 2; u.pn = tile & 3; u.kind = i % 3; return true; }
    __device__ __forceinline__ void ops(const Unit& u, Ops& o) const { o.lda2 = 2048; o.ldb2 = 2048;
        o.A = (const char*)TBUF(ws, u.kind) + (size_t)u.pm * 256 * 2048; o.B = (const char*)ws + WS_WOA + (size_t)u.kind * (2 * MiB) + (size_t)u.pn * 256 * 2048; }
};
struct EpiP4 { unsigned char* ws; unsigned char* out;
    __device__ __forceinline__ bool keep(const Unit&) const { return true; }
    static __device__ __forceinline__ float gc(float g) { return g; }
    __device__ __forceinline__ void operator()(Acc& acc, const Unit& u, int wr, int wc, int fr, int fq, LAS unsigned char*) const {
        const int rl = wr * 64 + fr, cl = wc * 32 + 8 * fq; const size_t off = ((size_t)u.pm * 256 + rl) * DM + u.pn * 256 + cl;
        const bool lastb = u.kind == 2;
        const bf16* Ga = GBUF(ws, u.kind) + off; const bf16* Gb = GBUF(ws, lastb ? 2 : u.kind + 1) + off; bf16* Op = (bf16*)(out + OUT_P) + off;
        const float keepf = lastb ? 0.f : 1.f;
#define R_(a, b) (gc(a) * (lastb ? 1.f : __builtin_amdgcn_rcpf(gc(b))))
#define O2_(c) ((size_t)(((c) >> 3) * 128 + (((c) >> 1) & 3) * 16) * DM + ((c) & 1) * 128)
        constexpr int PD = 4;
        u32x4 gaq[PD], gbq[PD];
#pragma unroll
        for (int c = 0; c < PD; ++c) { gaq[c] = *(const u32x4*)(Ga + O2_(c)); gbq[c] = *(const u32x4*)(Gb + O2_(c)); }
#pragma unroll
        for (int c = 0; c < 16; ++c) { const int ai = c >> 3, m = (c >> 1) & 3, bj = c & 1;
            const u32x4 ga = gaq[c % PD], gb = gbq[c % PD];
            asm volatile("" :: "v"(ga), "v"(gb) : "memory");
            if (c + PD < 16) { gaq[c % PD] = *(const u32x4*)(Ga + O2_(c + PD)); gbq[c % PD] = *(const u32x4*)(Gb + O2_(c + PD)); }
            const f32x4 r0 = {R_(bflo(ga.x), bflo(gb.x)), R_(bfhi(ga.x), bfhi(gb.x)), R_(bflo(ga.y), bflo(gb.y)), R_(bfhi(ga.y), bfhi(gb.y))};
            const f32x4 r1 = {R_(bflo(ga.z), bflo(gb.z)), R_(bfhi(ga.z), bfhi(gb.z)), R_(bflo(ga.w), bflo(gb.w)), R_(bfhi(ga.w), bfhi(gb.w))};
            const f32x4 v0 = acc[ai][bj][m][0] * r0, v1 = acc[ai][bj][m][1] * r1;
            if (lastb) { u32x4 w; w.x = cvt_pk_bf16(v0[0], v0[1]); w.y = cvt_pk_bf16(v0[2], v0[3]); w.z = cvt_pk_bf16(v1[0], v1[1]); w.w = cvt_pk_bf16(v1[2], v1[3]); *(u32x4*)(Op + O2_(c)) = w; }
            acc[ai][bj][m][0] = v0 * keepf; acc[ai][bj][m][1] = v1 * keepf; asm volatile("" : "+v"(acc[ai][bj][m][0]), "+v"(acc[ai][bj][m][1])); }
#undef O2_
#undef R_
    }
};
struct SchedP5 { int G, v; unsigned char* ws; unsigned char* out;
    __device__ __forceinline__ bool next(int i, Unit& u) const { const int tile = v + i * G; if (tile >= 512) return false; u.pm = tile >> 2; u.pn = tile & 3; u.kind = 0; return true; }
    __device__ __forceinline__ void ops(const Unit& u, Ops& o) const { o.lda2 = 2048; o.ldb2 = 2048; o.A = (const char*)out + OUT_P + (size_t)u.pm * 256 * 2048; o.B = (const char*)ws + WS_WOUT + (size_t)u.pn * 256 * 2048; }
};
struct EpiP5 { unsigned char* ws;
    __device__ __forceinline__ bool keep(const Unit&) const { return false; }
    __device__ __forceinline__ void operator()(const Acc& acc, const Unit& u, int wr, int wc, int fr, int fq, LAS unsigned char*) const {
        const int rl = wr * 64 + fr, cl = wc * 32 + 8 * fq; const size_t row0 = (size_t)u.pm * 256 + rl;
        pg8::store_plain(acc, TBUF(ws, 0) + row0 * DM + u.pn * 256 + cl, DM, 1.f);
        float* rsq = (float*)TBUF(ws, 1);
#pragma unroll
        for (int ai = 0; ai < 2; ++ai)
#pragma unroll
            for (int m = 0; m < 4; ++m) { float ss = 0.f;
#pragma unroll
                for (int bj = 0; bj < 2; ++bj)
#pragma unroll
                    for (int n = 0; n < 2; ++n) { const f32x4 v = acc[ai][bj][m][n]; ss += (v[0] * v[0] + v[1] * v[1]) + (v[2] * v[2] + v[3] * v[3]); }
                ss += __shfl_xor(ss, 16); ss += __shfl_xor(ss, 32);
                if (fq == 0) rsq[(row0 + ai * 128 + m * 16) * 16 + u.pn * 4 + wc] = ss; }
    }
};

#ifndef PHMASK
#define PHMASK 0x77f
#endif
#ifndef REPMASK
#define REPMASK 0
#endif
#define REP(k) (((REPMASK >> (k)) & 1) ? 2 : 1)
#ifndef ATT_V2
#define ATT_V2 2
#endif
#ifndef NOFALLBACK
#define NOFALLBACK 0
#endif

#define TD_BEGIN(k) unsigned long long td0_##k = 0; if (TIMEDUP == (k)) td0_##k = __builtin_amdgcn_s_memrealtime();
#define TD_END(k) if (TIMEDUP == (k)) { const unsigned long long td1 = __builtin_amdgcn_s_memrealtime(); const unsigned long long until = td1 + (td1 - td0_##k); while (__builtin_amdgcn_s_memrealtime() < until) __builtin_amdgcn_s_sleep(8); }
__global__ void __launch_bounds__(512, 2) mk_fwd(Args args) {
    extern __shared__ __attribute__((aligned(16))) unsigned char lds[];
    Frame F;
    F.lds = (LAS unsigned char*)lds;
    F.tid = threadIdx.x; F.lane = F.tid & 63; F.wave = __builtin_amdgcn_readfirstlane(F.tid >> 6);
    F.G = gridDim.x; { const int bx = blockIdx.x; F.vcu = (F.G % 8 == 0) ? (bx % 8) * (F.G / 8) + bx / 8 : bx; }
    F.out = args.out; F.ws = args.ws;
    unsigned char* ws = args.ws; unsigned char* outb = (unsigned char*)args.out;
    gu32* ctl = (gu32*)(ws + WS_CTL);
    for (int u = F.tid; u < (LDS_BYTES - LDSCTL_OFF) / 4; u += 512) ((LAS unsigned*)(F.lds + LDSCTL_OFF))[u] = 0u;
    __syncthreads();
    volatile LAS unsigned* MISC = (volatile LAS unsigned*)(F.lds + MISC_OFF);
    XcdBarrier bar; bar.bar = (unsigned*)(ctl + CW_BAR); bar.x = 0; bar.st = nullptr;
    if (MK_N_LAUNCHES == 1) bar = xcd_barrier_post((unsigned*)(ctl + CW_BAR), MISC + 8);
    const int lo = args.ph_lo, hi = args.ph_hi;
#define IN(k) (((PHMASK >> (k)) & 1) && lo <= (k) && (k) < hi)
#define SEAM(k) do { if (lo <= (k) && (k) + 1 < hi) xcd_barrier(bar); } while (0)

    { TD_BEGIN(0) if (IN(0)) { for (int rep = 0; rep < REP(0); ++rep) p0_prologue(F); } TD_END(0) }
    { TD_BEGIN(10) SEAM(0); TD_END(10) }
    TD_BEGIN(1)
    if (IN(1)) {
        SchedP1 S{F.G, (int)blockIdx.x, ws, outb}; EpiP1 E{ws};
        for (int rep = 0; rep < REP(1); ++rep) pg8::gemm_phase(F.lds, 16, S, E);
        if (F.G == 256 && blockIdx.x >= 128) p0_transposes(F, true, ((int)blockIdx.x - 128) * 8 + F.wave, 128 * 8);
        else if (F.G != 256) p0_transposes(F, true, F.vcu * 8 + F.wave, F.G * 8);
    }
    TD_END(1)
    { TD_BEGIN(11) SEAM(1); TD_END(11) }
    if (IN(2)) {
        TD_BEGIN(7)
        if ((PHMASK >> 8) & 1) { for (int rep = 0; rep < REP(7); ++rep) { SchedX S{F.G, F.vcu, ws, outb}; EpiX E{ws, outb, rep ? (size_t)(WS_END - (WS_T + 2 * UB)) : (size_t)0}; pg8::gemm_phase(F.lds, 4, S, E); } }
        TD_END(7)
        TD_BEGIN(8)
        if ((PHMASK >> 9) & 1) {
            const float* lq1 = INP(I_LQ1); const float* lk1 = INP(I_LK1); const float* lq2 = INP(I_LQ2); const float* lk2 = INP(I_LK2);
            const float s1 = wave_sum(lq1[F.lane] * lk1[F.lane]), s2 = wave_sum(lq2[F.lane] * lk2[F.lane]);
            const float lam = expf(s1) - expf(s2) + 0.2f;
            const float* tab = INP(I_RELB); const float* gsub = INP(I_GSUB);
            for (int rep = 0; rep < REP(2); ++rep)
            for (int v = F.vcu; v < 256; v += F.G) {
                const int bh = v >> 1, s = v & 1;
                bool pref = false, tabok = false; bf16x8 qr[4];
                for (int i = 0; i < 4; ++i) { const int qb = (i == 0) ? s : (i == 1) ? 3 - s : (i == 2) ? 4 + s : 7 - s; const int qbn = (i == 0) ? 3 - s : (i == 1) ? 4 + s : (i == 2) ? 7 - s : -1;
                    bf16* Od = rep ? (bf16*)(ws + WS_END) : TBUF(ws, 0);
                    bool redo = (ATT_V2 == 0);
                    if (ATT_V2 != 0) for (int attempt = 0; attempt < 2; ++attempt) {
                        redo = att3::attn_unit(bh >> 3, bh & 7, qb, qbn, !pref || attempt > 0, !tabok, qr, TBUF(ws, 0), GBUF(ws, 0), GBUF(ws, 1), Od, tab, gsub, lam, F.lds);
                        tabok = true;
                        if (!redo || NOFALLBACK) break; }
                    pref = qbn >= 0;
                    if (redo && NOFALLBACK == 0) {
                        asm volatile("s_waitcnt vmcnt(0) lgkmcnt(0)\n\ts_barrier" ::: "memory");
                        att::attn_unit(bh >> 3, bh & 7, qb, TBUF(ws, 0), GBUF(ws, 0), GBUF(ws, 1), Od, tab, gsub, lam, F.lds); pref = false; tabok = false; } }
            }
        }
        __syncthreads();
        TD_END(8)
        TD_BEGIN(9)
        if ((PHMASK >> 10) & 1) for (int rep = 0; rep < REP(8); ++rep) for (int v = F.vcu; v < 256; v += F.G) conv_unit(F, v * 128, GBUF(ws, 2), TBUF(ws, 1));
        TD_END(9)
    }
    { TD_BEGIN(12) SEAM(2); TD_END(12) }
    TD_BEGIN(3)
    if (IN(3)) {
        for (int rep = 0; rep < REP(3); ++rep) { SchedP3 S{F.G, (int)blockIdx.x, ws, outb}; EpiP3 E{ws, INP(I_BMERGE), rep};
        pg8::gemm_phase(F.lds, 16, S, E); }
    }
    TD_END(3)
    { TD_BEGIN(13) SEAM(3); TD_END(13) }
    TD_BEGIN(4)
    if (IN(4)) {
        SchedP4 S{F.G, F.vcu, ws}; EpiP4 E{ws, outb};
        for (int rep = 0; rep < REP(4); ++rep) pg8::gemm_phase(F.lds, 16, S, E);
    }
    TD_END(4)
    { TD_BEGIN(14) SEAM(4); TD_END(14) }
    TD_BEGIN(5)
    if (IN(5)) {
        SchedP5 S{F.G, F.vcu, ws, outb}; EpiP5 E{ws};
        for (int rep = 0; rep < REP(5); ++rep) pg8::gemm_phase(F.lds, 16, S, E);
    }
    TD_END(5)
    { TD_BEGIN(15) SEAM(5); TD_END(15) }
    if (IN(6)) {
        const int t6 = fresh_tid(), lane6 = t6 & 63; const int gw = F.vcu * 8 + __builtin_amdgcn_readfirstlane(t6 >> 6), NGW = F.G * 8;
        const float* gp = INP(I_GPOST); const float* xin = INP(I_X); const float* RSQ = (const float*)TBUF(ws, 1); const bf16* Yb = TBUF(ws, 0);
        for (int rep = 0; rep < REP(6); ++rep)
        for (int m = gw; m < MTOK; m += NGW) {
            float ss = (lane6 < 16) ? RSQ[(size_t)m * 16 + lane6] : 0.f;
            ss = wave_sum(ss);
            const float rstd = 1.f / sqrtf(ss * (1.f / 1024.f) + EPS);
            const bf16* yr = Yb + (size_t)m * DM; const float* xr = xin + (size_t)m * DM; float* orow = F.out + (size_t)m * DM;
#pragma unroll
            for (int j = 0; j < 4; ++j) { const int c0 = lane6 * 4 + 256 * j; const u32x2 yw = *(const u32x2*)(yr + c0); const f32x4 xv = *(const f32x4*)(xr + c0), g = *(const f32x4*)(gp + c0);
                f32x4 o; o.x = xv.x + bflo(yw.x) * rstd * g.x; o.y = xv.y + bfhi(yw.x) * rstd * g.y; o.z = xv.z + bflo(yw.y) * rstd * g.z; o.w = xv.w + bfhi(yw.y) * rstd * g.w;
                *(f32x4*)(orow + c0) = o; }
        }
    }
#ifndef DUMP
#define DUMP 0
#endif
    if (DUMP == 13 && lo <= 8 && 8 < hi) {
        const int t8 = fresh_tid();
        for (size_t i = (size_t)blockIdx.x * 512 + t8; i < (size_t)MTOK * DM / 2; i += (size_t)gridDim.x * 512) ((unsigned*)TBUF(ws, 1))[i] = ((const unsigned*)(outb + OUT_P))[i];
    }
    if (DUMP && MK_N_LAUNCHES == 1) xcd_barrier(bar);
    if (DUMP && ((lo <= 7 && 7 < hi) || MK_N_LAUNCHES == 1)) {
        const int t7 = fresh_tid();
        for (size_t i = (size_t)blockIdx.x * 512 + t7; i < (size_t)MTOK * DM / 2; i += (size_t)gridDim.x * 512) {
            float a = 0.f, b = 0.f;
#define ADDB(ptr) do { const unsigned w = ((const unsigned*)(ptr))[i]; a += bflo(w); b += bfhi(w); } while (0)
            if (DUMP == 1) { ADDB(TBUF(ws, 0)); ADDB(TBUF(ws, 2)); ADDB(GBUF(ws, 0)); ADDB(GBUF(ws, 1)); ADDB(GBUF(ws, 2)); const unsigned w = ((const unsigned*)(ws + WS_KM))[i & (4096 * 512 - 1)]; a += bflo(w); b += bfhi(w); const unsigned w2 = ((const unsigned*)(ws + WS_VT))[i & (4096 * 512 - 1)]; a += bflo(w2); b += bfhi(w2); }
            if (DUMP == 2) { ADDB(TBUF(ws, 0)); ADDB(TBUF(ws, 1)); ADDB(TBUF(ws, 2)); }
            if (DUMP == 3) { ADDB(TBUF(ws, 0)); ADDB(TBUF(ws, 1)); ADDB(TBUF(ws, 2)); ADDB(GBUF(ws, 0)); ADDB(GBUF(ws, 1)); ADDB(GBUF(ws, 2)); }
            if (DUMP == 4) { ADDB(ws + WS_G + 2 * UB - 0); }
            if (DUMP == 5) { ADDB(TBUF(ws, 0)); }
            if (DUMP == 10) { ADDB(TBUF(ws, 0)); }
            if (DUMP == 11 || DUMP == 13) { ADDB(TBUF(ws, 1)); }
            if (DUMP == 12) { ADDB(TBUF(ws, 2)); }
            ((f32x2*)F.out)[i] = (f32x2){a, b};
        }
    }
#undef IN
#undef SEAM
}

extern "C" void kernel_launch(void* const* d_in, const int* in_sizes, int n_in, void* d_out, int out_size, void* d_ws, size_t ws_size, hipStream_t stream) {
    static int grid = 0;
    if (grid == 0) {
        if (n_in != 22 || in_sizes[0] != MTOK * DM || out_size != MTOK * DM || ws_size < WS_END + (REPMASK ? UB : 0)) { fprintf(stderr, "kernel_launch: unexpected shapes / workspace (n_in %d, ws %zu, need %zu)\n", n_in, ws_size, (size_t)WS_END); grid = -1; return; }
        int dev = 0, cus = 0;
        if (hipGetDevice(&dev) != hipSuccess || hipDeviceGetAttribute(&cus, hipDeviceAttributeMultiprocessorCount, dev) != hipSuccess) { grid = -1; return; }
        if (hipFuncSetAttribute((const void*)mk_fwd, hipFuncAttributeMaxDynamicSharedMemorySize, LDS_BYTES) != hipSuccess) { fprintf(stderr, "kernel_launch: hipFuncSetAttribute failed\n"); grid = -1; return; }
        int per_cu = 0;
        if (hipOccupancyMaxActiveBlocksPerMultiprocessor(&per_cu, (const void*)mk_fwd, 512, LDS_BYTES) != hipSuccess || per_cu < 1) fprintf(stderr, "kernel_launch: occupancy query says %d\n", per_cu);
        (void)hipGetLastError();
        grid = cus > 256 ? 256 : cus;
    }
    if (grid < 0) return;
    (void)hipMemsetAsync((char*)d_ws + WS_CTL, 0, CTL_ZERO_BYTES, stream);
    Args a{};
    for (int i = 0; i < 22; ++i) a.in[i] = (const float*)d_in[i];
    a.out = (float*)d_out; a.ws = (unsigned char*)d_ws;
    if (MK_N_LAUNCHES == 1) { a.ph_lo = 0; a.ph_hi = DUMP ? (DUMP >= 10 ? 3 : DUMP + 1) : N_PHASES; hipLaunchKernelGGL(mk_fwd, dim3(grid), dim3(512), LDS_BYTES, stream, a); }
    else { const int np = DUMP ? (DUMP >= 10 ? 3 : DUMP + 1) : N_PHASES;
        for (int p = 0; p < np; ++p) { a.ph_lo = p; a.ph_hi = p + 1; hipLaunchKernelGGL(mk_fwd, dim3(grid), dim3(512), LDS_BYTES, stream, a); }
        if (DUMP == 13) { a.ph_lo = 8; a.ph_hi = 9; hipLaunchKernelGGL(mk_fwd, dim3(grid), dim3(512), LDS_BYTES, stream, a); }
        if (DUMP) { a.ph_lo = 7; a.ph_hi = 8; hipLaunchKernelGGL(mk_fwd, dim3(grid), dim3(512), LDS_BYTES, stream, a); } }
}
```

```cpp
#include <hip/hip_runtime.h>
#ifndef BADTEST
#define BADTEST 0
#endif
#include <cstdio>
#include <cstdint>

#define LAS __attribute__((address_space(3)))
#define GAS __attribute__((address_space(1)))
typedef unsigned short bf16;
typedef short bf16x8 __attribute__((ext_vector_type(8)));
typedef short s16x4 __attribute__((ext_vector_type(4)));
typedef float f32x4 __attribute__((ext_vector_type(4)));
typedef float f32x2 __attribute__((ext_vector_type(2)));
typedef float f32x16 __attribute__((ext_vector_type(16)));
typedef unsigned u32x4 __attribute__((ext_vector_type(4)));
typedef unsigned u32x2 __attribute__((ext_vector_type(2)));
typedef GAS unsigned gu32;

#ifndef MK_N_LAUNCHES
#define MK_N_LAUNCHES 1
#endif
constexpr int N_PHASES = 7;

constexpr int BATCH = 16, SEQ = 2048, DM = 1024, MTOK = BATCH * SEQ;
constexpr int NMEM = 256, MMEM = BATCH * NMEM;
constexpr int INW = 12288;
constexpr float EPS = 1e-6f;
constexpr float LOG2E = 1.4426950408889634f;
constexpr float C2A = 0.125f * LOG2E;
constexpr float C2X = 0.0625f * LOG2E;
constexpr int NREL = 2112;

constexpr size_t MiB = 1u << 20;
constexpr size_t WS_CTL = 0, CTL_ZERO_BYTES = 1 * MiB;
constexpr size_t WS_WIN = 2 * MiB;
constexpr size_t WS_WOA = 26 * MiB, WS_WOB = 28 * MiB, WS_WOC = 30 * MiB, WS_WOUT = 32 * MiB;
constexpr size_t WS_WMKV = 34 * MiB;
constexpr size_t WS_MN = 38 * MiB;
constexpr size_t WS_KM = 46 * MiB;
constexpr size_t WS_VT = 54 * MiB;
constexpr size_t WS_U0 = 64 * MiB, UB = 64 * MiB;
constexpr size_t WS_T = WS_U0 + 0 * UB;
constexpr size_t WS_G = WS_U0 + 3 * UB;
constexpr size_t WS_END = WS_U0 + 6 * UB;
constexpr size_t OUT_XN = 0, OUT_P = 64 * MiB;

constexpr int CW_TMO = 0;
constexpr int CW_BAR = 4096;

constexpr int RING_BYTES = 131072;
constexpr int LDS_BYTES = 163840;
constexpr int LDSCTL_OFF = LDS_BYTES - 512, MISC_OFF = LDSCTL_OFF + 320;
constexpr int LSUM_OFF = LDSCTL_OFF - 8192;
constexpr int PHASE_LDS = LSUM_OFF;

__device__ __forceinline__ int fresh_tid() { int t = threadIdx.x; asm volatile("" : "+v"(t)); return t; }
#define LDS_WAIT() asm volatile("s_waitcnt lgkmcnt(0)" ::: "memory")
#define VM_WAIT() asm volatile("s_waitcnt vmcnt(0)" ::: "memory")
#define RLX_AGENT __ATOMIC_RELAXED, __HIP_MEMORY_SCOPE_AGENT

__device__ __forceinline__ unsigned f2bf(float f) { unsigned u = __builtin_bit_cast(unsigned, f); return (u + 0x7fffu + ((u >> 16) & 1u)) >> 16; }
__device__ __forceinline__ unsigned pk2(float lo, float hi) { return f2bf(lo) | (f2bf(hi) << 16); }
typedef __bf16 bf16x2_t __attribute__((ext_vector_type(2)));
__device__ __forceinline__ unsigned cvt_pk_bf16(float lo, float hi) { f32x2 v = {lo, hi}; bf16x2_t b = __builtin_convertvector(v, bf16x2_t); return __builtin_bit_cast(unsigned, b); }
__device__ __forceinline__ float bflo(unsigned w) { return __uint_as_float(w << 16); }
__device__ __forceinline__ float bfhi(unsigned w) { return __uint_as_float(w & 0xffff0000u); }
__device__ __forceinline__ float sigmoidf_(float v) { return __builtin_amdgcn_rcpf(1.0f + __builtin_amdgcn_exp2f(-v * LOG2E)); }
__device__ __forceinline__ float siluf_(float v) { return v * sigmoidf_(v); }
__device__ __forceinline__ float wave_sum(float v) {
#define DPP_(ctrl) v += __builtin_bit_cast(float, __builtin_amdgcn_update_dpp(0, __builtin_bit_cast(int, v), ctrl, 0xf, 0xf, true))
    DPP_(0xB1); DPP_(0x4E); DPP_(0x141); DPP_(0x140);
#undef DPP_
    const int b = __builtin_bit_cast(int, v);
    return (__builtin_bit_cast(float, __builtin_amdgcn_readlane(b, 0)) + __builtin_bit_cast(float, __builtin_amdgcn_readlane(b, 16))) + (__builtin_bit_cast(float, __builtin_amdgcn_readlane(b, 32)) + __builtin_bit_cast(float, __builtin_amdgcn_readlane(b, 48)));
}

__device__ __forceinline__ int t5_bucket(int rel) {
    const int n = rel < 0 ? -rel : rel; int v;
    if (n < 8) v = n; else if (n < 12) v = 8; else if (n < 16) v = 9; else if (n < 23) v = 10; else if (n < 32) v = 11; else if (n < 46) v = 12; else if (n < 64) v = 13; else if (n < 91) v = 14; else v = 15;
    return (rel > 0 ? 16 : 0) + v;
}

#ifndef TIMEDUP
#define TIMEDUP -1
#endif
namespace pg8 {
constexpr int BM = 256, BK = 64, HALF = 128, HTB = HALF * BK * 2, NXCD = 8, WGM = 2;
__host__ __device__ __forceinline__ int lds_byte(int r, int c) { const int st = (r >> 4) * 2 + (c >> 5), rr = r & 15, cc = c & 31, ob = rr * 64 + cc * 2; return st * 1024 + (ob ^ (((ob >> 9) & 1) << 5)); }
__host__ __device__ __forceinline__ void stage_rc(int b, int& R, int& C) { const int st = b / 1024, sb = b % 1024, swz = sb ^ (((sb >> 9) & 1) << 5); R = (st >> 1) * 16 + swz / 64; C = (st & 1) * 32 + (swz % 64) / 2; }
__host__ __device__ __forceinline__ int perm32(int rho) { const int n = rho >> 4, i = rho & 15; return 8 * (i >> 2) + 4 * n + (i & 3); }

struct Unit { int pm, pn, kind; };
struct Ops { const char* A; const char* B; unsigned lda2, ldb2; };

__device__ __forceinline__ void tile_order(int L, int nM, int nN, int& pm, int& pn) {
    const int nwg = nM * nN; int wgid = L;
    { const int q = nwg / NXCD, r = nwg % NXCD, xcd = wgid % NXCD, off = wgid / NXCD; wgid = (xcd < r ? xcd * (q + 1) : r * (q + 1) + (xcd - r) * q) + off; }
    const int nig = WGM * nN, gid = wgid / nig, fm = gid * WGM, gsz = (nM - fm) < WGM ? (nM - fm) : WGM;
    pm = fm + ((wgid % nig) % gsz); pn = (wgid % nig) / gsz;
}

template <class Epi, class Sched>
__device__ __forceinline__ void gemm_phase(LAS unsigned char* lds, const int nt, const Sched& S, const Epi& E) {
    const int tid = fresh_tid(), wid = __builtin_amdgcn_readfirstlane(tid >> 6), lane = tid & 63, wr = wid >> 2, wc = wid & 3, fr = lane & 15, fq = lane >> 4;
    int sR[2], sRb[2], sC2[2];
#pragma unroll
    for (int i = 0; i < 2; ++i) { int R, C; stage_rc(tid * 16 + i * 8192, R, C); sR[i] = R; sRb[i] = (R & ~31) + perm32(R & 31); sC2[i] = C * 2; }
    const size_t kstep = (size_t)(BK * 2);
    const unsigned ldsw = (unsigned)wid * 1024u;
    const int aoff = lds_byte(wr * 64 + fr, fq * 8), boff = lds_byte(wc * 32 + fr, fq * 8);
#define PG8_SA(b, h) (((b) * 2 + (h)) * HTB)
#define PG8_SB(b, h) ((4 + (b) * 2 + (h)) * HTB)
#define PG8_STAGE(bufoff, gbase, v0, v1) do { \
        __builtin_amdgcn_global_load_lds((const unsigned*)((const char*)(gbase) + (v0)), (LAS unsigned*)(lds + (bufoff) + ldsw), 16, 0, 0); \
        __builtin_amdgcn_global_load_lds((const unsigned*)((const char*)(gbase) + (v1)), (LAS unsigned*)(lds + (bufoff) + ldsw + 8192), 16, 0, 0); } while (0)
#define PG8_LDA(dst, b, h) do { _Pragma("unroll") for (int m = 0; m < 4; ++m) _Pragma("unroll") for (int k = 0; k < 2; ++k) dst[m][k] = *(const LAS bf16x8*)(lds + PG8_SA(b, h) + aoff + m * 2048 + k * 1024); } while (0)
#define PG8_LDB(dst, b, h) do { _Pragma("unroll") for (int n = 0; n < 2; ++n) _Pragma("unroll") for (int k = 0; k < 2; ++k) dst[n][k] = *(const LAS bf16x8*)(lds + PG8_SB(b, h) + boff + n * 2048 + k * 1024); } while (0)
#define PG8_MMA(ai, bj, At, Bt) do { __builtin_amdgcn_s_setprio(1); _Pragma("unroll") for (int m = 0; m < 4; ++m) _Pragma("unroll") for (int n = 0; n < 2; ++n) _Pragma("unroll") for (int k = 0; k < 2; ++k) \
        acc[ai][bj][m][n] = __builtin_amdgcn_mfma_f32_16x16x32_bf16(Bt[n][k], At[m][k], acc[ai][bj][m][n], 0, 0, 0); __builtin_amdgcn_s_setprio(0); } while (0)
#define PG8_WAIT_V(n) asm volatile("s_waitcnt vmcnt(" #n ")" ::: "memory")
#define PG8_WAIT_L(n) asm volatile("s_waitcnt lgkmcnt(" #n ")" ::: "memory")
#define PG8_BAR __builtin_amdgcn_s_barrier()
#define PG8_SCHED __builtin_amdgcn_sched_barrier(0)
    Unit cur, nxt; int ui = 0;
    if (!S.next(0, cur)) return;
    Ops co, no; S.ops(cur, co);
    unsigned vA0 = sR[0] * co.lda2 + sC2[0], vA1 = sR[1] * co.lda2 + sC2[1], vB0 = sRb[0] * co.ldb2 + sC2[0], vB1 = sRb[1] * co.ldb2 + sC2[1];
    size_t hA = (size_t)HALF * co.lda2, hB = (size_t)HALF * co.ldb2;
    f32x4 acc[2][2][4][2];
#pragma unroll
    for (int a = 0; a < 2; ++a)
#pragma unroll
        for (int b = 0; b < 2; ++b)
#pragma unroll
            for (int m = 0; m < 4; ++m)
#pragma unroll
                for (int n = 0; n < 2; ++n) acc[a][b][m][n] = (f32x4){0.f, 0.f, 0.f, 0.f};
    bf16x8 At[4][2], B0[2][2], B1[2][2];
    const char* cA = co.A; const char* cB = co.B;
    PG8_STAGE(PG8_SB(0, 0), cB, vB0, vB1); PG8_STAGE(PG8_SB(0, 1), cB + hB, vB0, vB1); PG8_STAGE(PG8_SA(0, 0), cA, vA0, vA1); PG8_STAGE(PG8_SA(0, 1), cA + hA, vA0, vA1);
    if (wr == 1) PG8_BAR;
    PG8_WAIT_V(2); PG8_BAR;
    PG8_STAGE(PG8_SB(1, 0), cB + kstep, vB0, vB1); PG8_STAGE(PG8_SA(1, 0), cA + kstep, vA0, vA1); PG8_STAGE(PG8_SB(1, 1), cB + hB + kstep, vB0, vB1);
    PG8_WAIT_V(6); PG8_BAR;
    for (;;) {
        const bool has_next = S.next(ui + 1, nxt);
        if (has_next) S.ops(nxt, no); else no = co;
        const char* nA = no.A; const char* nB = no.B;
        const unsigned nvA0 = sR[0] * no.lda2 + sC2[0], nvA1 = sR[1] * no.lda2 + sC2[1], nvB0 = sRb[0] * no.ldb2 + sC2[0], nvB1 = sRb[1] * no.ldb2 + sC2[1];
        const size_t nhA = (size_t)HALF * no.lda2, nhB = (size_t)HALF * no.ldb2;
        for (int t = 0; t < nt; t += 2) {
            const bool last = (t == nt - 2);
            const char* a1 = cA + (size_t)(t + 1) * kstep;
            const char* a2 = last ? nA : cA + (size_t)(t + 2) * kstep; const char* b2 = last ? nB : cB + (size_t)(t + 2) * kstep;
            const char* a3 = a2 + kstep; const char* b3 = b2 + kstep;
            const unsigned xA0 = last ? nvA0 : vA0, xA1 = last ? nvA1 : vA1, xB0 = last ? nvB0 : vB0, xB1 = last ? nvB1 : vB1;
            const size_t xhA = last ? nhA : hA, xhB = last ? nhB : hB;
            PG8_LDB(B0, 0, 0); PG8_LDB(B1, 0, 1); PG8_SCHED; PG8_LDA(At, 0, 0); PG8_STAGE(PG8_SA(1, 1), a1 + hA, vA0, vA1);
            PG8_WAIT_V(8); PG8_WAIT_L(0); PG8_BAR; PG8_MMA(0, 0, At, B0); PG8_MMA(0, 1, At, B1); PG8_BAR; PG8_SCHED;
            PG8_LDA(At, 0, 1); PG8_STAGE(PG8_SB(0, 0), b2, xB0, xB1); PG8_STAGE(PG8_SB(0, 1), b2 + xhB, xB0, xB1); PG8_STAGE(PG8_SA(0, 0), a2, xA0, xA1);
            PG8_WAIT_V(8); PG8_WAIT_L(0); PG8_BAR; PG8_MMA(1, 0, At, B0); PG8_MMA(1, 1, At, B1); PG8_BAR; PG8_SCHED;
            PG8_LDB(B0, 1, 0); PG8_LDB(B1, 1, 1); PG8_SCHED; PG8_LDA(At, 1, 0); PG8_STAGE(PG8_SA(0, 1), a2 + xhA, xA0, xA1);
            PG8_WAIT_V(8); PG8_WAIT_L(0); PG8_BAR; PG8_MMA(0, 0, At, B0); PG8_MMA(0, 1, At, B1); PG8_BAR; PG8_SCHED;
            PG8_LDA(At, 1, 1); PG8_STAGE(PG8_SB(1, 0), b3, xB0, xB1); PG8_STAGE(PG8_SB(1, 1), b3 + xhB, xB0, xB1); PG8_STAGE(PG8_SA(1, 0), a3, xA0, xA1);
            PG8_WAIT_V(8); PG8_WAIT_L(0); PG8_BAR; PG8_MMA(1, 0, At, B0); PG8_MMA(1, 1, At, B1); PG8_BAR; PG8_SCHED;
        }
        if (wr == 0) PG8_BAR;
        { int le = lane; asm volatile("" : "+v"(le));
          E(acc, cur, wr, wc, le & 15, le >> 4, lds + RING_BYTES); }
        if (!has_next) break;
        if (!E.keep(cur)) {
#pragma unroll
        for (int a = 0; a < 2; ++a)
#pragma unroll
            for (int b = 0; b < 2; ++b)
#pragma unroll
                for (int m = 0; m < 4; ++m)
#pragma unroll
                    for (int n = 0; n < 2; ++n) acc[a][b][m][n] = (f32x4){0.f, 0.f, 0.f, 0.f};
        }
        cur = nxt; co = no; cA = nA; cB = nB; vA0 = nvA0; vA1 = nvA1; vB0 = nvB0; vB1 = nvB1; hA = nhA; hB = nhB; ++ui;
        if (wr == 1) PG8_BAR;
    }
    PG8_WAIT_V(0);
    PG8_BAR;
#undef PG8_SA
#undef PG8_SB
#undef PG8_STAGE
#undef PG8_LDA
#undef PG8_LDB
#undef PG8_MMA
#undef PG8_WAIT_V
#undef PG8_WAIT_L
#undef PG8_BAR
#undef PG8_SCHED
}

typedef f32x4 Acc[2][2][4][2];
__device__ __forceinline__ void store_plain(const Acc& acc, bf16* base, size_t ldc, float sc) {
#pragma unroll
    for (int ai = 0; ai < 2; ++ai)
#pragma unroll
        for (int m = 0; m < 4; ++m) { bf16* rowp = base + (size_t)(ai * HALF + m * 16) * ldc;
#pragma unroll
            for (int bj = 0; bj < 2; ++bj) { const f32x4 v0 = acc[ai][bj][m][0] * sc, v1 = acc[ai][bj][m][1] * sc;
                u32x4 w; w.x = cvt_pk_bf16(v0[0], v0[1]); w.y = cvt_pk_bf16(v0[2], v0[3]); w.z = cvt_pk_bf16(v1[0], v1[1]); w.w = cvt_pk_bf16(v1[2], v1[3]);
                *(u32x4*)(rowp + bj * HALF) = w; } }
}
}

#define XB_TMO      128
#define XB_XCNT(j)  (256  + 64 * (j))
#define XB_XSUB(j)  (1280 + 64 * (j))
#define XB_XGEN(j)  (2304 + 64 * (j))
#define XB_TOP      3328
#define XB_TOPGEN   3392
#define XCD_BAR_WORDS 3456
#define XB_SPIN_CAP (1u << 18)
__device__ __forceinline__ unsigned xb_ld(unsigned* p)              { return __hip_atomic_load(p, __ATOMIC_RELAXED, __HIP_MEMORY_SCOPE_AGENT); }
__device__ __forceinline__ unsigned xb_add(unsigned* p, unsigned v) { return __hip_atomic_fetch_add(p, v, __ATOMIC_RELAXED, __HIP_MEMORY_SCOPE_AGENT); }
__device__ __forceinline__ unsigned xb_xcc_id() { return (unsigned)__builtin_amdgcn_s_getreg((3 << 11) | 20) & 0xFu; }
#define XB_SPIN(cond, bar) do { unsigned _sp = 0; while (cond) { __builtin_amdgcn_s_sleep(1); \
    if ((++_sp & 255u) == 0u) { if (xb_ld(&(bar)[XB_TMO])) break; if (_sp > XB_SPIN_CAP) { atomicAdd(&(bar)[XB_TMO], 1u); break; } } } } while (0)
struct XcdBarrier { unsigned* bar; unsigned x; volatile LAS unsigned* st; };
__device__ __forceinline__ XcdBarrier xcd_barrier_post(unsigned* bar, volatile LAS unsigned* st) {
    XcdBarrier b; b.bar = bar; b.x = xb_xcc_id(); b.st = st;
    if (threadIdx.x == 0) (void)xb_add(&bar[XB_XCNT(b.x)], 1u);
    return b;
}
__device__ __forceinline__ void xcd_barrier_complete(unsigned* bar, unsigned x, unsigned& nloc, unsigned& nx) {
    const unsigned G = gridDim.x * gridDim.y * gridDim.z;
    unsigned sum, cnt, mine, sp = 0u;
    for (;;) {
        sum = 0u; cnt = 0u; mine = 0u;
#pragma unroll
        for (unsigned j = 0; j < 16; ++j) { const unsigned c = xb_ld(&bar[XB_XCNT(j)]); sum += c; cnt += (c > 0u) ? 1u : 0u; mine = (j == x) ? c : mine; }
        if (sum == G) break;
        __builtin_amdgcn_s_sleep(1);
        if ((++sp & 255u) == 0u) { if (xb_ld(&bar[XB_TMO])) break; if (sp > XB_SPIN_CAP) { atomicAdd(&bar[XB_TMO], 1u); break; } }
    }
    nloc = mine > 0u ? mine : 1u; nx = cnt > 0u ? cnt : 1u;
}
__device__ __forceinline__ void xcd_barrier(const XcdBarrier& b) {
    asm volatile("s_waitcnt vmcnt(0)" ::: "memory");
    __syncthreads();
    if (threadIdx.x == 0) {
        unsigned* bar = b.bar;
        __builtin_amdgcn_s_waitcnt(0);
        unsigned nloc = b.st[0], nx = b.st[1];
        if (nloc == 0u) { xcd_barrier_complete(bar, b.x, nloc, nx); b.st[0] = nloc; b.st[1] = nx; }
        const unsigned old = xb_add(&bar[XB_XSUB(b.x)], 1u);
        const unsigned gen = old / nloc;
        if (old + 1u == (gen + 1u) * nloc) {
            __builtin_amdgcn_fence(__ATOMIC_RELEASE, "agent");
            asm volatile("s_waitcnt vmcnt(0)" ::: "memory");
            const unsigned og = xb_add(&bar[XB_TOP], 1u);
            if (og + 1u == (gen + 1u) * nx) xb_add(&bar[XB_TOPGEN], 1u);
        }
        XB_SPIN(xb_ld(&bar[XB_TOPGEN]) == gen, bar);
        __builtin_amdgcn_fence(__ATOMIC_ACQUIRE, "agent");
        asm volatile("s_waitcnt vmcnt(0)" ::: "memory");
    }
    __syncthreads();
}

struct Frame {
    LAS unsigned char* lds;
    int tid, lane, wave, vcu, G;
    float* out; unsigned char* ws;
};
struct Args { const float* in[22]; float* out; unsigned char* ws; int ph_lo, ph_hi; };
typedef __attribute__((address_space(4))) const Args* KArgs;
__device__ __forceinline__ KArgs kargs() { KArgs p = (KArgs)__builtin_amdgcn_kernarg_segment_ptr(); asm volatile("" : "+s"(p)); return p; }
#define INP(i) (kargs()->in[i])
enum { I_X = 0, I_MEM, I_RELB, I_GPRE, I_GMEM, I_WIN, I_BMERGE, I_LQ1, I_LK1, I_LQ2, I_LK2, I_GSUB, I_WOA, I_CONVW, I_CONVB, I_LNG, I_LNB, I_WOB, I_WMKV, I_WOC, I_WOUT, I_GPOST };

__device__ __forceinline__ int dest_row(int c) {
    if (c < 3072) return c;
    if (c < 4096) return 6144 + (c - 3072);
    if (c < 5120) { const int j = (c - 4096) >> 7, i = (c - 4096) & 127; return 3072 + 256 * j + i; }
    if (c < 6144) { const int j = (c - 5120) >> 7, i = (c - 5120) & 127; return 3072 + 256 * j + 128 + i; }
    if (c < 7168) return 7168 + (c - 6144);
    if (c < 8192) return 5120 + (c - 7168);
    return c;
}
__device__ __forceinline__ void p0_transpose_item(const float* W, int K, int N, bf16* WT, int k0, int n0, int drow0, LAS float* scr, int lane) {
    { const int r = lane >> 3, c4 = (lane & 7) * 4; f32x4 v[8];
#pragma unroll
      for (int p = 0; p < 8; ++p) v[p] = *(const GAS f32x4*)(W + (size_t)(k0 + 8 * p + r) * N + n0 + c4);
#pragma unroll
      for (int p = 0; p < 8; ++p) { LAS float* d = scr + (8 * p + r) * 33 + c4; d[0] = v[p].x; d[1] = v[p].y; d[2] = v[p].z; d[3] = v[p].w; } }
    LDS_WAIT(); asm volatile("" ::: "memory");
    const int c = lane & 7;
#pragma unroll
    for (int j = 0; j < 4; ++j) { const int n = (lane >> 3) + 8 * j; const LAS float* s = scr + (8 * c) * 33 + n;
        u32x4 o; o.x = pk2(s[0 * 33], s[1 * 33]); o.y = pk2(s[2 * 33], s[3 * 33]); o.z = pk2(s[4 * 33], s[5 * 33]); o.w = pk2(s[6 * 33], s[7 * 33]);
        *(GAS u32x4*)(WT + (size_t)(drow0 + n) * K + k0 + 8 * c) = o; }
    LDS_WAIT(); asm volatile("" ::: "memory");
}
template <int NR> __device__ __forceinline__ void rms_rows_to_bf16(const float* x, const float* g, bf16* o, size_t m0, size_t stride, size_t mend, int lane) {
    const GAS f32x4* gr = (const GAS f32x4*)g + lane;
    f32x4 v[NR][4];
#pragma unroll
    for (int r = 0; r < NR; ++r) { const size_t m = m0 + r * stride; if (m < mend) { const GAS f32x4* xr = (const GAS f32x4*)(x + m * DM) + lane;
#pragma unroll
            for (int j = 0; j < 4; ++j) v[r][j] = xr[64 * j]; } else {
#pragma unroll
            for (int j = 0; j < 4; ++j) v[r][j] = (f32x4){0.f, 0.f, 0.f, 0.f}; } }
    f32x4 gg[4];
#pragma unroll
    for (int j = 0; j < 4; ++j) gg[j] = gr[64 * j];
#pragma unroll
    for (int r = 0; r < NR; ++r) { const size_t m = m0 + r * stride; float s = 0.f;
#pragma unroll
        for (int j = 0; j < 4; ++j) s += (v[r][j].x * v[r][j].x + v[r][j].y * v[r][j].y) + (v[r][j].z * v[r][j].z + v[r][j].w * v[r][j].w);
        const float rstd = 1.f / sqrtf(wave_sum(s) * (1.f / 1024.f) + EPS);
        if (m < mend) { GAS unsigned long long* o8 = (GAS unsigned long long*)(o + m * DM) + lane;
#pragma unroll
            for (int j = 0; j < 4; ++j) o8[64 * j] = (unsigned long long)pk2(v[r][j].x * rstd * gg[j].x, v[r][j].y * rstd * gg[j].y) | ((unsigned long long)pk2(v[r][j].z * rstd * gg[j].z, v[r][j].w * rstd * gg[j].w) << 32); } }
}
__device__ __forceinline__ void p0_transposes(Frame& F, bool late, int gw, int NGW) {
    LAS float* scr = (LAS float*)(F.lds + F.wave * 16384);
    bf16* WIN = (bf16*)(F.ws + WS_WIN);
    constexpr int I_INH = 16 * 192, I_SQ = 16 * 32, I_KV = 16 * 64;
    const int NITEMS = late ? I_INH + 4 * I_SQ : I_INH + I_KV;
    const float* p_win = INP(I_WIN); const float* p_woa = INP(I_WOA); const float* p_wob = INP(I_WOB); const float* p_woc = INP(I_WOC); const float* p_wout = INP(I_WOUT); const float* p_wmkv = INP(I_WMKV);
    for (int it = gw; it < NITEMS; it += NGW) {
        int r = it;
        if (r < I_INH) { const int kb = r / 192, e = r % 192;
            const int nb = late ? (e < 32 ? 96 + e : e < 64 ? 160 + e : 192 + e) : (e < 96 ? e : e < 160 ? e + 32 : e + 64);
            p0_transpose_item(p_win, 1024, INW, WIN, 64 * kb, 32 * nb, dest_row(32 * nb), scr, F.lane); continue; } r -= I_INH;
        if (late) { const int w = r / I_SQ, q = r % I_SQ, kb = q / 32, nb = q % 32;
            const float* src = w == 0 ? p_woa : w == 1 ? p_wob : w == 2 ? p_woc : p_wout;
            bf16* dst = (bf16*)(F.ws + (w == 0 ? WS_WOA : w == 1 ? WS_WOB : w == 2 ? WS_WOC : WS_WOUT));
            p0_transpose_item(src, 1024, 1024, dst, 64 * kb, 32 * nb, 32 * nb, scr, F.lane); continue; }
        { const int kb = r / 64, nb = r % 64; p0_transpose_item(p_wmkv, 1024, 2048, (bf16*)(F.ws + WS_WMKV), 64 * kb, 32 * nb, 32 * nb, scr, F.lane); }
    }
}
__device__ __forceinline__ void p0_prologue(Frame& F) {
    const int gw = F.vcu * 8 + F.wave, NGW = F.G * 8;
    p0_transposes(F, false, gw, NGW);
    bf16* XN = (bf16*)((unsigned char*)F.out + OUT_XN);
    { const float* xin = INP(I_X); const float* gpre = INP(I_GPRE);
      for (size_t m = gw; m < MTOK; m += (size_t)4 * NGW) rms_rows_to_bf16<4>(xin, gpre, XN, m, NGW, MTOK, F.lane); }
    bf16* MN = (bf16*)(F.ws + WS_MN);
    { const float* min_ = INP(I_MEM); const float* gmem = INP(I_GMEM);
      for (size_t m = gw; m < MMEM; m += (size_t)2 * NGW) rms_rows_to_bf16<2>(min_, gmem, MN, m, NGW, MMEM, F.lane); }
}

namespace att {
constexpr int L_K = 0, L_V = 16384, L_BIAS = 49152, L_WS = 49152 + NREL * 4, L_ST = L_WS + 2048, L_END = L_ST + 65536;
static_assert(L_END <= RING_BYTES, "attention LDS");
__device__ __forceinline__ int crow(int r, int hi) { return (r & 3) + 8 * (r >> 2) + 4 * hi; }
__device__ __forceinline__ void glds16(const void* gsrc, unsigned lds_dst) { unsigned keep;
    asm volatile("s_mov_b32 %0, m0\n\ts_mov_b32 m0, %2\n\ts_nop 0\n\tglobal_load_lds_dwordx4 %1, off\n\ts_mov_b32 m0, %0" : "=&s"(keep) : "v"(gsrc), "s"(lds_dst) : "memory"); }
typedef short v4i16_t __attribute__((ext_vector_type(4)));
__device__ __forceinline__ s16x4 vtr(const LAS char* p) { return __builtin_bit_cast(s16x4, __builtin_amdgcn_ds_read_tr16_b64_v4i16((LAS v4i16_t*)p)); }
#define MFMA32(a, b, c) __builtin_amdgcn_mfma_f32_32x32x16_bf16(a, b, c, 0, 0, 0)

__device__ __forceinline__ void attn_unit(int b, int h, int qb, const bf16* Q, const bf16* K, const bf16* V, bf16* O, const float* tab, const float* gsub, float lam, LAS unsigned char* shm) {
    const int tid = fresh_tid(), lane = tid & 63, r32 = lane & 31, hi = lane >> 5; const int wid = __builtin_amdgcn_readfirstlane(tid >> 6);
    const long rowbase = (long)b * SEQ; const int q0 = qb * 256, NT = q0 / 64 + 4;
    const int qw = q0 + 32 * wid, ntw = qw / 64 + 1;
    const unsigned lds0 = (unsigned)(uintptr_t)shm;
    LAS float* biasl = (LAS float*)(shm + L_BIAS);
    LAS float* wsf = (LAS float*)(shm + L_WS) + wid * 64;
    LAS unsigned short* stg = (LAS unsigned short*)(shm + L_ST + wid * 8192);
    for (int i = tid; i < NREL; i += 512) biasl[i] = tab[t5_bucket(i - 2047) * 8 + h] * LOG2E;
    const float c15 = tab[15 * 8 + h] * LOG2E;
    const LAS char* kp0 = (const LAS char*)shm + L_K + hi * 1024 + r32 * 16;
    const LAS char* vp0 = (const LAS char*)shm + L_V + ((lane >> 4) & 1) * 32 + (lane & 3) * 8 + (4 * hi + ((lane & 15) >> 2)) * 64;
    f32x16 o[4];
    for (int c = 0; c < 2; ++c) {
        const bf16* Qw = Q + (rowbase + qw) * DM + h * 128 + c * 64;
        const bf16* ksrc = K + (rowbase + lane) * DM + h * 128 + c * 64 + wid * 8;
        const int p0i = wid * 2, p1i = wid * 2 + 1;
        const bf16* vsrc0 = V + (rowbase + 16 * (p0i & 3) + (lane >> 2)) * DM + h * 128 + (p0i >> 2) * 32 + (lane & 3) * 8;
        const bf16* vsrc1 = V + (rowbase + 16 * (p1i & 3) + (lane >> 2)) * DM + h * 128 + (p1i >> 2) * 32 + (lane & 3) * 8;
#define DMA_KV(t, slot) do { glds16(ksrc + (long)(t) * 64 * DM, (unsigned)__builtin_amdgcn_readfirstlane(lds0 + L_K + (slot) * 8192 + wid * 1024)); \
        glds16(vsrc0 + (long)(t) * 64 * DM, (unsigned)__builtin_amdgcn_readfirstlane(lds0 + L_V + (slot) * 16384 + p0i * 1024)); \
        glds16(vsrc1 + (long)(t) * 64 * DM, (unsigned)__builtin_amdgcn_readfirstlane(lds0 + L_V + (slot) * 16384 + p1i * 1024)); } while (0)
        DMA_KV(0, 0);
        bf16x8 qr[4];
#pragma unroll
        for (int d0 = 0; d0 < 4; ++d0) qr[d0] = *reinterpret_cast<const bf16x8*>(&Qw[(long)r32 * DM + d0 * 16 + hi * 8]);
        asm volatile("" :: "v"(qr[0]), "v"(qr[1]), "v"(qr[2]), "v"(qr[3]));
        float m_run = -1e30f, l_run = 0.f;
#pragma unroll
        for (int d0 = 0; d0 < 4; ++d0) o[d0] = f32x16{};
        for (int t = 0; t < NT; ++t) {
            asm volatile("s_waitcnt vmcnt(0) lgkmcnt(0)\n\ts_barrier" ::: "memory");
            const int slot = t & 1;
            if (t + 1 < NT) DMA_KV(t + 1, slot ^ 1);
            if (t < ntw) {
                const LAS char* kp = kp0 + slot * 8192; const LAS char* vp = vp0 + slot * 16384;
                f32x16 p0 = f32x16{}, p1 = f32x16{};
#pragma unroll
                for (int d0 = 0; d0 < 4; ++d0) {
                    const bf16x8 k0 = *(const LAS bf16x8*)(kp + d0 * 2048), k1 = *(const LAS bf16x8*)(kp + d0 * 2048 + 512);
                    p0 = MFMA32(k0, qr[d0], p0); p1 = MFMA32(k1, qr[d0], p1);
                }
                if (64 * t + 63 - qw <= -91) {
#pragma unroll
                    for (int r = 0; r < 16; ++r) { p0[r] += c15; p1[r] += c15; }
                } else {
                    const int ib = 64 * t - qw - r32 + 2047 + 4 * hi;
#pragma unroll
                    for (int r = 0; r < 16; ++r) { const int kk = (r & 3) + 8 * (r >> 2); p0[r] += biasl[ib + kk]; p1[r] += biasl[ib + kk + 32]; }
                }
                float rm = p0[0];
#pragma unroll
                for (int r = 0; r < 16; ++r) { rm = fmaxf(rm, p0[r]); rm = fmaxf(rm, p1[r]); }
                rm = fmaxf(rm, __shfl_xor(rm, 32));
                const float m_new = fmaxf(m_run, rm), alpha = __builtin_amdgcn_exp2f(m_run - m_new);
                m_run = m_new;
                float rs = 0.f;
#pragma unroll
                for (int r = 0; r < 16; ++r) { p0[r] = __builtin_amdgcn_exp2f(p0[r] - m_new); p1[r] = __builtin_amdgcn_exp2f(p1[r] - m_new); }
                u32x4 pw[4];
#pragma unroll
                for (int ks = 0; ks < 2; ++ks)
#pragma unroll
                    for (int j = 0; j < 4; ++j) { pw[ks][j] = cvt_pk_bf16(p0[8 * ks + 2 * j], p0[8 * ks + 2 * j + 1]); pw[2 + ks][j] = cvt_pk_bf16(p1[8 * ks + 2 * j], p1[8 * ks + 2 * j + 1]); }
#pragma unroll
                for (int ks = 0; ks < 4; ++ks)
#pragma unroll
                    for (int j = 0; j < 4; ++j) rs += bflo(pw[ks][j]) + bfhi(pw[ks][j]);
                l_run = l_run * alpha + rs;
                if (__any(alpha != 1.0f)) {
                    if (hi == 0) wsf[r32] = alpha;
                    LDS_WAIT();
#pragma unroll
                    for (int r = 0; r < 16; ++r) { const float a = wsf[crow(r, hi)];
#pragma unroll
                        for (int d0 = 0; d0 < 4; ++d0) o[d0][r] *= a; }
                }
#pragma unroll
                for (int d0 = 0; d0 < 4; ++d0)
#pragma unroll
                    for (int ks = 0; ks < 4; ++ks) {
                        const s16x4 lo = vtr(vp + d0 * 4096 + ks * 1024), hh = vtr(vp + d0 * 4096 + ks * 1024 + 512);
                        const bf16x8 vb = (bf16x8){lo[0], lo[1], lo[2], lo[3], hh[0], hh[1], hh[2], hh[3]};
                        o[d0] = MFMA32(__builtin_bit_cast(bf16x8, pw[ks]), vb, o[d0]);
                    }
            }
        }
        asm volatile("s_waitcnt lgkmcnt(0)\n\ts_barrier" ::: "memory");
        l_run += __shfl_xor(l_run, 32);
        if (hi == 0) wsf[32 + r32] = l_run;
        LDS_WAIT();
        LAS unsigned* stash = (LAS unsigned*)stg;
        if (c == 0) {
#pragma unroll
            for (int r = 0; r < 16; r += 2) { const float rl0 = __builtin_amdgcn_rcpf(wsf[32 + crow(r, hi)]), rl1 = __builtin_amdgcn_rcpf(wsf[32 + crow(r + 1, hi)]);
#pragma unroll
                for (int d0 = 0; d0 < 4; ++d0) stash[(d0 * 8 + (r >> 1)) * 64 + lane] = cvt_pk_bf16(o[d0][r] * rl0, o[d0][r + 1] * rl1); }
        } else {
#pragma unroll
            for (int r = 0; r < 16; r += 2) { const float rl0 = __builtin_amdgcn_rcpf(wsf[32 + crow(r, hi)]), rl1 = __builtin_amdgcn_rcpf(wsf[32 + crow(r + 1, hi)]);
#pragma unroll
                for (int d0 = 0; d0 < 4; ++d0) { const unsigned w = stash[(d0 * 8 + (r >> 1)) * 64 + lane]; o[d0][r] = bflo(w) - lam * (o[d0][r] * rl0); o[d0][r + 1] = bfhi(w) - lam * (o[d0][r + 1] * rl1); } }
        }
        LDS_WAIT();
#undef DMA_KV
    }
    float gs[4];
#pragma unroll
    for (int d0 = 0; d0 < 4; ++d0) gs[d0] = gsub[32 * d0 + r32] * 0.8f;
#pragma unroll
    for (int r = 0; r < 16; ++r) {
        float ss = 0.f;
#pragma unroll
        for (int d0 = 0; d0 < 4; ++d0) ss += o[d0][r] * o[d0][r];
#pragma unroll
        for (int x = 1; x < 32; x <<= 1) ss += __shfl_xor(ss, x);
        const float rstd = 1.f / sqrtf(ss * (1.f / 128.f) + EPS);
        const int orow = crow(r, hi);
#pragma unroll
        for (int d0 = 0; d0 < 4; ++d0) stg[orow * 128 + d0 * 32 + r32] = (unsigned short)f2bf(o[d0][r] * rstd * gs[d0]);
    }
    LDS_WAIT();
    bf16* Ow = O + (rowbase + qw) * DM + h * 128;
#pragma unroll
    for (int i = 0; i < 8; ++i) { const int idx = i * 64 + lane, row = idx >> 4, ch = idx & 15; const u32x4 v = *(const LAS u32x4*)(stg + row * 128 + ch * 8); *(u32x4*)(Ow + (long)row * DM + ch * 8) = v; }
    asm volatile("s_waitcnt lgkmcnt(0)\n\ts_barrier" ::: "memory");
}
}

namespace att2 {
using att::crow; using att::glds16; using att::vtr;
constexpr int NSK = 3, NSV = 3;
constexpr int L_K = 0, L_V = NSK * 8192, L_BIAS = L_V + NSV * 16384, L_WS = L_BIAS + NREL * 4, L_FLAG = L_WS + 2048, L_ST = L_FLAG + 64, L_END = L_ST + 65536;
static_assert(L_END <= PHASE_LDS, "attention LDS");
__device__ __forceinline__ bool attn_unit(int b, int h, int qb, const bf16* Q, const bf16* K, const bf16* V, bf16* O, const float* tab, const float* gsub, float lam, LAS unsigned char* shm) {
    const int tid = fresh_tid(), lane = tid & 63, r32 = lane & 31, hi = lane >> 5; const int wid = __builtin_amdgcn_readfirstlane(tid >> 6);
    const long rowbase = (long)b * SEQ; const int q0 = qb * 256, NT = q0 / 64 + 4;
    const int grp = wid >> 2, blk = (wid & 3) * 2 + grp;
    const int qw = q0 + 32 * blk, ntw = qw / 64 + 1;
    const unsigned lds0 = (unsigned)(uintptr_t)shm;
    LAS float* biasl = (LAS float*)(shm + L_BIAS);
    LAS float* wsf = (LAS float*)(shm + L_WS) + wid * 64;
    LAS unsigned short* stg = (LAS unsigned short*)(shm + L_ST + wid * 8192);
    LAS unsigned* flag = (LAS unsigned*)(shm + L_FLAG);
    { const float b15 = tab[15 * 8 + h]; for (int i = tid; i < NREL; i += 512) biasl[i] = (tab[t5_bucket(i - 2047) * 8 + h] - b15) * LOG2E; }
    if (tid == 0) flag[0] = 0u;
    const LAS char* kp0 = (const LAS char*)shm + L_K + hi * 1024 + r32 * 16;
    const LAS char* vp0 = (const LAS char*)shm + L_V + ((lane >> 4) & 1) * 32 + (lane & 3) * 8 + (4 * hi + ((lane & 15) >> 2)) * 64;
    f32x16 o[4]; bool bad = false;
    for (int c = 0; c < 2; ++c) {
        const bf16* Qw = Q + (rowbase + qw) * DM + h * 128 + c * 64;
        const bf16* ksrc = K + (rowbase + lane) * DM + h * 128 + c * 64 + wid * 8;
        const int p0i = wid * 2, p1i = wid * 2 + 1;
        const bf16* vsrc0 = V + (rowbase + 16 * (p0i & 3) + (lane >> 2)) * DM + h * 128 + (p0i >> 2) * 32 + (lane & 3) * 8;
        const bf16* vsrc1 = V + (rowbase + 16 * (p1i & 3) + (lane >> 2)) * DM + h * 128 + (p1i >> 2) * 32 + (lane & 3) * 8;
#define DMA_K(t, slot) glds16(ksrc + (long)(t) * 64 * DM, (unsigned)__builtin_amdgcn_readfirstlane(lds0 + L_K + (slot) * 8192 + wid * 1024))
#define DMA_V(t, slot) do { glds16(vsrc0 + (long)(t) * 64 * DM, (unsigned)__builtin_amdgcn_readfirstlane(lds0 + L_V + (slot) * 16384 + p0i * 1024)); \
        glds16(vsrc1 + (long)(t) * 64 * DM, (unsigned)__builtin_amdgcn_readfirstlane(lds0 + L_V + (slot) * 16384 + p1i * 1024)); } while (0)
        DMA_K(0, 0); DMA_V(0, 0); DMA_K(1, 1);
        bf16x8 qr[4];
#pragma unroll
        for (int d0 = 0; d0 < 4; ++d0) qr[d0] = *reinterpret_cast<const bf16x8*>(&Qw[(long)r32 * DM + d0 * 16 + hi * 8]);
        asm volatile("" :: "v"(qr[0]), "v"(qr[1]), "v"(qr[2]), "v"(qr[3]));
        float l_run = 0.f;
#pragma unroll
        for (int d0 = 0; d0 < 4; ++d0) o[d0] = f32x16{};
        u32x4 pw[4];
#pragma unroll
        for (int ks = 0; ks < 4; ++ks) pw[ks] = (u32x4){0u, 0u, 0u, 0u};
        for (int hs = 0; hs <= 2 * NT + 1; ++hs) {
            const int g = hs >> 1;
            if ((hs & 1) == 0) {
#define WB(N) asm volatile("s_waitcnt vmcnt(" #N ") lgkmcnt(0)\n\ts_barrier" ::: "memory")
                if (g + 1 < NT) WB(1); else WB(0);
#undef WB
                if (g + 1 < NT) DMA_V(g + 1, (g + 1) % 3);
                if (g + 2 < NT) DMA_K(g + 2, (g + 2) % 3);
            }
            const int j = hs - grp;
            if (j >= 0) {
                const int t = j >> 1;
                if (t < ntw) {
                    if ((j & 1) == 0) {
                        const LAS char* kp = kp0 + (t % 3) * 8192;
                        bf16x8 kf[8];
#pragma unroll
                        for (int d0 = 0; d0 < 4; ++d0) { kf[2 * d0] = *(const LAS bf16x8*)(kp + d0 * 2048); kf[2 * d0 + 1] = *(const LAS bf16x8*)(kp + d0 * 2048 + 512); }
                        __builtin_amdgcn_sched_barrier(0);
                        __builtin_amdgcn_s_setprio(1);
                        f32x16 p0 = MFMA32(kf[0], qr[0], (f32x16){}), p1 = MFMA32(kf[1], qr[0], (f32x16){});
#pragma unroll
                        for (int d0 = 1; d0 < 4; ++d0) { p0 = MFMA32(kf[2 * d0], qr[d0], p0); p1 = MFMA32(kf[2 * d0 + 1], qr[d0], p1); }
                        __builtin_amdgcn_s_setprio(0);
                        if (64 * t + 63 - qw > -91) {
                            const int ib = 64 * t - qw - r32 + 2047 + 4 * hi;
#pragma unroll
                            for (int r = 0; r < 16; ++r) { const int kk = (r & 3) + 8 * (r >> 2); p0[r] += biasl[ib + kk]; p1[r] += biasl[ib + kk + 32]; } }
                        float rs = 0.f;
#pragma unroll
                        for (int r = 0; r < 16; ++r) { p0[r] = __builtin_amdgcn_exp2f(p0[r]); p1[r] = __builtin_amdgcn_exp2f(p1[r]); }
#pragma unroll
                        for (int r = 0; r < 16; ++r) rs += p0[r] + p1[r];
                        l_run += rs;
#pragma unroll
                        for (int ks = 0; ks < 2; ++ks)
#pragma unroll
                            for (int q = 0; q < 4; ++q) { pw[ks][q] = cvt_pk_bf16(p0[8 * ks + 2 * q], p0[8 * ks + 2 * q + 1]); pw[2 + ks][q] = cvt_pk_bf16(p1[8 * ks + 2 * q], p1[8 * ks + 2 * q + 1]); }
                    } else {
                        const LAS char* vp = vp0 + (t % 3) * 16384;
                        s16x4 va[8], vb[8];
#define RDV(dst, d0) do { _Pragma("unroll") for (int ks = 0; ks < 4; ++ks) { dst[2 * ks] = vtr(vp + (d0) * 4096 + ks * 1024); dst[2 * ks + 1] = vtr(vp + (d0) * 4096 + ks * 1024 + 512); } } while (0)
#define PVB(src, d0) do { _Pragma("unroll") for (int ks = 0; ks < 4; ++ks) { const bf16x8 vv = (bf16x8){src[2 * ks][0], src[2 * ks][1], src[2 * ks][2], src[2 * ks][3], src[2 * ks + 1][0], src[2 * ks + 1][1], src[2 * ks + 1][2], src[2 * ks + 1][3]}; \
                            o[d0] = MFMA32(__builtin_bit_cast(bf16x8, pw[ks]), vv, o[d0]); } } while (0)
                        RDV(va, 0); RDV(vb, 1); __builtin_amdgcn_sched_barrier(0);
                        PVB(va, 0); __builtin_amdgcn_sched_barrier(0);
                        RDV(va, 2); __builtin_amdgcn_sched_barrier(0);
                        PVB(vb, 1); __builtin_amdgcn_sched_barrier(0);
                        RDV(vb, 3); __builtin_amdgcn_sched_barrier(0);
                        PVB(va, 2); __builtin_amdgcn_sched_barrier(0);
                        PVB(vb, 3);
#undef RDV
#undef PVB
                    }
                }
            }
        }
        asm volatile("s_waitcnt lgkmcnt(0)\n\ts_barrier" ::: "memory");
        l_run += __shfl_xor(l_run, 32);
        bad = bad || (BADTEST == 1 ? false : BADTEST == 2 ? !(l_run == l_run) : BADTEST == 3 ? !(l_run > 1e-30f) : BADTEST == 4 ? !(l_run < 1e30f) : !(l_run > 1e-30f && l_run < 1e30f));
        if (hi == 0) wsf[32 + r32] = l_run;
        LDS_WAIT();
        LAS unsigned* stash = (LAS unsigned*)stg;
        if (c == 0) {
#pragma unroll
            for (int r = 0; r < 16; r += 2) { const float rl0 = __builtin_amdgcn_rcpf(wsf[32 + crow(r, hi)]), rl1 = __builtin_amdgcn_rcpf(wsf[32 + crow(r + 1, hi)]);
#pragma unroll
                for (int d0 = 0; d0 < 4; ++d0) stash[(d0 * 8 + (r >> 1)) * 64 + lane] = cvt_pk_bf16(o[d0][r] * rl0, o[d0][r + 1] * rl1); }
        } else {
#pragma unroll
            for (int r = 0; r < 16; r += 2) { const float rl0 = __builtin_amdgcn_rcpf(wsf[32 + crow(r, hi)]), rl1 = __builtin_amdgcn_rcpf(wsf[32 + crow(r + 1, hi)]);
#pragma unroll
                for (int d0 = 0; d0 < 4; ++d0) { const unsigned w = stash[(d0 * 8 + (r >> 1)) * 64 + lane]; o[d0][r] = bflo(w) - lam * (o[d0][r] * rl0); o[d0][r + 1] = bfhi(w) - lam * (o[d0][r + 1] * rl1); } }
        }
        LDS_WAIT();
#undef DMA_K
#undef DMA_V
    }
    if (__any(bad) && lane == 0) flag[0] = 1u;
    asm volatile("s_waitcnt lgkmcnt(0)\n\ts_barrier" ::: "memory");
    const bool redo = flag[0] != 0u;
    if (!redo) {
        float gs[4];
#pragma unroll
        for (int d0 = 0; d0 < 4; ++d0) gs[d0] = gsub[32 * d0 + r32] * 0.8f;
#pragma unroll
        for (int r = 0; r < 16; ++r) {
            float ss = 0.f;
#pragma unroll
            for (int d0 = 0; d0 < 4; ++d0) ss += o[d0][r] * o[d0][r];
#pragma unroll
            for (int x = 1; x < 32; x <<= 1) ss += __shfl_xor(ss, x);
            const float rstd = 1.f / sqrtf(ss * (1.f / 128.f) + EPS);
            const int orow = crow(r, hi);
#pragma unroll
            for (int d0 = 0; d0 < 4; ++d0) stg[orow * 128 + d0 * 32 + r32] = (unsigned short)f2bf(o[d0][r] * rstd * gs[d0]);
        }
        LDS_WAIT();
        bf16* Ow = O + (rowbase + qw) * DM + h * 128;
#pragma unroll
        for (int i = 0; i < 8; ++i) { const int idx = i * 64 + lane, row = idx >> 4, ch = idx & 15; const u32x4 v = *(const LAS u32x4*)(stg + row * 128 + ch * 8); *(u32x4*)(Ow + (long)row * DM + ch * 8) = v; }
    }
    asm volatile("s_waitcnt lgkmcnt(0)\n\ts_barrier" ::: "memory");
    return redo;
}
}

namespace att3 {
using att::crow; using att::vtr;
__device__ __forceinline__ void glds16s(const void* sbase, unsigned voff, unsigned lds_dst) { unsigned keep;
    asm volatile("s_mov_b32 %0, m0\n\ts_mov_b32 m0, %3\n\ts_nop 0\n\tglobal_load_lds_dwordx4 %1, %2\n\ts_mov_b32 m0, %0" : "=&s"(keep) : "v"(voff), "s"(sbase), "s"(lds_dst) : "memory"); }
constexpr int L_K = 0, L_V = 3 * 8192, L_BIAS = L_V + 3 * 16384, L_WS = L_BIAS + NREL * 4, L_FLAG = L_WS + 2048, L_GS = L_FLAG + 64, L_ST = L_GS + 512, L_END = L_ST + 65536;
static_assert(L_END <= PHASE_LDS, "attention LDS");
__device__ __forceinline__ bool attn_unit(int b, int h, int qb, int qb_next, bool first, bool build_tab, bf16x8 (&qr)[4], const bf16* Q, const bf16* K, const bf16* V, bf16* O, const float* tab, const float* gsub, float lam, LAS unsigned char* shm) {
    const int tid = fresh_tid(), lane = tid & 63, r32 = lane & 31, hi = lane >> 5; const int wid = __builtin_amdgcn_readfirstlane(tid >> 6);
    const long rowbase = (long)b * SEQ; const int q0 = qb * 256, NT = q0 / 64 + 4;
    const int blk = (((wid >> 2) ? 3 - ((wid & 3) >> 1) : ((wid & 3) >> 1)) << 1) + (wid & 1);
    const int qw = q0 + 32 * blk, ntw = qw / 64 + 1;
    const unsigned lds0 = (unsigned)(uintptr_t)shm;
    LAS float* biasl = (LAS float*)(shm + L_BIAS);
    LAS float* wsf = (LAS float*)(shm + L_WS) + wid * 64;
    LAS unsigned short* stg = (LAS unsigned short*)(shm + L_ST + wid * 8192);
    LAS unsigned* flag = (LAS unsigned*)(shm + L_FLAG);
    if (first) asm volatile("s_waitcnt vmcnt(0) lgkmcnt(0)\n\ts_barrier" ::: "memory");
    if (build_tab) { const float b15 = tab[15 * 8 + h]; for (int i = tid; i < NREL; i += 512) biasl[i] = (tab[t5_bucket(i - 2047) * 8 + h] - b15) * LOG2E;
                     if (tid < 128) ((LAS float*)(shm + L_GS))[tid] = gsub[tid] * 0.8f; }
    if (tid == 0) flag[0] = 0u;
    const LAS char* kp0 = (const LAS char*)shm + L_K + hi * 1024 + r32 * 16;
    const LAS char* vp0 = (const LAS char*)shm + L_V + ((lane >> 4) & 1) * 32 + (lane & 3) * 8 + (4 * hi + ((lane & 15) >> 2)) * 64;
    const int ibase = -qw - r32 + 2047 + 4 * hi;
    f32x16 o[4]; bool bad = false;
#define SBV __builtin_amdgcn_sched_barrier(0x406)
#define WB(N) asm volatile("s_waitcnt vmcnt(" #N ") lgkmcnt(0)\n\ts_barrier" ::: "memory")
#define QKT(P0, P1, t) do { int so_ = ((t) % 3) * 8192; asm volatile("" : "+s"(so_)); const LAS char* kp_ = kp0 + so_; bf16x8 kf[8]; \
        _Pragma("unroll") for (int d0 = 0; d0 < 4; ++d0) { kf[2 * d0] = *(const LAS bf16x8*)(kp_ + d0 * 2048); kf[2 * d0 + 1] = *(const LAS bf16x8*)(kp_ + d0 * 2048 + 512); } \
        __builtin_amdgcn_sched_barrier(0);     \
        P0 = MFMA32(kf[0], qr[0], (f32x16){}); P1 = MFMA32(kf[1], qr[0], (f32x16){}); \
        _Pragma("unroll") for (int d0 = 1; d0 < 4; ++d0) { P0 = MFMA32(kf[2 * d0], qr[d0], P0); P1 = MFMA32(kf[2 * d0 + 1], qr[d0], P1); } \
        if (64 * (t) + 63 - qw > -91) { const int ib = 64 * (t) + ibase; \
            _Pragma("unroll") for (int r = 0; r < 16; ++r) { const int kk = (r & 3) + 8 * (r >> 2); P0[r] += biasl[ib + kk]; P1[r] += biasl[ib + kk + 32]; } } } while (0)
#define SOFTMAX(P0, P1, PW) do { float rs = 0.f; \
        _Pragma("unroll") for (int r = 0; r < 16; ++r) { P0[r] = __builtin_amdgcn_exp2f(P0[r]); P1[r] = __builtin_amdgcn_exp2f(P1[r]); } \
        _Pragma("unroll") for (int r = 0; r < 16; ++r) rs += P0[r] + P1[r]; \
        l_run += rs; \
        _Pragma("unroll") for (int ks = 0; ks < 2; ++ks) _Pragma("unroll") for (int q = 0; q < 4; ++q) { PW[ks][q] = cvt_pk_bf16(P0[8 * ks + 2 * q], P0[8 * ks + 2 * q + 1]); PW[2 + ks][q] = cvt_pk_bf16(P1[8 * ks + 2 * q], P1[8 * ks + 2 * q + 1]); } } while (0)
#define RDV(dst, d0) do { _Pragma("unroll") for (int ks = 0; ks < 4; ++ks) { dst[2 * ks] = vtr(vp + (d0) * 4096 + ks * 1024); dst[2 * ks + 1] = vtr(vp + (d0) * 4096 + ks * 1024 + 512); } } while (0)
#define PVB(src, d0) do { _Pragma("unroll") for (int ks = 0; ks < 4; ++ks) { const bf16x8 vv = (bf16x8){src[2 * ks][0], src[2 * ks][1], src[2 * ks][2], src[2 * ks][3], src[2 * ks + 1][0], src[2 * ks + 1][1], src[2 * ks + 1][2], src[2 * ks + 1][3]}; \
        o[d0] = MFMA32(__builtin_bit_cast(bf16x8, pw[ks]), vv, o[d0]); } } while (0)
#define PV(t) do { int so_ = ((t) % 3) * 16384; asm volatile("" : "+s"(so_)); const LAS char* vp = vp0 + so_; s16x4 va[8]; \
        RDV(va, 0); SBV; PVB(va, 0); SBV; RDV(va, 1); SBV; PVB(va, 1); SBV; RDV(va, 2); SBV; PVB(va, 2); SBV; RDV(va, 3); SBV; PVB(va, 3); } while (0)
    for (int c = 0; c < 2; ++c) {
        const bf16* Qw = Q + (rowbase + qw) * DM + h * 128 + c * 64;
        const bf16* kbase = K + rowbase * DM + h * 128 + c * 64;
        const bf16* vbase = V + rowbase * DM + h * 128;
        const int p0i = wid * 2, p1i = wid * 2 + 1;
#define LANE_() ({ int l_ = lane; asm volatile("" : "+v"(l_)); l_; })
#define KVO() ((unsigned)((LANE_() * DM + wid * 8) * 2))
#define VVO(pi) ({ const int l2_ = LANE_(); (unsigned)(((16 * ((pi) & 3) + (l2_ >> 2)) * DM + ((pi) >> 2) * 32 + (l2_ & 3) * 8) * 2); })
#define DMA_KB(kb, t) glds16s((kb) + (size_t)(t) * 64 * DM, KVO(), (unsigned)__builtin_amdgcn_readfirstlane(lds0 + L_K + ((t) % 3) * 8192 + wid * 1024))
#define DMA_VB(vb, t) do { glds16s((vb) + (size_t)(t) * 64 * DM, VVO(p0i), (unsigned)__builtin_amdgcn_readfirstlane(lds0 + L_V + ((t) % 3) * 16384 + p0i * 1024)); \
        glds16s((vb) + (size_t)(t) * 64 * DM, VVO(p1i), (unsigned)__builtin_amdgcn_readfirstlane(lds0 + L_V + ((t) % 3) * 16384 + p1i * 1024)); } while (0)
#define DMA_K(t) DMA_KB(kbase, t)
#define DMA_V(t) DMA_VB(vbase, t)
#define PROLOGUE(kb, vb, qp) do { DMA_KB(kb, 0); DMA_VB(vb, 0); DMA_KB(kb, 1); DMA_VB(vb, 1); DMA_KB(kb, 2); \
        { const int lq_ = LANE_(); _Pragma("unroll") for (int d0 = 0; d0 < 4; ++d0) qr[d0] = *reinterpret_cast<const bf16x8*>(&(qp)[(long)(lq_ & 31) * DM + d0 * 16 + (lq_ >> 5) * 8]); } } while (0)
        if (c == 0 && first) PROLOGUE(kbase, vbase, Qw);
        asm volatile("" :: "v"(qr[0]), "v"(qr[1]), "v"(qr[2]), "v"(qr[3]));
        float l_run = 0.f;
#pragma unroll
        for (int d0 = 0; d0 < 4; ++d0) o[d0] = f32x16{};
        u32x4 pw[4];
        WB(0);
        { f32x16 s0, s1; QKT(s0, s1, 0); SOFTMAX(s0, s1, pw); }
        for (int t = 0; t < NT; ++t) {
            if (t + 2 < NT) WB(3); else if (t + 1 < NT) WB(2); else WB(0);
            if (t + 2 < NT) DMA_V(t + 2);
            if (t + 3 < NT) DMA_K(t + 3);
            if (t < ntw) {
                if (t + 1 < ntw) {
                    f32x16 n0, n1; u32x4 pwn[4];
                    QKT(n0, n1, t + 1);
                    __builtin_amdgcn_sched_barrier(0);
                    {
                        int so_ = (t % 3) * 16384; asm volatile("" : "+s"(so_)); const LAS char* vp = vp0 + so_;
                        s16x4 vl[4], vh[4]; float rs = 0.f;
#define VRD_(i) do { vl[(i) & 3] = vtr(vp + ((i) >> 2) * 4096 + ((i) & 3) * 1024); vh[(i) & 3] = vtr(vp + ((i) >> 2) * 4096 + ((i) & 3) * 1024 + 512); } while (0)
#define VFR_(i) (bf16x8){vl[(i) & 3][0], vl[(i) & 3][1], vl[(i) & 3][2], vl[(i) & 3][3], vh[(i) & 3][0], vh[(i) & 3][1], vh[(i) & 3][2], vh[(i) & 3][3]}
#define PIN_(x) asm volatile("" : "+v"(x))
#define GAP_(i, N, j) do { if ((i) + 2 < 16) VRD_((i) + 2); \
                            o[(i) >> 2] = MFMA32(__builtin_bit_cast(bf16x8, pw[(i) & 3]), VFR_(i), o[(i) >> 2]); PIN_(o[(i) >> 2]); \
                            N[j] = __builtin_amdgcn_exp2f(N[j]); N[(j) + 1] = __builtin_amdgcn_exp2f(N[(j) + 1]); PIN_(N); \
                            __builtin_amdgcn_sched_barrier(0); } while (0)
#define FIN_(i, N, j) do { rs += N[j] + N[(j) + 1]; pwn[(i) >> 2][(i) & 3] = cvt_pk_bf16(N[j], N[(j) + 1]); PIN_(rs); PIN_(pwn[(i) >> 2]); } while (0)
                        VRD_(0); VRD_(1); __builtin_amdgcn_sched_barrier(0);
                        GAP_(0, n0, 0);
                        FIN_(0, n0, 0);  GAP_(1, n0, 2);
                        FIN_(1, n0, 2);  GAP_(2, n0, 4);
                        FIN_(2, n0, 4);  GAP_(3, n0, 6);
                        FIN_(3, n0, 6);  GAP_(4, n0, 8);
                        FIN_(4, n0, 8);  GAP_(5, n0, 10);
                        FIN_(5, n0, 10); GAP_(6, n0, 12);
                        FIN_(6, n0, 12); GAP_(7, n0, 14);
                        FIN_(7, n0, 14); GAP_(8, n1, 0);
                        FIN_(8, n1, 0);  GAP_(9, n1, 2);
                        FIN_(9, n1, 2);  GAP_(10, n1, 4);
                        FIN_(10, n1, 4); GAP_(11, n1, 6);
                        FIN_(11, n1, 6); GAP_(12, n1, 8);
                        FIN_(12, n1, 8); GAP_(13, n1, 10);
                        FIN_(13, n1, 10); GAP_(14, n1, 12);
                        FIN_(14, n1, 12); GAP_(15, n1, 14);
                        FIN_(15, n1, 14);
                        l_run += rs;
#undef VRD_
#undef VFR_
#undef PIN_
#undef GAP_
#undef FIN_
                    }
#pragma unroll
                    for (int ks = 0; ks < 4; ++ks) pw[ks] = pwn[ks];
                } else { PV(t); }
            }
        }
        asm volatile("s_waitcnt lgkmcnt(0)\n\ts_barrier" ::: "memory");
        if (c == 0) PROLOGUE(kbase + 64, vbase, Qw + 64);
        else if (qb_next >= 0) { const bf16* Qn = Q + (rowbase + qb_next * 256 + 32 * blk) * DM + h * 128; PROLOGUE(kbase - 64, vbase, Qn); }
        l_run += __shfl_xor(l_run, 32);
        bad = bad || !(l_run > 1e-30f && l_run < 1e30f);
        if (hi == 0) wsf[32 + r32] = l_run;
        LDS_WAIT();
        LAS unsigned* stash = (LAS unsigned*)stg;
#pragma unroll
        for (int d0 = 0; d0 < 4; ++d0) {
            asm volatile("" : "+v"(o[d0]));
            if (c == 0) {
#pragma unroll
                for (int r = 0; r < 16; r += 2) { const float rl0 = __builtin_amdgcn_rcpf(wsf[32 + crow(r, hi)]), rl1 = __builtin_amdgcn_rcpf(wsf[32 + crow(r + 1, hi)]);
                    stash[(d0 * 8 + (r >> 1)) * 64 + lane] = cvt_pk_bf16(o[d0][r] * rl0, o[d0][r + 1] * rl1); }
            } else {
#pragma unroll
                for (int r = 0; r < 16; r += 2) { const float rl0 = __builtin_amdgcn_rcpf(wsf[32 + crow(r, hi)]) * lam, rl1 = __builtin_amdgcn_rcpf(wsf[32 + crow(r + 1, hi)]) * lam;
                    const unsigned w = stash[(d0 * 8 + (r >> 1)) * 64 + lane]; o[d0][r] = bflo(w) - o[d0][r] * rl0; o[d0][r + 1] = bfhi(w) - o[d0][r + 1] * rl1; }
            }
            asm volatile("" : "+v"(o[d0]));
        }
        LDS_WAIT();
#undef PROLOGUE
#undef DMA_K
#undef DMA_V
#undef DMA_KB
#undef DMA_VB
#undef LANE_
#undef KVO
#undef VVO
    }
#undef SBV
#undef WB
#undef QKT
#undef SOFTMAX
#undef RDV
#undef PVB
#undef PV
    if (__any(bad) && lane == 0) flag[0] = 1u;
    asm volatile("s_waitcnt lgkmcnt(0)\n\ts_barrier" ::: "memory");
    const bool redo = flag[0] != 0u;
    if (!redo) {
        const LAS float* gsl = (const LAS float*)(shm + L_GS);
        float gs[4];
#pragma unroll
        for (int d0 = 0; d0 < 4; ++d0) gs[d0] = gsl[32 * d0 + r32];
        float ss[16];
#pragma unroll
        for (int r = 0; r < 16; ++r) ss[r] = (o[0][r] * o[0][r] + o[1][r] * o[1][r]) + (o[2][r] * o[2][r] + o[3][r] * o[3][r]);
#define DPPADD_(ctrl) do { _Pragma("unroll") for (int r = 0; r < 16; ++r) ss[r] += __builtin_bit_cast(float, __builtin_amdgcn_update_dpp(0, __builtin_bit_cast(int, ss[r]), ctrl, 0xf, 0xf, true)); } while (0)
        DPPADD_(0xB1); DPPADD_(0x4E); DPPADD_(0x141); DPPADD_(0x140);
#undef DPPADD_
        float sx[16];
#pragma unroll
        for (int r = 0; r < 16; ++r) sx[r] = __builtin_bit_cast(float, __builtin_amdgcn_ds_swizzle(__builtin_bit_cast(int, ss[r]), (16 << 10) | 0x1f));
#pragma unroll
        for (int r = 0; r < 16; ++r) {
            const float rstd = __builtin_amdgcn_rsqf((ss[r] + sx[r]) * (1.f / 128.f) + EPS);
            const int orow = crow(r, hi);
            const unsigned w01 = cvt_pk_bf16(o[0][r] * rstd * gs[0], o[1][r] * rstd * gs[1]), w23 = cvt_pk_bf16(o[2][r] * rstd * gs[2], o[3][r] * rstd * gs[3]);
            stg[orow * 128 + r32] = (unsigned short)w01; stg[orow * 128 + 32 + r32] = (unsigned short)(w01 >> 16);
            stg[orow * 128 + 64 + r32] = (unsigned short)w23; stg[orow * 128 + 96 + r32] = (unsigned short)(w23 >> 16);
        }
        LDS_WAIT();
        bf16* Ow = O + (rowbase + qw) * DM + h * 128;
#pragma unroll
        for (int i = 0; i < 8; ++i) { const int idx = i * 64 + lane, row = idx >> 4, ch = idx & 15; const u32x4 v = *(const LAS u32x4*)(stg + row * 128 + ch * 8); *(u32x4*)(Ow + (long)row * DM + ch * 8) = v; }
    }
    asm volatile("s_waitcnt lgkmcnt(0)\n\ts_barrier" ::: "memory");
    return redo;
}
}

__device__ __forceinline__ void conv_unit(Frame& F, int tok0, const bf16* C, bf16* OB) {
    constexpr int CT = 32, NP = CT + 30;
    const int t = fresh_tid(), ch = 2 * t, lane = t & 63, wave = __builtin_amdgcn_readfirstlane(t >> 6);
    const float* cw = INP(I_CONVW); const float* cb = INP(I_CONVB); const float* lng = INP(I_LNG); const float* lnb = INP(I_LNB);
    LAS float* tile = (LAS float*)F.lds;
    unsigned wq0[16], wq1[16];
#pragma unroll
    for (int m = 0; m < 16; ++m) { const f32x2 wa = *(const f32x2*)(cw + (2 * m) * 1024 + ch); f32x2 wb = (f32x2){0.f, 0.f}; if (2 * m + 1 < 31) wb = *(const f32x2*)(cw + (2 * m + 1) * 1024 + ch);
        wq0[m] = cvt_pk_bf16(wa.x, wb.x); wq1[m] = cvt_pk_bf16(wa.y, wb.y); }
    const f32x2 bb = *(const f32x2*)(cb + ch);
    const int s_in_batch0 = tok0 & (SEQ - 1);
    const char* cbase = (const char*)(C + (size_t)tok0 * DM); const unsigned voff = (unsigned)ch * 2u;
#define PAIR0_(lo, hi) __builtin_amdgcn_perm(hi, lo, 0x05040100u)
#define PAIR1_(lo, hi) __builtin_amdgcn_perm(hi, lo, 0x07060302u)
#define DOT2_(a, b, c) __builtin_amdgcn_fdot2_f32_bf16(__builtin_bit_cast(bf16x2_t, a), __builtin_bit_cast(bf16x2_t, b), c, false)
    unsigned p0[NP], p1[NP], raw[CT], wlast;
    { unsigned w[NP];
#pragma unroll
      for (int i = 0; i < NP; ++i) { const int rel = i - 30; unsigned u = 0u; if (s_in_batch0 + rel >= 0) u = *(const unsigned*)(cbase + (long)rel * (DM * 2) + voff); w[i] = u; }
#pragma unroll
      for (int i = 0; i < NP - 1; ++i) { p0[i] = PAIR0_(w[i], w[i + 1]); p1[i] = PAIR1_(w[i], w[i + 1]); }
      p0[NP - 1] = w[NP - 1] & 0xffffu; p1[NP - 1] = w[NP - 1] >> 16; wlast = w[NP - 1]; }
#pragma unroll 1
    for (int k = 0; k < 128 / CT; ++k) {
#pragma unroll
        for (int i = 0; i < CT; ++i) { float a0 = bb.x, a1 = bb.y;
#pragma unroll
            for (int m = 0; m < 16; ++m) { a0 = DOT2_(p0[i + 2 * m], wq0[m], a0); a1 = DOT2_(p1[i + 2 * m], wq1[m], a1); }
            *(LAS f32x2*)(tile + i * 1024 + ch) = (f32x2){a0, a1};
            if ((i & 3) == 3) __builtin_amdgcn_sched_barrier(0); }
        {
#pragma unroll
            for (int i = 0; i < 29; ++i) { p0[i] = p0[i + CT]; p1[i] = p1[i + CT]; }
            const int r0 = CT * (k + 1);
            unsigned vo = voff; asm volatile("" : "+v"(vo));
#pragma unroll
            for (int i = 0; i < CT; ++i) { int rr = r0 + i; if (tok0 + rr > MTOK - 1) rr = MTOK - 1 - tok0; raw[i] = *(const unsigned*)(cbase + (long)rr * (DM * 2) + vo); } }
        LDS_WAIT(); __syncthreads();
        int lane_n; asm volatile("v_mbcnt_lo_u32_b32 %0, -1, 0\n\tv_mbcnt_hi_u32_b32 %0, -1, %0" : "=v"(lane_n));
        {
            constexpr int TQ = CT / 8;
            f32x4 v[TQ][4], lg[4], lb[4]; float mean[TQ], rstd[TQ];
#pragma unroll
            for (int j = 0; j < 4; ++j) { lg[j] = *(const f32x4*)(lng + lane_n * 4 + 256 * j); lb[j] = *(const f32x4*)(lnb + lane_n * 4 + 256 * j); }
#pragma unroll
            for (int q = 0; q < TQ; ++q) { const int i = wave * TQ + q; float s = 0.f;
#pragma unroll
                for (int j = 0; j < 4; ++j) { v[q][j] = *(const LAS f32x4*)(tile + i * 1024 + lane_n * 4 + 256 * j); s += (v[q][j].x + v[q][j].y) + (v[q][j].z + v[q][j].w); }
                mean[q] = s; }
#pragma unroll
            for (int q = 0; q < TQ; ++q) mean[q] = wave_sum(mean[q]) * (1.f / 1024.f);
#pragma unroll
            for (int q = 0; q < TQ; ++q) { float s2 = 0.f;
#pragma unroll
                for (int j = 0; j < 4; ++j) { v[q][j] = v[q][j] - mean[q]; s2 += (v[q][j].x * v[q][j].x + v[q][j].y * v[q][j].y) + (v[q][j].z * v[q][j].z + v[q][j].w * v[q][j].w); }
                rstd[q] = s2; }
#pragma unroll
            for (int q = 0; q < TQ; ++q) rstd[q] = __builtin_amdgcn_rsqf(wave_sum(rstd[q]) * (1.f / 1024.f) + EPS);
#pragma unroll
            for (int q = 0; q < TQ; ++q) { const int i = wave * TQ + q; bf16* orow = OB + (size_t)(tok0 + CT * k + i) * DM;
#pragma unroll
                for (int j = 0; j < 4; ++j) { const int c0 = lane_n * 4 + 256 * j;
                    f32x4 y = v[q][j] * rstd[q] * lg[j] + lb[j]; y.x = siluf_(y.x); y.y = siluf_(y.y); y.z = siluf_(y.z); y.w = siluf_(y.w);
                    u32x2 w; w.x = pk2(y.x, y.y); w.y = pk2(y.z, y.w); *(u32x2*)(orow + c0) = w; } }
        }
#pragma unroll
        for (int i = 0; i < CT; ++i) asm volatile("" : "+v"(raw[i]));
        p0[29] = PAIR0_(wlast, raw[0]); p1[29] = PAIR1_(wlast, raw[0]);
#pragma unroll
        for (int i = 0; i < CT - 1; ++i) { p0[30 + i] = PAIR0_(raw[i], raw[i + 1]); p1[30 + i] = PAIR1_(raw[i], raw[i + 1]); }
        p0[NP - 1] = raw[CT - 1] & 0xffffu; p1[NP - 1] = raw[CT - 1] >> 16; wlast = raw[CT - 1];
        LDS_WAIT(); __syncthreads();
    }
#undef PAIR0_
#undef PAIR1_
#undef DOT2_
}

using pg8::Unit; using pg8::Ops; using pg8::Acc;
#define TBUF(ws, i) ((bf16*)((ws) + WS_T + (size_t)(i) * UB))
#define GBUF(ws, i) ((bf16*)((ws) + WS_G + (size_t)(i) * UB))
struct SchedP1 { int G, c; unsigned char* ws; unsigned char* out;
    __device__ __forceinline__ bool next(int i, Unit& u) const { const int L = i * G + c; if (L >= 3072 + 128) return false;
        if (L < 3072) { pg8::tile_order(L, 128, 24, u.pm, u.pn); u.kind = 0; } else if (L < 3136) { const int x = L - 3072; u.pm = x & 15; u.pn = x >> 4; u.kind = 1; } else { const int x = L - 3136; u.pm = x & 3; u.pn = x >> 2; u.kind = 2; } return true; }
    __device__ __forceinline__ void ops(const Unit& u, Ops& o) const { o.lda2 = 2048; o.ldb2 = 2048;
        const char* XN = (const char*)out + OUT_XN; const char* WIN = (const char*)ws + WS_WIN; const char* MN = (const char*)ws + WS_MN; const char* WMKV = (const char*)ws + WS_WMKV;
        if (u.kind == 0) { o.A = XN + (size_t)u.pm * 256 * 2048; o.B = WIN + (size_t)u.pn * 256 * 2048; }
        else if (u.kind == 1) { o.A = MN + (size_t)u.pm * 256 * 2048; o.B = WMKV + (size_t)u.pn * 256 * 2048; }
        else { o.A = WMKV + (size_t)(1024 + u.pm * 256) * 2048; o.B = MN + (size_t)u.pn * 256 * 2048; } }
};
struct EpiP1 { unsigned char* ws;
    __device__ __forceinline__ bool keep(const Unit&) const { return false; }
    __device__ __forceinline__ void operator()(const Acc& acc, const Unit& u, int wr, int wc, int fr, int fq, LAS unsigned char*) const {
        const int rl = wr * 64 + fr, cl = wc * 32 + 8 * fq;
        if (u.kind == 0) {
            const int pn = u.pn; const size_t row = (size_t)u.pm * 256 + rl;
            if (pn >= 12 && pn < 20) {
                bf16* base = GBUF(ws, 2) + row * DM + (pn - 12) * 128 + cl;
#pragma unroll
                for (int ai = 0; ai < 2; ++ai)
#pragma unroll
                    for (int m = 0; m < 4; ++m) { const f32x4 a0 = acc[ai][0][m][0], a1 = acc[ai][0][m][1], g0 = acc[ai][1][m][0], g1 = acc[ai][1][m][1]; float r[8];
#pragma unroll
                        for (int e = 0; e < 4; ++e) { r[e] = a0[e] * sigmoidf_(g0[e]); r[4 + e] = a1[e] * sigmoidf_(g1[e]); }
                        u32x4 w; w.x = cvt_pk_bf16(r[0], r[1]); w.y = cvt_pk_bf16(r[2], r[3]); w.z = cvt_pk_bf16(r[4], r[5]); w.w = cvt_pk_bf16(r[6], r[7]);
                        *(u32x4*)(base + (size_t)(ai * 128 + m * 16) * DM) = w; }
            } else {
                const int grp = pn < 12 ? (pn >> 2) : 3; const float sc = (grp == 0) ? C2A : 1.f; const int cc = (pn & 3) * 256;
                const size_t boff = (grp == 0) ? WS_T : (grp == 1) ? WS_G : (grp == 2) ? (WS_G + UB) : (WS_T + 2 * UB);
                pg8::store_plain(acc, (bf16*)(ws + boff) + row * DM + cc + cl, DM, sc);
            }
        } else if (u.kind == 1) pg8::store_plain(acc, (bf16*)(ws + WS_KM) + ((size_t)u.pm * 256 + rl) * 1024 + u.pn * 256 + cl, 1024, 1.f);
        else pg8::store_plain(acc, (bf16*)(ws + WS_VT) + ((size_t)u.pm * 256 + rl) * 4096 + u.pn * 256 + cl, 4096, 1.f);
    }
};
struct SchedX { int G, v; unsigned char* ws; unsigned char* out;
    __device__ __forceinline__ bool next(int i, Unit& u) const {
        const int cnt = (512 - v + G - 1) / G;
        if (i >= 2 * cnt) return false; const int j = i % cnt; u.kind = i / cnt; u.pm = v + j * G; u.pn = j & 1; return true; }
    __device__ __forceinline__ void ops(const Unit& u, Ops& o) const { const int p = u.pm, b = p >> 5, h = (p >> 3) & 3, qb = p & 7;
        if (u.kind == 0) { o.A = (const char*)TBUF(ws, 2) + ((size_t)(b * SEQ + qb * 256) * DM + h * 256) * 2; o.lda2 = 2048; o.B = (const char*)ws + WS_KM + ((size_t)(b * 256) * 1024 + h * 256) * 2; o.ldb2 = 2048; }
        else { o.A = (const char*)out + OUT_P + (size_t)p * 131072; o.lda2 = 512; o.B = (const char*)ws + WS_VT + ((size_t)(h * 256) * 4096 + b * 256) * 2; o.ldb2 = 8192; } }
};
struct EpiX { unsigned char* ws; unsigned char* out; size_t oc_redirect;
    __device__ __forceinline__ bool keep(const Unit&) const { return false; }
    __device__ __forceinline__ void operator()(const Acc& acc, const Unit& u, int wr, int wc, int fr, int fq, LAS unsigned char* ldst) const {
        const int rl = wr * 64 + fr, cl = wc * 32 + 8 * fq; const int p = u.pm;
        LAS float* lsum = (LAS float*)(ldst + (LSUM_OFF - RING_BYTES)) + u.pn * 1024;
        if (u.kind == 0) {
            bf16* base = (bf16*)(out + OUT_P) + (size_t)p * 65536 + (size_t)rl * 256 + cl;
#pragma unroll
            for (int ai = 0; ai < 2; ++ai)
#pragma unroll
                for (int m = 0; m < 4; ++m) { float rs = 0.f;
#pragma unroll
                    for (int bj = 0; bj < 2; ++bj) { const f32x4 v0 = acc[ai][bj][m][0], v1 = acc[ai][bj][m][1]; float e[8];
#pragma unroll
                        for (int k = 0; k < 4; ++k) { e[k] = __builtin_amdgcn_exp2f(v0[k] * C2X); e[4 + k] = __builtin_amdgcn_exp2f(v1[k] * C2X); }
                        u32x4 w; w.x = cvt_pk_bf16(e[0], e[1]); w.y = cvt_pk_bf16(e[2], e[3]); w.z = cvt_pk_bf16(e[4], e[5]); w.w = cvt_pk_bf16(e[6], e[7]);
                        rs += (bflo(w.x) + bfhi(w.x)) + (bflo(w.y) + bfhi(w.y)) + (bflo(w.z) + bfhi(w.z)) + (bflo(w.w) + bfhi(w.w));
                        *(u32x4*)(base + (size_t)(ai * 128 + m * 16) * 256 + bj * 128) = w; }
                    rs += __shfl_xor(rs, 16); rs += __shfl_xor(rs, 32);
                    if (fq == 0) lsum[(ai * 128 + m * 16 + rl) * 4 + wc] = rs; }
        } else {
            const int b = p >> 5, h = (p >> 3) & 3, qb = p & 7;
            bf16* base = (bf16*)((unsigned char*)TBUF(ws, 2) + oc_redirect) + ((size_t)(b * SEQ + qb * 256) + rl) * DM + h * 256 + cl;
#pragma unroll
            for (int ai = 0; ai < 2; ++ai)
#pragma unroll
                for (int m = 0; m < 4; ++m) { const f32x4 l4 = *(const LAS f32x4*)(lsum + (ai * 128 + m * 16 + rl) * 4); const float rcp = __builtin_amdgcn_rcpf((l4.x + l4.y) + (l4.z + l4.w));
#pragma unroll
                    for (int bj = 0; bj < 2; ++bj) { const f32x4 v0 = acc[ai][bj][m][0] * rcp, v1 = acc[ai][bj][m][1] * rcp;
                        u32x4 w; w.x = cvt_pk_bf16(v0[0], v0[1]); w.y = cvt_pk_bf16(v0[2], v0[3]); w.z = cvt_pk_bf16(v1[0], v1[1]); w.w = cvt_pk_bf16(v1[2], v1[3]);
                        *(u32x4*)(base + (size_t)(ai * 128 + m * 16) * DM + bj * 128) = w; } }
        }
    }
};
struct SchedP3 { int G, c; unsigned char* ws; unsigned char* out;
    __device__ __forceinline__ bool next(int i, Unit& u) const { const int L = i * G + c; if (L >= 3072) return false; pg8::tile_order(L, 128, 24, u.pm, u.pn); u.kind = 0; return true; }
    __device__ __forceinline__ void ops(const Unit& u, Ops& o) const { o.lda2 = 2048; o.ldb2 = 2048; o.A = (const char*)out + OUT_XN + (size_t)u.pm * 256 * 2048; o.B = (const char*)ws + WS_WIN + (size_t)(6144 + u.pn * 256) * 2048; }
};
struct EpiP3 { unsigned char* ws; const float* bmerge; int rep;
    __device__ __forceinline__ bool keep(const Unit&) const { return false; }
    __device__ __forceinline__ void operator()(const Acc& acc, const Unit& u, int wr, int wc, int fr, int fq, LAS unsigned char*) const {
        const int rl = wr * 64 + fr, cl = wc * 32 + 8 * fq; const int pn = u.pn; const size_t row = (size_t)u.pm * 256 + rl;
        if (pn < 12) {
            bf16* T = TBUF(ws, pn >> 2) + row * DM + (pn & 3) * 256 + cl;
            bf16* Tw = rep ? (bf16*)(ws + WS_END) + (row * DM + (pn & 3) * 256 + cl) : T;
#define O2_(c) ((size_t)(((c) >> 3) * 128 + (((c) >> 1) & 3) * 16) * DM + ((c) & 1) * 128)
            u32x4 oq[16];
#pragma unroll
            for (int c = 0; c < 16; ++c) oq[c] = *(const u32x4*)(T + O2_(c));
            asm volatile("" ::: "memory");
#pragma unroll
            for (int c = 0; c < 16; ++c) { const int ai = c >> 3, m = (c >> 1) & 3, bj = c & 1;
                const u32x4 o = oq[c];
                const f32x4 z0 = acc[ai][bj][m][0], z1 = acc[ai][bj][m][1];
                u32x4 w; w.x = cvt_pk_bf16(bflo(o.x) * siluf_(z0[0]), bfhi(o.x) * siluf_(z0[1])); w.y = cvt_pk_bf16(bflo(o.y) * siluf_(z0[2]), bfhi(o.y) * siluf_(z0[3]));
                w.z = cvt_pk_bf16(bflo(o.z) * siluf_(z1[0]), bfhi(o.z) * siluf_(z1[1])); w.w = cvt_pk_bf16(bflo(o.w) * siluf_(z1[2]), bfhi(o.w) * siluf_(z1[3]));
                *(u32x4*)(Tw + O2_(c)) = w; asm volatile("" ::: "memory"); }
#undef O2_
        } else {
            const int gi = (pn - 12) >> 2, cc = ((pn - 12) & 3) * 256 + cl;
            bf16* Gp = GBUF(ws, gi) + row * DM + cc; const float* bp = bmerge + gi * 1024 + cc;
            const f32x4 b00 = *(const f32x4*)(bp), b01 = *(const f32x4*)(bp + 4), b10 = *(const f32x4*)(bp + 128), b11 = *(const f32x4*)(bp + 132);
#pragma unroll
            for (int ai = 0; ai < 2; ++ai)
#pragma unroll
                for (int m = 0; m < 4; ++m)
#pragma unroll
                    for (int bj = 0; bj < 2; ++bj) { const f32x4 v0 = acc[ai][bj][m][0] + (bj ? b10 : b00), v1 = acc[ai][bj][m][1] + (bj ? b11 : b01);
#define SG_(x) __builtin_bit_cast(float, max(__builtin_bit_cast(unsigned, sigmoidf_(x)), 0x0DA24260u))
                        u32x4 w; w.x = cvt_pk_bf16(SG_(v0[0]), SG_(v0[1])); w.y = cvt_pk_bf16(SG_(v0[2]), SG_(v0[3])); w.z = cvt_pk_bf16(SG_(v1[0]), SG_(v1[1])); w.w = cvt_pk_bf16(SG_(v1[2]), SG_(v1[3]));
#undef SG_
                        *(u32x4*)(Gp + (size_t)(ai * 128 + m * 16) * DM + bj * 128) = w; }
        }
    }
};
struct SchedP4 { int G, v; unsigned char* ws;
    __device__ __forceinline__ bool next(int i, Unit& u) const { const int tile = v + (i / 3) * G; if (tile >= 512) return false; u.pm = tile >> 2; u.pn = tile & 3; u.kind = i % 3; return true; }
    __device__ __forceinline__ void ops(const Unit& u, Ops& o) const { o.lda2 = 2048; o.ldb2 = 2048;
        o.A = (const char*)TBUF(ws, u.kind) + (size_t)u.pm * 256 * 2048; o.B = (const char*)ws + WS_WOA + (size_t)u.kind * (2 * MiB) + (size_t)u.pn * 256 * 2048; }
};
struct EpiP4 { unsigned char* ws; unsigned char* out;
    __device__ __forceinline__ bool keep(const Unit&) const { return true; }
    static __device__ __forceinline__ float gc(float g) { return g; }
    __device__ __forceinline__ void operator()(Acc& acc, const Unit& u, int wr, int wc, int fr, int fq, LAS unsigned char*) const {
        const int rl = wr * 64 + fr, cl = wc * 32 + 8 * fq; const size_t off = ((size_t)u.pm * 256 + rl) * DM + u.pn * 256 + cl;
        const bool lastb = u.kind == 2;
        const bf16* Ga = GBUF(ws, u.kind) + off; const bf16* Gb = GBUF(ws, lastb ? 2 : u.kind + 1) + off; bf16* Op = (bf16*)(out + OUT_P) + off;
        const float keepf = lastb ? 0.f : 1.f;
#define R_(a, b) (gc(a) * (lastb ? 1.f : __builtin_amdgcn_rcpf(gc(b))))
#define O2_(c) ((size_t)(((c) >> 3) * 128 + (((c) >> 1) & 3) * 16) * DM + ((c) & 1) * 128)
        constexpr int PD = 4;
        u32x4 gaq[PD], gbq[PD];
#pragma unroll
        for (int c = 0; c < PD; ++c) { gaq[c] = *(const u32x4*)(Ga + O2_(c)); gbq[c] = *(const u32x4*)(Gb + O2_(c)); }
#pragma unroll
        for (int c = 0; c < 16; ++c) { const int ai = c >> 3, m = (c >> 1) & 3, bj = c & 1;
            const u32x4 ga = gaq[c % PD], gb = gbq[c % PD];
            asm volatile("" :: "v"(ga), "v"(gb) : "memory");
            if (c + PD < 16) { gaq[c % PD] = *(const u32x4*)(Ga + O2_(c + PD)); gbq[c % PD] = *(const u32x4*)(Gb + O2_(c + PD)); }
            const f32x4 r0 = {R_(bflo(ga.x), bflo(gb.x)), R_(bfhi(ga.x), bfhi(gb.x)), R_(bflo(ga.y), bflo(gb.y)), R_(bfhi(ga.y), bfhi(gb.y))};
            const f32x4 r1 = {R_(bflo(ga.z), bflo(gb.z)), R_(bfhi(ga.z), bfhi(gb.z)), R_(bflo(ga.w), bflo(gb.w)), R_(bfhi(ga.w), bfhi(gb.w))};
            const f32x4 v0 = acc[ai][bj][m][0] * r0, v1 = acc[ai][bj][m][1] * r1;
            if (lastb) { u32x4 w; w.x = cvt_pk_bf16(v0[0], v0[1]); w.y = cvt_pk_bf16(v0[2], v0[3]); w.z = cvt_pk_bf16(v1[0], v1[1]); w.w = cvt_pk_bf16(v1[2], v1[3]); *(u32x4*)(Op + O2_(c)) = w; }
            acc[ai][bj][m][0] = v0 * keepf; acc[ai][bj][m][1] = v1 * keepf; asm volatile("" : "+v"(acc[ai][bj][m][0]), "+v"(acc[ai][bj][m][1])); }
#undef O2_
#undef R_
    }
};
struct SchedP5 { int G, v; unsigned char* ws; unsigned char* out;
    __device__ __forceinline__ bool next(int i, Unit& u) const { const int tile = v + i * G; if (tile >= 512) return false; u.pm = tile >> 2; u.pn = tile & 3; u.kind = 0; return true; }
    __device__ __forceinline__ void ops(const Unit& u, Ops& o) const { o.lda2 = 2048; o.ldb2 = 2048; o.A = (const char*)out + OUT_P + (size_t)u.pm * 256 * 2048; o.B = (const char*)ws + WS_WOUT + (size_t)u.pn * 256 * 2048; }
};
struct EpiP5 { unsigned char* ws;
    __device__ __forceinline__ bool keep(const Unit&) const { return false; }
    __device__ __forceinline__ void operator()(const Acc& acc, const Unit& u, int wr, int wc, int fr, int fq, LAS unsigned char*) const {
        const int rl = wr * 64 + fr, cl = wc * 32 + 8 * fq; const size_t row0 = (size_t)u.pm * 256 + rl;
        pg8::store_plain(acc, TBUF(ws, 0) + row0 * DM + u.pn * 256 + cl, DM, 1.f);
        float* rsq = (float*)TBUF(ws, 1);
#pragma unroll
        for (int ai = 0; ai < 2; ++ai)
#pragma unroll
            for (int m = 0; m < 4; ++m) { float ss = 0.f;
#pragma unroll
                for (int bj = 0; bj < 2; ++bj)
#pragma unroll
                    for (int n = 0; n < 2; ++n) { const f32x4 v = acc[ai][bj][m][n]; ss += (v[0] * v[0] + v[1] * v[1]) + (v[2] * v[2] + v[3] * v[3]); }
                ss += __shfl_xor(ss, 16); ss += __shfl_xor(ss, 32);
                if (fq == 0) rsq[(row0 + ai * 128 + m * 16) * 16 + u.pn * 4 + wc] = ss; }
    }
};

#ifndef PHMASK
#define PHMASK 0x77f
#endif
#ifndef REPMASK
#define REPMASK 0
#endif
#define REP(k) (((REPMASK >> (k)) & 1) ? 2 : 1)
#ifndef ATT_V2
#define ATT_V2 2
#endif
#ifndef NOFALLBACK
#define NOFALLBACK 0
#endif

#define TD_BEGIN(k) unsigned long long td0_##k = 0; if (TIMEDUP == (k)) td0_##k = __builtin_amdgcn_s_memrealtime();
#define TD_END(k) if (TIMEDUP == (k)) { const unsigned long long td1 = __builtin_amdgcn_s_memrealtime(); const unsigned long long until = td1 + (td1 - td0_##k); while (__builtin_amdgcn_s_memrealtime() < until) __builtin_amdgcn_s_sleep(8); }
__global__ void __launch_bounds__(512, 2) mk_fwd(Args args) {
    extern __shared__ __attribute__((aligned(16))) unsigned char lds[];
    Frame F;
    F.lds = (LAS unsigned char*)lds;
    F.tid = threadIdx.x; F.lane = F.tid & 63; F.wave = __builtin_amdgcn_readfirstlane(F.tid >> 6);
    F.G = gridDim.x; { const int bx = blockIdx.x; F.vcu = (F.G % 8 == 0) ? (bx % 8) * (F.G / 8) + bx / 8 : bx; }
    F.out = args.out; F.ws = args.ws;
    unsigned char* ws = args.ws; unsigned char* outb = (unsigned char*)args.out;
    gu32* ctl = (gu32*)(ws + WS_CTL);
    for (int u = F.tid; u < (LDS_BYTES - LDSCTL_OFF) / 4; u += 512) ((LAS unsigned*)(F.lds + LDSCTL_OFF))[u] = 0u;
    __syncthreads();
    volatile LAS unsigned* MISC = (volatile LAS unsigned*)(F.lds + MISC_OFF);
    XcdBarrier bar; bar.bar = (unsigned*)(ctl + CW_BAR); bar.x = 0; bar.st = nullptr;
    if (MK_N_LAUNCHES == 1) bar = xcd_barrier_post((unsigned*)(ctl + CW_BAR), MISC + 8);
    const int lo = args.ph_lo, hi = args.ph_hi;
#define IN(k) (((PHMASK >> (k)) & 1) && lo <= (k) && (k) < hi)
#define SEAM(k) do { if (lo <= (k) && (k) + 1 < hi) xcd_barrier(bar); } while (0)

    { TD_BEGIN(0) if (IN(0)) { for (int rep = 0; rep < REP(0); ++rep) p0_prologue(F); } TD_END(0) }
    { TD_BEGIN(10) SEAM(0); TD_END(10) }
    TD_BEGIN(1)
    if (IN(1)) {
        SchedP1 S{F.G, (int)blockIdx.x, ws, outb}; EpiP1 E{ws};
        for (int rep = 0; rep < REP(1); ++rep) pg8::gemm_phase(F.lds, 16, S, E);
        if (F.G == 256 && blockIdx.x >= 128) p0_transposes(F, true, ((int)blockIdx.x - 128) * 8 + F.wave, 128 * 8);
        else if (F.G != 256) p0_transposes(F, true, F.vcu * 8 + F.wave, F.G * 8);
    }
    TD_END(1)
    { TD_BEGIN(11) SEAM(1); TD_END(11) }
    if (IN(2)) {
        TD_BEGIN(7)
        if ((PHMASK >> 8) & 1) { for (int rep = 0; rep < REP(7); ++rep) { SchedX S{F.G, F.vcu, ws, outb}; EpiX E{ws, outb, rep ? (size_t)(WS_END - (WS_T + 2 * UB)) : (size_t)0}; pg8::gemm_phase(F.lds, 4, S, E); } }
        TD_END(7)
        TD_BEGIN(8)
        if ((PHMASK >> 9) & 1) {
            const float* lq1 = INP(I_LQ1); const float* lk1 = INP(I_LK1); const float* lq2 = INP(I_LQ2); const float* lk2 = INP(I_LK2);
            const float s1 = wave_sum(lq1[F.lane] * lk1[F.lane]), s2 = wave_sum(lq2[F.lane] * lk2[F.lane]);
            const float lam = expf(s1) - expf(s2) + 0.2f;
            const float* tab = INP(I_RELB); const float* gsub = INP(I_GSUB);
            for (int rep = 0; rep < REP(2); ++rep)
            for (int v = F.vcu; v < 256; v += F.G) {
                const int bh = v >> 1, s = v & 1;
                bool pref = false, tabok = false; bf16x8 qr[4];
                for (int i = 0; i < 4; ++i) { const int qb = (i == 0) ? s : (i == 1) ? 3 - s : (i == 2) ? 4 + s : 7 - s; const int qbn = (i == 0) ? 3 - s : (i == 1) ? 4 + s : (i == 2) ? 7 - s : -1;
                    bf16* Od = rep ? (bf16*)(ws + WS_END) : TBUF(ws, 0);
                    bool redo = (ATT_V2 == 0);
                    if (ATT_V2 != 0) for (int attempt = 0; attempt < 2; ++attempt) {
                        redo = att3::attn_unit(bh >> 3, bh & 7, qb, qbn, !pref || attempt > 0, !tabok, qr, TBUF(ws, 0), GBUF(ws, 0), GBUF(ws, 1), Od, tab, gsub, lam, F.lds);
                        tabok = true;
                        if (!redo || NOFALLBACK) break; }
                    pref = qbn >= 0;
                    if (redo && NOFALLBACK == 0) {
                        asm volatile("s_waitcnt vmcnt(0) lgkmcnt(0)\n\ts_barrier" ::: "memory");
                        att::attn_unit(bh >> 3, bh & 7, qb, TBUF(ws, 0), GBUF(ws, 0), GBUF(ws, 1), Od, tab, gsub, lam, F.lds); pref = false; tabok = false; } }
            }
        }
        __syncthreads();
        TD_END(8)
        TD_BEGIN(9)
        if ((PHMASK >> 10) & 1) for (int rep = 0; rep < REP(8); ++rep) for (int v = F.vcu; v < 256; v += F.G) conv_unit(F, v * 128, GBUF(ws, 2), TBUF(ws, 1));
        TD_END(9)
    }
    { TD_BEGIN(12) SEAM(2); TD_END(12) }
    TD_BEGIN(3)
    if (IN(3)) {
        for (int rep = 0; rep < REP(3); ++rep) { SchedP3 S{F.G, (int)blockIdx.x, ws, outb}; EpiP3 E{ws, INP(I_BMERGE), rep};
        pg8::gemm_phase(F.lds, 16, S, E); }
    }
    TD_END(3)
    { TD_BEGIN(13) SEAM(3); TD_END(13) }
    TD_BEGIN(4)
    if (IN(4)) {
        SchedP4 S{F.G, F.vcu, ws}; EpiP4 E{ws, outb};
        for (int rep = 0; rep < REP(4); ++rep) pg8::gemm_phase(F.lds, 16, S, E);
    }
    TD_END(4)
    { TD_BEGIN(14) SEAM(4); TD_END(14) }
    TD_BEGIN(5)
    if (IN(5)) {
        SchedP5 S{F.G, F.vcu, ws, outb}; EpiP5 E{ws};
        for (int rep = 0; rep < REP(5); ++rep) pg8::gemm_phase(F.lds, 16, S, E);
    }
    TD_END(5)
    { TD_BEGIN(15) SEAM(5); TD_END(15) }
    if (IN(6)) {
        const int t6 = fresh_tid(), lane6 = t6 & 63; const int gw = F.vcu * 8 + __builtin_amdgcn_readfirstlane(t6 >> 6), NGW = F.G * 8;
        const float* gp = INP(I_GPOST); const float* xin = INP(I_X); const float* RSQ = (const float*)TBUF(ws, 1); const bf16* Yb = TBUF(ws, 0);
        for (int rep = 0; rep < REP(6); ++rep)
        for (int m = gw; m < MTOK; m += NGW) {
            float ss = (lane6 < 16) ? RSQ[(size_t)m * 16 + lane6] : 0.f;
            ss = wave_sum(ss);
            const float rstd = 1.f / sqrtf(ss * (1.f / 1024.f) + EPS);
            const bf16* yr = Yb + (size_t)m * DM; const float* xr = xin + (size_t)m * DM; float* orow = F.out + (size_t)m * DM;
#pragma unroll
            for (int j = 0; j < 4; ++j) { const int c0 = lane6 * 4 + 256 * j; const u32x2 yw = *(const u32x2*)(yr + c0); const f32x4 xv = *(const f32x4*)(xr + c0), g = *(const f32x4*)(gp + c0);
                f32x4 o; o.x = xv.x + bflo(yw.x) * rstd * g.x; o.y = xv.y + bfhi(yw.x) * rstd * g.y; o.z = xv.z + bflo(yw.y) * rstd * g.z; o.w = xv.w + bfhi(yw.y) * rstd * g.w;
                *(f32x4*)(orow + c0) = o; }
        }
    }
#ifndef DUMP
#define DUMP 0
#endif
    if (DUMP == 13 && lo <= 8 && 8 < hi) {
        const int t8 = fresh_tid();
        for (size_t i = (size_t)blockIdx.x * 512 + t8; i < (size_t)MTOK * DM / 2; i += (size_t)gridDim.x * 512) ((unsigned*)TBUF(ws, 1))[i] = ((const unsigned*)(outb + OUT_P))[i];
    }
    if (DUMP && MK_N_LAUNCHES == 1) xcd_barrier(bar);
    if (DUMP && ((lo <= 7 && 7 < hi) || MK_N_LAUNCHES == 1)) {
        const int t7 = fresh_tid();
        for (size_t i = (size_t)blockIdx.x * 512 + t7; i < (size_t)MTOK * DM / 2; i += (size_t)gridDim.x * 512) {
            float a = 0.f, b = 0.f;
#define ADDB(ptr) do { const unsigned w = ((const unsigned*)(ptr))[i]; a += bflo(w); b += bfhi(w); } while (0)
            if (DUMP == 1) { ADDB(TBUF(ws, 0)); ADDB(TBUF(ws, 2)); ADDB(GBUF(ws, 0)); ADDB(GBUF(ws, 1)); ADDB(GBUF(ws, 2)); const unsigned w = ((const unsigned*)(ws + WS_KM))[i & (4096 * 512 - 1)]; a += bflo(w); b += bfhi(w); const unsigned w2 = ((const unsigned*)(ws + WS_VT))[i & (4096 * 512 - 1)]; a += bflo(w2); b += bfhi(w2); }
            if (DUMP == 2) { ADDB(TBUF(ws, 0)); ADDB(TBUF(ws, 1)); ADDB(TBUF(ws, 2)); }
            if (DUMP == 3) { ADDB(TBUF(ws, 0)); ADDB(TBUF(ws, 1)); ADDB(TBUF(ws, 2)); ADDB(GBUF(ws, 0)); ADDB(GBUF(ws, 1)); ADDB(GBUF(ws, 2)); }
            if (DUMP == 4) { ADDB(ws + WS_G + 2 * UB - 0); }
            if (DUMP == 5) { ADDB(TBUF(ws, 0)); }
            if (DUMP == 10) { ADDB(TBUF(ws, 0)); }
            if (DUMP == 11 || DUMP == 13) { ADDB(TBUF(ws, 1)); }
            if (DUMP == 12) { ADDB(TBUF(ws, 2)); }
            ((f32x2*)F.out)[i] = (f32x2){a, b};
        }
    }
#undef IN
#undef SEAM
}

extern "C" void kernel_launch(void* const* d_in, const int* in_sizes, int n_in, void* d_out, int out_size, void* d_ws, size_t ws_size, hipStream_t stream) {
    static int grid = 0;
    if (grid == 0) {
        if (n_in != 22 || in_sizes[0] != MTOK * DM || out_size != MTOK * DM || ws_size < WS_END + (REPMASK ? UB : 0)) { fprintf(stderr, "kernel_launch: unexpected shapes / workspace (n_in %d, ws %zu, need %zu)\n", n_in, ws_size, (size_t)WS_END); grid = -1; return; }
        int dev = 0, cus = 0;
        if (hipGetDevice(&dev) != hipSuccess || hipDeviceGetAttribute(&cus, hipDeviceAttributeMultiprocessorCount, dev) != hipSuccess) { grid = -1; return; }
        if (hipFuncSetAttribute((const void*)mk_fwd, hipFuncAttributeMaxDynamicSharedMemorySize, LDS_BYTES) != hipSuccess) { fprintf(stderr, "kernel_launch: hipFuncSetAttribute failed\n"); grid = -1; return; }
        int per_cu = 0;
        if (hipOccupancyMaxActiveBlocksPerMultiprocessor(&per_cu, (const void*)mk_fwd, 512, LDS_BYTES) != hipSuccess || per_cu < 1) fprintf(stderr, "kernel_launch: occupancy query says %d\n", per_cu);
        (void)hipGetLastError();
        grid = cus > 256 ? 256 : cus;
    }
    if (grid < 0) return;
    (void)hipMemsetAsync((char*)d_ws + WS_CTL, 0, CTL_ZERO_BYTES, stream);
    Args a{};
    for (int i = 0; i < 22; ++i) a.in[i] = (const float*)d_in[i];
    a.out = (float*)d_out; a.ws = (unsigned char*)d_ws;
    if (MK_N_LAUNCHES == 1) { a.ph_lo = 0; a.ph_hi = DUMP ? (DUMP >= 10 ? 3 : DUMP + 1) : N_PHASES; hipLaunchKernelGGL(mk_fwd, dim3(grid), dim3(512), LDS_BYTES, stream, a); }
    else { const int np = DUMP ? (DUMP >= 10 ? 3 : DUMP + 1) : N_PHASES;
        for (int p = 0; p < np; ++p) { a.ph_lo = p; a.ph_hi = p + 1; hipLaunchKernelGGL(mk_fwd, dim3(grid), dim3(512), LDS_BYTES, stream, a); }
        if (DUMP == 13) { a.ph_lo = 8; a.ph_hi = 9; hipLaunchKernelGGL(mk_fwd, dim3(grid), dim3(512), LDS_BYTES, stream, a); }
        if (DUMP) { a.ph_lo = 7; a.ph_hi = 8; hipLaunchKernelGGL(mk_fwd, dim3(grid), dim3(512), LDS_BYTES, stream, a); } }
}
```

```cpp
#include <hip/hip_runtime.h>
#ifndef BADTEST
#define BADTEST 0
#endif
#ifndef DUMP
#define DUMP 0
#endif
#include <cstdio>
#include <cstdint>

#define LAS __attribute__((address_space(3)))
#define GAS __attribute__((address_space(1)))
typedef unsigned short bf16;
typedef short bf16x8 __attribute__((ext_vector_type(8)));
typedef short s16x4 __attribute__((ext_vector_type(4)));
typedef float f32x4 __attribute__((ext_vector_type(4)));
typedef float f32x2 __attribute__((ext_vector_type(2)));
typedef float f32x16 __attribute__((ext_vector_type(16)));
typedef unsigned u32x4 __attribute__((ext_vector_type(4)));
typedef unsigned u32x2 __attribute__((ext_vector_type(2)));
typedef GAS unsigned gu32;

#ifndef MK_N_LAUNCHES
#define MK_N_LAUNCHES 1
#endif
constexpr int N_PHASES = 7;

constexpr int BATCH = 16, SEQ = 2048, DM = 1024, MTOK = BATCH * SEQ;
constexpr int NMEM = 256, MMEM = BATCH * NMEM;
constexpr int INW = 12288;
constexpr float EPS = 1e-6f;
constexpr float LOG2E = 1.4426950408889634f;
constexpr float C2A = 0.125f * LOG2E;
constexpr float C2X = 0.0625f * LOG2E;
constexpr int NREL = 2112;

constexpr size_t MiB = 1u << 20;
constexpr size_t WS_CTL = 0, CTL_ZERO_BYTES = 1 * MiB;
constexpr size_t WS_WIN = 2 * MiB;
constexpr size_t WS_WOA = 26 * MiB, WS_WOB = 28 * MiB, WS_WOC = 30 * MiB, WS_WOUT = 32 * MiB;
constexpr size_t WS_WMKV = 34 * MiB;
constexpr size_t WS_MN = 38 * MiB;
constexpr size_t WS_KM = 46 * MiB;
constexpr size_t WS_VT = 54 * MiB;
constexpr size_t WS_U0 = 64 * MiB, UB = 64 * MiB;
constexpr size_t WS_T = WS_U0 + 0 * UB;
constexpr size_t WS_G = WS_U0 + 3 * UB;
constexpr size_t WS_END = WS_U0 + 6 * UB;
constexpr size_t WS_XN = 448 * MiB;
constexpr size_t OUT_P = 64 * MiB;

constexpr int CW_TMO = 0;
constexpr int CW_BAR = 4096;

constexpr int RING_BYTES = 131072;
constexpr int LDS_BYTES = 163840;
constexpr int LDSCTL_OFF = LDS_BYTES - 512, MISC_OFF = LDSCTL_OFF + 320;
constexpr int LSUM_OFF = LDSCTL_OFF - 8192;
constexpr int PHASE_LDS = LSUM_OFF;

__device__ __forceinline__ int fresh_tid() { int t = threadIdx.x; asm volatile("" : "+v"(t)); return t; }
#define LDS_WAIT() asm volatile("s_waitcnt lgkmcnt(0)" ::: "memory")
#define VM_WAIT() asm volatile("s_waitcnt vmcnt(0)" ::: "memory")
#define RLX_AGENT __ATOMIC_RELAXED, __HIP_MEMORY_SCOPE_AGENT

__device__ __forceinline__ unsigned f2bf(float f) { unsigned u = __builtin_bit_cast(unsigned, f); return (u + 0x7fffu + ((u >> 16) & 1u)) >> 16; }
__device__ __forceinline__ unsigned pk2(float lo, float hi) { return f2bf(lo) | (f2bf(hi) << 16); }
typedef __bf16 bf16x2_t __attribute__((ext_vector_type(2)));
__device__ __forceinline__ unsigned cvt_pk_bf16(float lo, float hi) { f32x2 v = {lo, hi}; bf16x2_t b = __builtin_convertvector(v, bf16x2_t); return __builtin_bit_cast(unsigned, b); }
__device__ __forceinline__ float bflo(unsigned w) { return __uint_as_float(w << 16); }
__device__ __forceinline__ float bfhi(unsigned w) { return __uint_as_float(w & 0xffff0000u); }
__device__ __forceinline__ float sigmoidf_(float v) { return __builtin_amdgcn_rcpf(1.0f + __builtin_amdgcn_exp2f(-v * LOG2E)); }
__device__ __forceinline__ float siluf_(float v) { return v * sigmoidf_(v); }
__device__ __forceinline__ float wave_sum(float v) {
#define DPP_(ctrl) v += __builtin_bit_cast(float, __builtin_amdgcn_update_dpp(0, __builtin_bit_cast(int, v), ctrl, 0xf, 0xf, true))
    DPP_(0xB1); DPP_(0x4E); DPP_(0x141); DPP_(0x140);
#undef DPP_
    const int b = __builtin_bit_cast(int, v);
    return (__builtin_bit_cast(float, __builtin_amdgcn_readlane(b, 0)) + __builtin_bit_cast(float, __builtin_amdgcn_readlane(b, 16))) + (__builtin_bit_cast(float, __builtin_amdgcn_readlane(b, 32)) + __builtin_bit_cast(float, __builtin_amdgcn_readlane(b, 48)));
}

__device__ __forceinline__ int t5_bucket(int rel) {
    const int n = rel < 0 ? -rel : rel; int v;
    if (n < 8) v = n; else if (n < 12) v = 8; else if (n < 16) v = 9; else if (n < 23) v = 10; else if (n < 32) v = 11; else if (n < 46) v = 12; else if (n < 64) v = 13; else if (n < 91) v = 14; else v = 15;
    return (rel > 0 ? 16 : 0) + v;
}

#ifndef TIMEDUP
#define TIMEDUP -1
#endif
namespace pg8 {
constexpr int BM = 256, BK = 64, HALF = 128, HTB = HALF * BK * 2, NXCD = 8, WGM = 2;
__host__ __device__ __forceinline__ int lds_byte(int r, int c) { const int st = (r >> 4) * 2 + (c >> 5), rr = r & 15, cc = c & 31, ob = rr * 64 + cc * 2; return st * 1024 + (ob ^ (((ob >> 9) & 1) << 5)); }
__host__ __device__ __forceinline__ void stage_rc(int b, int& R, int& C) { const int st = b / 1024, sb = b % 1024, swz = sb ^ (((sb >> 9) & 1) << 5); R = (st >> 1) * 16 + swz / 64; C = (st & 1) * 32 + (swz % 64) / 2; }
__host__ __device__ __forceinline__ int perm32(int rho) { const int n = rho >> 4, i = rho & 15; return 8 * (i >> 2) + 4 * n + (i & 3); }

struct Unit { int pm, pn, kind; };
struct Ops { const char* A; const char* B; unsigned lda2, ldb2; };

__device__ __forceinline__ void tile_order(int L, int nM, int nN, int& pm, int& pn) {
    const int nwg = nM * nN; int wgid = L;
    { const int q = nwg / NXCD, r = nwg % NXCD, xcd = wgid % NXCD, off = wgid / NXCD; wgid = (xcd < r ? xcd * (q + 1) : r * (q + 1) + (xcd - r) * q) + off; }
    const int nig = WGM * nN, gid = wgid / nig, fm = gid * WGM, gsz = (nM - fm) < WGM ? (nM - fm) : WGM;
    pm = fm + ((wgid % nig) % gsz); pn = (wgid % nig) / gsz;
}

template <class Epi, class Sched>
__device__ __forceinline__ void gemm_phase(LAS unsigned char* lds, const int nt, const Sched& S, const Epi& E, const int ko = 0) {
    const int tid = fresh_tid(), wid = __builtin_amdgcn_readfirstlane(tid >> 6), lane = tid & 63, wr = wid >> 2, wc = wid & 3, fr = lane & 15, fq = lane >> 4;
    int sR[2], sRb[2], sC2[2];
#pragma unroll
    for (int i = 0; i < 2; ++i) { int R, C; stage_rc(tid * 16 + i * 8192, R, C); sR[i] = R; sRb[i] = (R & ~31) + perm32(R & 31); sC2[i] = C * 2; }
    const size_t kstep = (size_t)(BK * 2); const int km = nt - 1; const size_t k0off = (size_t)(ko & km) * kstep;
    const unsigned ldsw = (unsigned)wid * 1024u;
    const int aoff = lds_byte(wr * 64 + fr, fq * 8), boff = lds_byte(wc * 32 + fr, fq * 8);
#define PG8_SA(b, h) (((b) * 2 + (h)) * HTB)
#define PG8_SB(b, h) ((4 + (b) * 2 + (h)) * HTB)
#define PG8_STAGE(bufoff, gbase, v0, v1) do { \
        __builtin_amdgcn_global_load_lds((const unsigned*)((const char*)(gbase) + (v0)), (LAS unsigned*)(lds + (bufoff) + ldsw), 16, 0, 0); \
        __builtin_amdgcn_global_load_lds((const unsigned*)((const char*)(gbase) + (v1)), (LAS unsigned*)(lds + (bufoff) + ldsw + 8192), 16, 0, 0); } while (0)
#define PG8_LDA(dst, b, h) do { _Pragma("unroll") for (int m = 0; m < 4; ++m) _Pragma("unroll") for (int k = 0; k < 2; ++k) dst[m][k] = *(const LAS bf16x8*)(lds + PG8_SA(b, h) + aoff + m * 2048 + k * 1024); } while (0)
#define PG8_LDB(dst, b, h) do { _Pragma("unroll") for (int n = 0; n < 2; ++n) _Pragma("unroll") for (int k = 0; k < 2; ++k) dst[n][k] = *(const LAS bf16x8*)(lds + PG8_SB(b, h) + boff + n * 2048 + k * 1024); } while (0)
#define PG8_MMA(ai, bj, At, Bt) do { __builtin_amdgcn_s_setprio(1); _Pragma("unroll") for (int m = 0; m < 4; ++m) _Pragma("unroll") for (int n = 0; n < 2; ++n) _Pragma("unroll") for (int k = 0; k < 2; ++k) \
        acc[ai][bj][m][n] = __builtin_amdgcn_mfma_f32_16x16x32_bf16(Bt[n][k], At[m][k], acc[ai][bj][m][n], 0, 0, 0); __builtin_amdgcn_s_setprio(0); } while (0)
#define PG8_WAIT_V(n) asm volatile("s_waitcnt vmcnt(" #n ")" ::: "memory")
#define PG8_WAIT_L(n) asm volatile("s_waitcnt lgkmcnt(" #n ")" ::: "memory")
#define PG8_BAR __builtin_amdgcn_s_barrier()
#define PG8_SCHED __builtin_amdgcn_sched_barrier(0)
    Unit cur, nxt; int ui = 0;
    if (!S.next(0, cur)) return;
    Ops co, no; S.ops(cur, co);
    unsigned vA0 = sR[0] * co.lda2 + sC2[0], vA1 = sR[1] * co.lda2 + sC2[1], vB0 = sRb[0] * co.ldb2 + sC2[0], vB1 = sRb[1] * co.ldb2 + sC2[1];
    size_t hA = (size_t)HALF * co.lda2, hB = (size_t)HALF * co.ldb2;
    f32x4 acc[2][2][4][2];
#pragma unroll
    for (int a = 0; a < 2; ++a)
#pragma unroll
        for (int b = 0; b < 2; ++b)
#pragma unroll
            for (int m = 0; m < 4; ++m)
#pragma unroll
                for (int n = 0; n < 2; ++n) acc[a][b][m][n] = (f32x4){0.f, 0.f, 0.f, 0.f};
    bf16x8 At[4][2], B0[2][2], B1[2][2];
    const char* cA = co.A; const char* cB = co.B;
    PG8_STAGE(PG8_SB(0, 0), cB + k0off, vB0, vB1); PG8_STAGE(PG8_SB(0, 1), cB + hB + k0off, vB0, vB1); PG8_STAGE(PG8_SA(0, 0), cA + k0off, vA0, vA1); PG8_STAGE(PG8_SA(0, 1), cA + hA + k0off, vA0, vA1);
    if (wr == 1) PG8_BAR;
    PG8_WAIT_V(2); PG8_BAR;
    PG8_STAGE(PG8_SB(1, 0), cB + k0off + kstep, vB0, vB1); PG8_STAGE(PG8_SA(1, 0), cA + k0off + kstep, vA0, vA1); PG8_STAGE(PG8_SB(1, 1), cB + hB + k0off + kstep, vB0, vB1);
    PG8_WAIT_V(6); PG8_BAR;
    for (;;) {
        const bool has_next = S.next(ui + 1, nxt);
        if (has_next) S.ops(nxt, no); else no = co;
        const char* nA = no.A; const char* nB = no.B;
        const unsigned nvA0 = sR[0] * no.lda2 + sC2[0], nvA1 = sR[1] * no.lda2 + sC2[1], nvB0 = sRb[0] * no.ldb2 + sC2[0], nvB1 = sRb[1] * no.ldb2 + sC2[1];
        const size_t nhA = (size_t)HALF * no.lda2, nhB = (size_t)HALF * no.ldb2;
        for (int t = 0; t < nt; t += 2) {
            const bool last = (t == nt - 2);
            const char* a1 = cA + (size_t)((t + 1 + ko) & km) * kstep;
            const size_t k2 = last ? k0off : (size_t)((t + 2 + ko) & km) * kstep;
            const char* a2 = (last ? nA : cA) + k2; const char* b2 = (last ? nB : cB) + k2;
            const char* a3 = a2 + kstep; const char* b3 = b2 + kstep;
            const unsigned xA0 = last ? nvA0 : vA0, xA1 = last ? nvA1 : vA1, xB0 = last ? nvB0 : vB0, xB1 = last ? nvB1 : vB1;
            const size_t xhA = last ? nhA : hA, xhB = last ? nhB : hB;
            PG8_LDB(B0, 0, 0); PG8_LDB(B1, 0, 1); PG8_SCHED; PG8_LDA(At, 0, 0); PG8_STAGE(PG8_SA(1, 1), a1 + hA, vA0, vA1);
            PG8_WAIT_V(8); PG8_WAIT_L(0); PG8_BAR; PG8_MMA(0, 0, At, B0); PG8_MMA(0, 1, At, B1); PG8_BAR; PG8_SCHED;
            PG8_LDA(At, 0, 1); PG8_STAGE(PG8_SB(0, 0), b2, xB0, xB1); PG8_STAGE(PG8_SB(0, 1), b2 + xhB, xB0, xB1); PG8_STAGE(PG8_SA(0, 0), a2, xA0, xA1);
            PG8_WAIT_V(8); PG8_WAIT_L(0); PG8_BAR; PG8_MMA(1, 0, At, B0); PG8_MMA(1, 1, At, B1); PG8_BAR; PG8_SCHED;
            PG8_LDB(B0, 1, 0); PG8_LDB(B1, 1, 1); PG8_SCHED; PG8_LDA(At, 1, 0); PG8_STAGE(PG8_SA(0, 1), a2 + xhA, xA0, xA1);
            PG8_WAIT_V(8); PG8_WAIT_L(0); PG8_BAR; PG8_MMA(0, 0, At, B0); PG8_MMA(0, 1, At, B1); PG8_BAR; PG8_SCHED;
            PG8_LDA(At, 1, 1); PG8_STAGE(PG8_SB(1, 0), b3, xB0, xB1); PG8_STAGE(PG8_SB(1, 1), b3 + xhB, xB0, xB1); PG8_STAGE(PG8_SA(1, 0), a3, xA0, xA1);
            PG8_WAIT_V(8); PG8_WAIT_L(0); PG8_BAR; PG8_MMA(1, 0, At, B0); PG8_MMA(1, 1, At, B1); PG8_BAR; PG8_SCHED;
        }
        if (wr == 0) PG8_BAR;
        { int le = lane; asm volatile("" : "+v"(le));
          if (ui == 0) S.pre_epi(lds);
          E(acc, cur, wr, wc, le & 15, le >> 4, lds + RING_BYTES); }
        if (!has_next) break;
        if (!E.keep(cur)) {
#pragma unroll
        for (int a = 0; a < 2; ++a)
#pragma unroll
            for (int b = 0; b < 2; ++b)
#pragma unroll
                for (int m = 0; m < 4; ++m)
#pragma unroll
                    for (int n = 0; n < 2; ++n) acc[a][b][m][n] = (f32x4){0.f, 0.f, 0.f, 0.f};
        }
        cur = nxt; co = no; cA = nA; cB = nB; vA0 = nvA0; vA1 = nvA1; vB0 = nvB0; vB1 = nvB1; hA = nhA; hB = nhB; ++ui;
        if (wr == 1) PG8_BAR;
    }
    PG8_WAIT_V(0);
    PG8_BAR;
#undef PG8_SA
#undef PG8_SB
#undef PG8_STAGE
#undef PG8_LDA
#undef PG8_LDB
#undef PG8_MMA
#undef PG8_WAIT_V
#undef PG8_WAIT_L
#undef PG8_BAR
#undef PG8_SCHED
}

typedef f32x4 Acc[2][2][4][2];
__device__ __forceinline__ void store_plain(const Acc& acc, bf16* base, size_t ldc, float sc) {
#pragma unroll
    for (int ai = 0; ai < 2; ++ai)
#pragma unroll
        for (int m = 0; m < 4; ++m) { bf16* rowp = base + (size_t)(ai * HALF + m * 16) * ldc;
#pragma unroll
            for (int bj = 0; bj < 2; ++bj) { const f32x4 v0 = acc[ai][bj][m][0] * sc, v1 = acc[ai][bj][m][1] * sc;
                u32x4 w; w.x = cvt_pk_bf16(v0[0], v0[1]); w.y = cvt_pk_bf16(v0[2], v0[3]); w.z = cvt_pk_bf16(v1[0], v1[1]); w.w = cvt_pk_bf16(v1[2], v1[3]);
                *(u32x4*)(rowp + bj * HALF) = w; } }
}
}

#define XB_TMO      128
#define XB_XCNT(j)  (256  + 64 * (j))
#define XB_XSUB(j)  (1280 + 64 * (j))
#define XB_XGEN(j)  (2304 + 64 * (j))
#define XB_TOP      3328
#define XB_TOPGEN   3392
#define XCD_BAR_WORDS 3456
#define XB_SPIN_CAP (1u << 18)
__device__ __forceinline__ unsigned xb_ld(unsigned* p)              { return __hip_atomic_load(p, __ATOMIC_RELAXED, __HIP_MEMORY_SCOPE_AGENT); }
__device__ __forceinline__ unsigned xb_add(unsigned* p, unsigned v) { return __hip_atomic_fetch_add(p, v, __ATOMIC_RELAXED, __HIP_MEMORY_SCOPE_AGENT); }
__device__ __forceinline__ unsigned xb_xcc_id() { return (unsigned)__builtin_amdgcn_s_getreg((3 << 11) | 20) & 0xFu; }
#define XB_SPIN(cond, bar) do { unsigned _sp = 0; while (cond) { __builtin_amdgcn_s_sleep(1); \
    if ((++_sp & 255u) == 0u) { if (xb_ld(&(bar)[XB_TMO])) break; if (_sp > XB_SPIN_CAP) { atomicAdd(&(bar)[XB_TMO], 1u); break; } } } } while (0)
struct XcdBarrier { unsigned* bar; unsigned x; volatile LAS unsigned* st; };
__device__ __forceinline__ XcdBarrier xcd_barrier_post(unsigned* bar, volatile LAS unsigned* st) {
    XcdBarrier b; b.bar = bar; b.x = xb_xcc_id(); b.st = st;
    if (threadIdx.x == 0) (void)xb_add(&bar[XB_XCNT(b.x)], 1u);
    return b;
}
__device__ __forceinline__ void xcd_barrier_complete(unsigned* bar, unsigned x, unsigned& nloc, unsigned& nx) {
    const unsigned G = gridDim.x * gridDim.y * gridDim.z;
    unsigned sum, cnt, mine, sp = 0u;
    for (;;) {
        sum = 0u; cnt = 0u; mine = 0u;
#pragma unroll
        for (unsigned j = 0; j < 16; ++j) { const unsigned c = xb_ld(&bar[XB_XCNT(j)]); sum += c; cnt += (c > 0u) ? 1u : 0u; mine = (j == x) ? c : mine; }
        if (sum == G) break;
        __builtin_amdgcn_s_sleep(1);
        if ((++sp & 255u) == 0u) { if (xb_ld(&bar[XB_TMO])) break; if (sp > XB_SPIN_CAP) { atomicAdd(&bar[XB_TMO], 1u); break; } }
    }
    nloc = mine > 0u ? mine : 1u; nx = cnt > 0u ? cnt : 1u;
}
__device__ __forceinline__ void xcd_barrier(const XcdBarrier& b) {
    asm volatile("s_waitcnt vmcnt(0)" ::: "memory");
    __syncthreads();
    if (threadIdx.x == 0) {
        unsigned* bar = b.bar;
        __builtin_amdgcn_s_waitcnt(0);
        unsigned nloc = b.st[0], nx = b.st[1];
        if (nloc == 0u) { xcd_barrier_complete(bar, b.x, nloc, nx); b.st[0] = nloc; b.st[1] = nx; }
        const unsigned old = xb_add(&bar[XB_XSUB(b.x)], 1u);
        const unsigned gen = old / nloc;
        if (old + 1u == (gen + 1u) * nloc) {
            __builtin_amdgcn_fence(__ATOMIC_RELEASE, "agent");
            asm volatile("s_waitcnt vmcnt(0)" ::: "memory");
            (void)xb_add(&bar[XB_TOP], 1u);
        }
        XB_SPIN(xb_ld(&bar[XB_TOP]) < (gen + 1u) * nx, bar);
        __builtin_amdgcn_fence(__ATOMIC_ACQUIRE, "agent");
        asm volatile("s_waitcnt vmcnt(0)" ::: "memory");
    }
    __syncthreads();
}

__device__ __forceinline__ void xcd_barrier_arrive(const XcdBarrier& b) {
    asm volatile("s_waitcnt vmcnt(0)" ::: "memory");
    __syncthreads();
    if (threadIdx.x == 0) {
        unsigned* bar = b.bar;
        __builtin_amdgcn_s_waitcnt(0);
        const unsigned nloc = b.st[0];
        const unsigned old = xb_add(&bar[XB_XSUB(b.x)], 1u);
        const unsigned gen = old / nloc; b.st[2] = gen;
        if (old + 1u == (gen + 1u) * nloc) { __builtin_amdgcn_fence(__ATOMIC_RELEASE, "agent"); asm volatile("s_waitcnt vmcnt(0)" ::: "memory"); (void)xb_add(&bar[XB_TOP], 1u); }
    }
}
__device__ __forceinline__ void xcd_barrier_wait(unsigned* bar, volatile LAS unsigned* st) {
    if (threadIdx.x == 0) {
        const unsigned nx = st[1], gen = st[2];
        XB_SPIN(xb_ld(&bar[XB_TOP]) < (gen + 1u) * nx, bar);
        __builtin_amdgcn_fence(__ATOMIC_ACQUIRE, "agent");
        asm volatile("s_waitcnt vmcnt(0)" ::: "memory");
    }
    __syncthreads();
}
constexpr int CW_XCC = 8192, CW_GRP = 8448;
__device__ __forceinline__ void grp_barrier(unsigned* ctl, int g, unsigned k, bool same_xcd) {
    asm volatile("s_waitcnt vmcnt(0)" ::: "memory");
    __syncthreads();
    if (threadIdx.x == 0) {
        unsigned* cnt = ctl + CW_GRP + g * 16;
        if (!same_xcd) { __builtin_amdgcn_fence(__ATOMIC_RELEASE, "agent"); asm volatile("s_waitcnt vmcnt(0)" ::: "memory"); }
        (void)xb_add(cnt, 1u);
        XB_SPIN(xb_ld(cnt) < 4u * k, ctl + CW_BAR);
        __builtin_amdgcn_fence(__ATOMIC_ACQUIRE, "agent");
        asm volatile("s_waitcnt vmcnt(0)" ::: "memory");
    }
    __syncthreads();
}

struct Frame {
    LAS unsigned char* lds;
    int tid, lane, wave, vcu, G;
    float* out; unsigned char* ws;
};
struct Args { const float* in[22]; float* out; unsigned char* ws; int ph_lo, ph_hi; };
typedef __attribute__((address_space(4))) const Args* KArgs;
__device__ __forceinline__ KArgs kargs() { KArgs p = (KArgs)__builtin_amdgcn_kernarg_segment_ptr(); asm volatile("" : "+s"(p)); return p; }
#define INP(i) (kargs()->in[i])
enum { I_X = 0, I_MEM, I_RELB, I_GPRE, I_GMEM, I_WIN, I_BMERGE, I_LQ1, I_LK1, I_LQ2, I_LK2, I_GSUB, I_WOA, I_CONVW, I_CONVB, I_LNG, I_LNB, I_WOB, I_WMKV, I_WOC, I_WOUT, I_GPOST };

__device__ __forceinline__ int dest_row(int c) {
    if (c < 3072) return c;
    if (c < 4096) return 6144 + (c - 3072);
    if (c < 5120) { const int j = (c - 4096) >> 7, i = (c - 4096) & 127; return 3072 + 256 * j + i; }
    if (c < 6144) { const int j = (c - 5120) >> 7, i = (c - 5120) & 127; return 3072 + 256 * j + 128 + i; }
    if (c < 7168) return 7168 + (c - 6144);
    if (c < 8192) return 5120 + (c - 7168);
    return c;
}
__device__ __forceinline__ void p0_transpose_item(const float* W, int K, int N, bf16* WT, int k0, int n0, int drow0, LAS float* scr, int lane) {
    { const int r = lane >> 3, c4 = (lane & 7) * 4; f32x4 v[8];
#pragma unroll
      for (int p = 0; p < 8; ++p) v[p] = *(const GAS f32x4*)(W + (size_t)(k0 + 8 * p + r) * N + n0 + c4);
#pragma unroll
      for (int p = 0; p < 8; ++p) { LAS float* d = scr + (8 * p + r) * 33 + c4; d[0] = v[p].x; d[1] = v[p].y; d[2] = v[p].z; d[3] = v[p].w; } }
    LDS_WAIT(); asm volatile("" ::: "memory");
    const int c = lane & 7;
#pragma unroll
    for (int j = 0; j < 4; ++j) { const int n = (lane >> 3) + 8 * j; const LAS float* s = scr + (8 * c) * 33 + n;
        u32x4 o; o.x = pk2(s[0 * 33], s[1 * 33]); o.y = pk2(s[2 * 33], s[3 * 33]); o.z = pk2(s[4 * 33], s[5 * 33]); o.w = pk2(s[6 * 33], s[7 * 33]);
        *(GAS u32x4*)(WT + (size_t)(drow0 + n) * K + k0 + 8 * c) = o; }
    LDS_WAIT(); asm volatile("" ::: "memory");
}
template <int NR> __device__ __forceinline__ void rms_rows_to_bf16(const float* x, const float* g, bf16* o, size_t m0, size_t stride, size_t mend, int lane) {
    const GAS f32x4* gr = (const GAS f32x4*)g + lane;
    f32x4 v[NR][4];
#pragma unroll
    for (int r = 0; r < NR; ++r) { const size_t m = m0 + r * stride; if (m < mend) { const GAS f32x4* xr = (const GAS f32x4*)(x + m * DM) + lane;
#pragma unroll
            for (int j = 0; j < 4; ++j) v[r][j] = xr[64 * j]; } else {
#pragma unroll
            for (int j = 0; j < 4; ++j) v[r][j] = (f32x4){0.f, 0.f, 0.f, 0.f}; } }
    f32x4 gg[4];
#pragma unroll
    for (int j = 0; j < 4; ++j) gg[j] = gr[64 * j];
#pragma unroll
    for (int r = 0; r < NR; ++r) { const size_t m = m0 + r * stride; float s = 0.f;
#pragma unroll
        for (int j = 0; j < 4; ++j) s += (v[r][j].x * v[r][j].x + v[r][j].y * v[r][j].y) + (v[r][j].z * v[r][j].z + v[r][j].w * v[r][j].w);
        const float rstd = 1.f / sqrtf(wave_sum(s) * (1.f / 1024.f) + EPS);
        if (m < mend) { GAS unsigned long long* o8 = (GAS unsigned long long*)(o + m * DM) + lane;
#pragma unroll
            for (int j = 0; j < 4; ++j) o8[64 * j] = (unsigned long long)pk2(v[r][j].x * rstd * gg[j].x, v[r][j].y * rstd * gg[j].y) | ((unsigned long long)pk2(v[r][j].z * rstd * gg[j].z, v[r][j].w * rstd * gg[j].w) << 32); } }
}
__device__ __forceinline__ void p0_transposes(Frame& F, bool late, int gw, int NGW) {
    LAS float* scr = (LAS float*)(F.lds + F.wave * 16384);
    bf16* WIN = (bf16*)(F.ws + WS_WIN);
    constexpr int I_INH = 16 * 192, I_SQ = 16 * 32, I_KV = 16 * 64;
    const int NITEMS = late ? I_INH + 4 * I_SQ : I_INH + I_KV;
    const float* p_win = INP(I_WIN); const float* p_woa = INP(I_WOA); const float* p_wob = INP(I_WOB); const float* p_woc = INP(I_WOC); const float* p_wout = INP(I_WOUT); const float* p_wmkv = INP(I_WMKV);
    for (int it = gw; it < NITEMS; it += NGW) {
        int r = it;
        if (r < I_INH) { const int kb = r / 192, e = r % 192;
            const int nb = late ? (e < 32 ? 96 + e : e < 64 ? 160 + e : 192 + e) : (e < 96 ? e : e < 160 ? e + 32 : e + 64);
            p0_transpose_item(p_win, 1024, INW, WIN, 64 * kb, 32 * nb, dest_row(32 * nb), scr, F.lane); continue; } r -= I_INH;
        if (late) { const int w = r / I_SQ, q = r % I_SQ, kb = q / 32, nb = q % 32;
            const float* src = w == 0 ? p_woa : w == 1 ? p_wob : w == 2 ? p_woc : p_wout;
            bf16* dst = (bf16*)(F.ws + (w == 0 ? WS_WOA : w == 1 ? WS_WOB : w == 2 ? WS_WOC : WS_WOUT));
            p0_transpose_item(src, 1024, 1024, dst, 64 * kb, 32 * nb, 32 * nb, scr, F.lane); continue; }
        { const int kb = r / 64, nb = r % 64; p0_transpose_item(p_wmkv, 1024, 2048, (bf16*)(F.ws + WS_WMKV), 64 * kb, 32 * nb, 32 * nb, scr, F.lane); }
    }
}
__device__ __forceinline__ void p0_prologue(Frame& F) {
    const int gw = F.vcu * 8 + F.wave, NGW = F.G * 8;
    p0_transposes(F, false, gw, NGW);
    bf16* XN = (bf16*)(F.ws + WS_XN);
    { const float* xin = INP(I_X); const float* gpre = INP(I_GPRE);
      for (size_t m = gw; m < MTOK; m += (size_t)4 * NGW) rms_rows_to_bf16<4>(xin, gpre, XN, m, NGW, MTOK, F.lane); }
    bf16* MN = (bf16*)(F.ws + WS_MN);
    { const float* min_ = INP(I_MEM); const float* gmem = INP(I_GMEM);
      for (size_t m = gw; m < MMEM; m += (size_t)2 * NGW) rms_rows_to_bf16<2>(min_, gmem, MN, m, NGW, MMEM, F.lane); }
}

namespace att {
constexpr int L_K = 0, L_V = 16384, L_BIAS = 49152, L_WS = 49152 + NREL * 4, L_ST = L_WS + 2048, L_END = L_ST + 65536;
static_assert(L_END <= RING_BYTES, "attention LDS");
__device__ __forceinline__ int crow(int r, int hi) { return (r & 3) + 8 * (r >> 2) + 4 * hi; }
__device__ __forceinline__ void glds16(const void* gsrc, unsigned lds_dst) { unsigned keep;
    asm volatile("s_mov_b32 %0, m0\n\ts_mov_b32 m0, %2\n\ts_nop 0\n\tglobal_load_lds_dwordx4 %1, off\n\ts_mov_b32 m0, %0" : "=&s"(keep) : "v"(gsrc), "s"(lds_dst) : "memory"); }
typedef short v4i16_t __attribute__((ext_vector_type(4)));
__device__ __forceinline__ s16x4 vtr(const LAS char* p) { return __builtin_bit_cast(s16x4, __builtin_amdgcn_ds_read_tr16_b64_v4i16((LAS v4i16_t*)p)); }
#define MFMA32(a, b, c) __builtin_amdgcn_mfma_f32_32x32x16_bf16(a, b, c, 0, 0, 0)

__device__ __forceinline__ void attn_unit(int b, int h, int qb, const bf16* Q, const bf16* K, const bf16* V, bf16* O, const float* tab, const float* gsub, float lam, LAS unsigned char* shm) {
    const int tid = fresh_tid(), lane = tid & 63, r32 = lane & 31, hi = lane >> 5; const int wid = __builtin_amdgcn_readfirstlane(tid >> 6);
    const long rowbase = (long)b * SEQ; const int q0 = qb * 256, NT = q0 / 64 + 4;
    const int qw = q0 + 32 * wid, ntw = qw / 64 + 1;
    const unsigned lds0 = (unsigned)(uintptr_t)shm;
    LAS float* biasl = (LAS float*)(shm + L_BIAS);
    LAS float* wsf = (LAS float*)(shm + L_WS) + wid * 64;
    LAS unsigned short* stg = (LAS unsigned short*)(shm + L_ST + wid * 8192);
    for (int i = tid; i < NREL; i += 512) biasl[i] = tab[t5_bucket(i - 2047) * 8 + h] * LOG2E;
    const float c15 = tab[15 * 8 + h] * LOG2E;
    const LAS char* kp0 = (const LAS char*)shm + L_K + hi * 1024 + r32 * 16;
    const LAS char* vp0 = (const LAS char*)shm + L_V + ((lane >> 4) & 1) * 32 + (lane & 3) * 8 + (4 * hi + ((lane & 15) >> 2)) * 64;
    f32x16 o[4];
    for (int c = 0; c < 2; ++c) {
        const bf16* Qw = Q + (rowbase + qw) * DM + h * 128 + c * 64;
        const bf16* ksrc = K + (rowbase + lane) * DM + h * 128 + c * 64 + wid * 8;
        const int p0i = wid * 2, p1i = wid * 2 + 1;
        const bf16* vsrc0 = V + (rowbase + 16 * (p0i & 3) + (lane >> 2)) * DM + h * 128 + (p0i >> 2) * 32 + (lane & 3) * 8;
        const bf16* vsrc1 = V + (rowbase + 16 * (p1i & 3) + (lane >> 2)) * DM + h * 128 + (p1i >> 2) * 32 + (lane & 3) * 8;
#define DMA_KV(t, slot) do { glds16(ksrc + (long)(t) * 64 * DM, (unsigned)__builtin_amdgcn_readfirstlane(lds0 + L_K + (slot) * 8192 + wid * 1024)); \
        glds16(vsrc0 + (long)(t) * 64 * DM, (unsigned)__builtin_amdgcn_readfirstlane(lds0 + L_V + (slot) * 16384 + p0i * 1024)); \
        glds16(vsrc1 + (long)(t) * 64 * DM, (unsigned)__builtin_amdgcn_readfirstlane(lds0 + L_V + (slot) * 16384 + p1i * 1024)); } while (0)
        DMA_KV(0, 0);
        bf16x8 qr[4];
#pragma unroll
        for (int d0 = 0; d0 < 4; ++d0) qr[d0] = *reinterpret_cast<const bf16x8*>(&Qw[(long)r32 * DM + d0 * 16 + hi * 8]);
        asm volatile("" :: "v"(qr[0]), "v"(qr[1]), "v"(qr[2]), "v"(qr[3]));
        float m_run = -1e30f, l_run = 0.f;
#pragma unroll
        for (int d0 = 0; d0 < 4; ++d0) o[d0] = f32x16{};
        for (int t = 0; t < NT; ++t) {
            asm volatile("s_waitcnt vmcnt(0) lgkmcnt(0)\n\ts_barrier" ::: "memory");
            const int slot = t & 1;
            if (t + 1 < NT) DMA_KV(t + 1, slot ^ 1);
            if (t < ntw) {
                const LAS char* kp = kp0 + slot * 8192; const LAS char* vp = vp0 + slot * 16384;
                f32x16 p0 = f32x16{}, p1 = f32x16{};
#pragma unroll
                for (int d0 = 0; d0 < 4; ++d0) {
                    const bf16x8 k0 = *(const LAS bf16x8*)(kp + d0 * 2048), k1 = *(const LAS bf16x8*)(kp + d0 * 2048 + 512);
                    p0 = MFMA32(k0, qr[d0], p0); p1 = MFMA32(k1, qr[d0], p1);
                }
                if (64 * t + 63 - qw <= -91) {
#pragma unroll
                    for (int r = 0; r < 16; ++r) { p0[r] += c15; p1[r] += c15; }
                } else {
                    const int ib = 64 * t - qw - r32 + 2047 + 4 * hi;
#pragma unroll
                    for (int r = 0; r < 16; ++r) { const int kk = (r & 3) + 8 * (r >> 2); p0[r] += biasl[ib + kk]; p1[r] += biasl[ib + kk + 32]; }
                }
                float rm = p0[0];
#pragma unroll
                for (int r = 0; r < 16; ++r) { rm = fmaxf(rm, p0[r]); rm = fmaxf(rm, p1[r]); }
                rm = fmaxf(rm, __shfl_xor(rm, 32));
                const float m_new = fmaxf(m_run, rm), alpha = __builtin_amdgcn_exp2f(m_run - m_new);
                m_run = m_new;
                float rs = 0.f;
#pragma unroll
                for (int r = 0; r < 16; ++r) { p0[r] = __builtin_amdgcn_exp2f(p0[r] - m_new); p1[r] = __builtin_amdgcn_exp2f(p1[r] - m_new); }
                u32x4 pw[4];
#pragma unroll
                for (int ks = 0; ks < 2; ++ks)
#pragma unroll
                    for (int j = 0; j < 4; ++j) { pw[ks][j] = cvt_pk_bf16(p0[8 * ks + 2 * j], p0[8 * ks + 2 * j + 1]); pw[2 + ks][j] = cvt_pk_bf16(p1[8 * ks + 2 * j], p1[8 * ks + 2 * j + 1]); }
#pragma unroll
                for (int ks = 0; ks < 4; ++ks)
#pragma unroll
                    for (int j = 0; j < 4; ++j) rs += bflo(pw[ks][j]) + bfhi(pw[ks][j]);
                l_run = l_run * alpha + rs;
                if (__any(alpha != 1.0f)) {
                    if (hi == 0) wsf[r32] = alpha;
                    LDS_WAIT();
#pragma unroll
                    for (int r = 0; r < 16; ++r) { const float a = wsf[crow(r, hi)];
#pragma unroll
                        for (int d0 = 0; d0 < 4; ++d0) o[d0][r] *= a; }
                }
#pragma unroll
                for (int d0 = 0; d0 < 4; ++d0)
#pragma unroll
                    for (int ks = 0; ks < 4; ++ks) {
                        const s16x4 lo = vtr(vp + d0 * 4096 + ks * 1024), hh = vtr(vp + d0 * 4096 + ks * 1024 + 512);
                        const bf16x8 vb = (bf16x8){lo[0], lo[1], lo[2], lo[3], hh[0], hh[1], hh[2], hh[3]};
                        o[d0] = MFMA32(__builtin_bit_cast(bf16x8, pw[ks]), vb, o[d0]);
                    }
            }
        }
        asm volatile("s_waitcnt lgkmcnt(0)\n\ts_barrier" ::: "memory");
        l_run += __shfl_xor(l_run, 32);
        if (hi == 0) wsf[32 + r32] = l_run;
        LDS_WAIT();
        LAS unsigned* stash = (LAS unsigned*)stg;
        if (c == 0) {
#pragma unroll
            for (int r = 0; r < 16; r += 2) { const float rl0 = __builtin_amdgcn_rcpf(wsf[32 + crow(r, hi)]), rl1 = __builtin_amdgcn_rcpf(wsf[32 + crow(r + 1, hi)]);
#pragma unroll
                for (int d0 = 0; d0 < 4; ++d0) stash[(d0 * 8 + (r >> 1)) * 64 + lane] = cvt_pk_bf16(o[d0][r] * rl0, o[d0][r + 1] * rl1); }
        } else {
#pragma unroll
            for (int r = 0; r < 16; r += 2) { const float rl0 = __builtin_amdgcn_rcpf(wsf[32 + crow(r, hi)]), rl1 = __builtin_amdgcn_rcpf(wsf[32 + crow(r + 1, hi)]);
#pragma unroll
                for (int d0 = 0; d0 < 4; ++d0) { const unsigned w = stash[(d0 * 8 + (r >> 1)) * 64 + lane]; o[d0][r] = bflo(w) - lam * (o[d0][r] * rl0); o[d0][r + 1] = bfhi(w) - lam * (o[d0][r + 1] * rl1); } }
        }
        LDS_WAIT();
#undef DMA_KV
    }
    float gs[4];
#pragma unroll
    for (int d0 = 0; d0 < 4; ++d0) gs[d0] = gsub[32 * d0 + r32] * 0.8f;
#pragma unroll
    for (int r = 0; r < 16; ++r) {
        float ss = 0.f;
#pragma unroll
        for (int d0 = 0; d0 < 4; ++d0) ss += o[d0][r] * o[d0][r];
#pragma unroll
        for (int x = 1; x < 32; x <<= 1) ss += __shfl_xor(ss, x);
        const float rstd = 1.f / sqrtf(ss * (1.f / 128.f) + EPS);
        const int orow = crow(r, hi);
#pragma unroll
        for (int d0 = 0; d0 < 4; ++d0) stg[orow * 128 + d0 * 32 + r32] = (unsigned short)f2bf(o[d0][r] * rstd * gs[d0]);
    }
    LDS_WAIT();
    bf16* Ow = O + (rowbase + qw) * DM + h * 128;
#pragma unroll
    for (int i = 0; i < 8; ++i) { const int idx = i * 64 + lane, row = idx >> 4, ch = idx & 15; const u32x4 v = *(const LAS u32x4*)(stg + row * 128 + ch * 8); *(u32x4*)(Ow + (long)row * DM + ch * 8) = v; }
    asm volatile("s_waitcnt lgkmcnt(0)\n\ts_barrier" ::: "memory");
}
}

namespace att2 {
using att::crow; using att::glds16; using att::vtr;
constexpr int NSK = 3, NSV = 3;
constexpr int L_K = 0, L_V = NSK * 8192, L_BIAS = L_V + NSV * 16384, L_WS = L_BIAS + NREL * 4, L_FLAG = L_WS + 2048, L_ST = L_FLAG + 64, L_END = L_ST + 65536;
static_assert(L_END <= PHASE_LDS, "attention LDS");
__device__ __forceinline__ bool attn_unit(int b, int h, int qb, const bf16* Q, const bf16* K, const bf16* V, bf16* O, const float* tab, const float* gsub, float lam, LAS unsigned char* shm) {
    const int tid = fresh_tid(), lane = tid & 63, r32 = lane & 31, hi = lane >> 5; const int wid = __builtin_amdgcn_readfirstlane(tid >> 6);
    const long rowbase = (long)b * SEQ; const int q0 = qb * 256, NT = q0 / 64 + 4;
    const int grp = wid >> 2, blk = (wid & 3) * 2 + grp;
    const int qw = q0 + 32 * blk, ntw = qw / 64 + 1;
    const unsigned lds0 = (unsigned)(uintptr_t)shm;
    LAS float* biasl = (LAS float*)(shm + L_BIAS);
    LAS float* wsf = (LAS float*)(shm + L_WS) + wid * 64;
    LAS unsigned short* stg = (LAS unsigned short*)(shm + L_ST + wid * 8192);
    LAS unsigned* flag = (LAS unsigned*)(shm + L_FLAG);
    { const float b15 = tab[15 * 8 + h]; for (int i = tid; i < NREL; i += 512) biasl[i] = (tab[t5_bucket(i - 2047) * 8 + h] - b15) * LOG2E; }
    if (tid == 0) flag[0] = 0u;
    const LAS char* kp0 = (const LAS char*)shm + L_K + hi * 1024 + r32 * 16;
    const LAS char* vp0 = (const LAS char*)shm + L_V + ((lane >> 4) & 1) * 32 + (lane & 3) * 8 + (4 * hi + ((lane & 15) >> 2)) * 64;
    f32x16 o[4]; bool bad = false;
    for (int c = 0; c < 2; ++c) {
        const bf16* Qw = Q + (rowbase + qw) * DM + h * 128 + c * 64;
        const bf16* ksrc = K + (rowbase + lane) * DM + h * 128 + c * 64 + wid * 8;
        const int p0i = wid * 2, p1i = wid * 2 + 1;
        const bf16* vsrc0 = V + (rowbase + 16 * (p0i & 3) + (lane >> 2)) * DM + h * 128 + (p0i >> 2) * 32 + (lane & 3) * 8;
        const bf16* vsrc1 = V + (rowbase + 16 * (p1i & 3) + (lane >> 2)) * DM + h * 128 + (p1i >> 2) * 32 + (lane & 3) * 8;
#define DMA_K(t, slot) glds16(ksrc + (long)(t) * 64 * DM, (unsigned)__builtin_amdgcn_readfirstlane(lds0 + L_K + (slot) * 8192 + wid * 1024))
#define DMA_V(t, slot) do { glds16(vsrc0 + (long)(t) * 64 * DM, (unsigned)__builtin_amdgcn_readfirstlane(lds0 + L_V + (slot) * 16384 + p0i * 1024)); \
        glds16(vsrc1 + (long)(t) * 64 * DM, (unsigned)__builtin_amdgcn_readfirstlane(lds0 + L_V + (slot) * 16384 + p1i * 1024)); } while (0)
        DMA_K(0, 0); DMA_V(0, 0); DMA_K(1, 1);
        bf16x8 qr[4];
#pragma unroll
        for (int d0 = 0; d0 < 4; ++d0) qr[d0] = *reinterpret_cast<const bf16x8*>(&Qw[(long)r32 * DM + d0 * 16 + hi * 8]);
        asm volatile("" :: "v"(qr[0]), "v"(qr[1]), "v"(qr[2]), "v"(qr[3]));
        float l_run = 0.f;
#pragma unroll
        for (int d0 = 0; d0 < 4; ++d0) o[d0] = f32x16{};
        u32x4 pw[4];
#pragma unroll
        for (int ks = 0; ks < 4; ++ks) pw[ks] = (u32x4){0u, 0u, 0u, 0u};
        for (int hs = 0; hs <= 2 * NT + 1; ++hs) {
            const int g = hs >> 1;
            if ((hs & 1) == 0) {
#define WB(N) asm volatile("s_waitcnt vmcnt(" #N ") lgkmcnt(0)\n\ts_barrier" ::: "memory")
                if (g + 1 < NT) WB(1); else WB(0);
#undef WB
                if (g + 1 < NT) DMA_V(g + 1, (g + 1) % 3);
                if (g + 2 < NT) DMA_K(g + 2, (g + 2) % 3);
            }
            const int j = hs - grp;
            if (j >= 0) {
                const int t = j >> 1;
                if (t < ntw) {
                    if ((j & 1) == 0) {
                        const LAS char* kp = kp0 + (t % 3) * 8192;
                        bf16x8 kf[8];
#pragma unroll
                        for (int d0 = 0; d0 < 4; ++d0) { kf[2 * d0] = *(const LAS bf16x8*)(kp + d0 * 2048); kf[2 * d0 + 1] = *(const LAS bf16x8*)(kp + d0 * 2048 + 512); }
                        __builtin_amdgcn_sched_barrier(0);
                        __builtin_amdgcn_s_setprio(1);
                        f32x16 p0 = MFMA32(kf[0], qr[0], (f32x16){}), p1 = MFMA32(kf[1], qr[0], (f32x16){});
#pragma unroll
                        for (int d0 = 1; d0 < 4; ++d0) { p0 = MFMA32(kf[2 * d0], qr[d0], p0); p1 = MFMA32(kf[2 * d0 + 1], qr[d0], p1); }
                        __builtin_amdgcn_s_setprio(0);
                        if (64 * t + 63 - qw > -91) {
                            const int ib = 64 * t - qw - r32 + 2047 + 4 * hi;
#pragma unroll
                            for (int r = 0; r < 16; ++r) { const int kk = (r & 3) + 8 * (r >> 2); p0[r] += biasl[ib + kk]; p1[r] += biasl[ib + kk + 32]; } }
                        float rs = 0.f;
#pragma unroll
                        for (int r = 0; r < 16; ++r) { p0[r] = __builtin_amdgcn_exp2f(p0[r]); p1[r] = __builtin_amdgcn_exp2f(p1[r]); }
#pragma unroll
                        for (int r = 0; r < 16; ++r) rs += p0[r] + p1[r];
                        l_run += rs;
#pragma unroll
                        for (int ks = 0; ks < 2; ++ks)
#pragma unroll
                            for (int q = 0; q < 4; ++q) { pw[ks][q] = cvt_pk_bf16(p0[8 * ks + 2 * q], p0[8 * ks + 2 * q + 1]); pw[2 + ks][q] = cvt_pk_bf16(p1[8 * ks + 2 * q], p1[8 * ks + 2 * q + 1]); }
                    } else {
                        const LAS char* vp = vp0 + (t % 3) * 16384;
                        s16x4 va[8], vb[8];
#define RDV(dst, d0) do { _Pragma("unroll") for (int ks = 0; ks < 4; ++ks) { dst[2 * ks] = vtr(vp + (d0) * 4096 + ks * 1024); dst[2 * ks + 1] = vtr(vp + (d0) * 4096 + ks * 1024 + 512); } } while (0)
#define PVB(src, d0) do { _Pragma("unroll") for (int ks = 0; ks < 4; ++ks) { const bf16x8 vv = (bf16x8){src[2 * ks][0], src[2 * ks][1], src[2 * ks][2], src[2 * ks][3], src[2 * ks + 1][0], src[2 * ks + 1][1], src[2 * ks + 1][2], src[2 * ks + 1][3]}; \
                            o[d0] = MFMA32(__builtin_bit_cast(bf16x8, pw[ks]), vv, o[d0]); } } while (0)
                        RDV(va, 0); RDV(vb, 1); __builtin_amdgcn_sched_barrier(0);
                        PVB(va, 0); __builtin_amdgcn_sched_barrier(0);
                        RDV(va, 2); __builtin_amdgcn_sched_barrier(0);
                        PVB(vb, 1); __builtin_amdgcn_sched_barrier(0);
                        RDV(vb, 3); __builtin_amdgcn_sched_barrier(0);
                        PVB(va, 2); __builtin_amdgcn_sched_barrier(0);
                        PVB(vb, 3);
#undef RDV
#undef PVB
                    }
                }
            }
        }
        asm volatile("s_waitcnt lgkmcnt(0)\n\ts_barrier" ::: "memory");
        l_run += __shfl_xor(l_run, 32);
        bad = bad || (BADTEST == 1 ? false : BADTEST == 2 ? !(l_run == l_run) : BADTEST == 3 ? !(l_run > 1e-30f) : BADTEST == 4 ? !(l_run < 1e30f) : !(l_run > 1e-30f && l_run < 1e30f));
        if (hi == 0) wsf[32 + r32] = l_run;
        LDS_WAIT();
        LAS unsigned* stash = (LAS unsigned*)stg;
        if (c == 0) {
#pragma unroll
            for (int r = 0; r < 16; r += 2) { const float rl0 = __builtin_amdgcn_rcpf(wsf[32 + crow(r, hi)]), rl1 = __builtin_amdgcn_rcpf(wsf[32 + crow(r + 1, hi)]);
#pragma unroll
                for (int d0 = 0; d0 < 4; ++d0) stash[(d0 * 8 + (r >> 1)) * 64 + lane] = cvt_pk_bf16(o[d0][r] * rl0, o[d0][r + 1] * rl1); }
        } else {
#pragma unroll
            for (int r = 0; r < 16; r += 2) { const float rl0 = __builtin_amdgcn_rcpf(wsf[32 + crow(r, hi)]), rl1 = __builtin_amdgcn_rcpf(wsf[32 + crow(r + 1, hi)]);
#pragma unroll
                for (int d0 = 0; d0 < 4; ++d0) { const unsigned w = stash[(d0 * 8 + (r >> 1)) * 64 + lane]; o[d0][r] = bflo(w) - lam * (o[d0][r] * rl0); o[d0][r + 1] = bfhi(w) - lam * (o[d0][r + 1] * rl1); } }
        }
        LDS_WAIT();
#undef DMA_K
#undef DMA_V
    }
    if (__any(bad) && lane == 0) flag[0] = 1u;
    asm volatile("s_waitcnt lgkmcnt(0)\n\ts_barrier" ::: "memory");
    const bool redo = flag[0] != 0u;
    if (!redo) {
        float gs[4];
#pragma unroll
        for (int d0 = 0; d0 < 4; ++d0) gs[d0] = gsub[32 * d0 + r32] * 0.8f;
#pragma unroll
        for (int r = 0; r < 16; ++r) {
            float ss = 0.f;
#pragma unroll
            for (int d0 = 0; d0 < 4; ++d0) ss += o[d0][r] * o[d0][r];
#pragma unroll
            for (int x = 1; x < 32; x <<= 1) ss += __shfl_xor(ss, x);
            const float rstd = 1.f / sqrtf(ss * (1.f / 128.f) + EPS);
            const int orow = crow(r, hi);
#pragma unroll
            for (int d0 = 0; d0 < 4; ++d0) stg[orow * 128 + d0 * 32 + r32] = (unsigned short)f2bf(o[d0][r] * rstd * gs[d0]);
        }
        LDS_WAIT();
        bf16* Ow = O + (rowbase + qw) * DM + h * 128;
#pragma unroll
        for (int i = 0; i < 8; ++i) { const int idx = i * 64 + lane, row = idx >> 4, ch = idx & 15; const u32x4 v = *(const LAS u32x4*)(stg + row * 128 + ch * 8); *(u32x4*)(Ow + (long)row * DM + ch * 8) = v; }
    }
    asm volatile("s_waitcnt lgkmcnt(0)\n\ts_barrier" ::: "memory");
    return redo;
}
}

namespace att3 {
using att::crow; using att::vtr;
__device__ __forceinline__ void glds16s(const void* sbase, unsigned voff, unsigned lds_dst) { unsigned keep;
    asm volatile("s_mov_b32 %0, m0\n\ts_mov_b32 m0, %3\n\ts_nop 0\n\tglobal_load_lds_dwordx4 %1, %2\n\ts_mov_b32 m0, %0" : "=&s"(keep) : "v"(voff), "s"(sbase), "s"(lds_dst) : "memory"); }
constexpr int L_K = 0, L_V = 3 * 8192, L_BIAS = L_V + 3 * 16384, L_WS = L_BIAS + NREL * 4, L_FLAG = L_WS + 2048, L_GS = L_FLAG + 64, L_ST = L_GS + 512, L_END = L_ST + 65536;
static_assert(L_END <= PHASE_LDS, "attention LDS");
__device__ __forceinline__ bool attn_unit(int b, int h, int qb, int qb_next, bool first, bool build_tab, bf16x8 (&qr)[4], const bf16* Q, const bf16* K, const bf16* V, bf16* O, const float* tab, const float* gsub, float lam, LAS unsigned char* shm) {
    const int tid = fresh_tid(), lane = tid & 63, r32 = lane & 31, hi = lane >> 5; const int wid = __builtin_amdgcn_readfirstlane(tid >> 6);
    const long rowbase = (long)b * SEQ; const int q0 = qb * 256, NT = q0 / 64 + 4;
    const int blk = (((wid >> 2) ? 3 - ((wid & 3) >> 1) : ((wid & 3) >> 1)) << 1) + (wid & 1);
    const int qw = q0 + 32 * blk, ntw = qw / 64 + 1;
    const unsigned lds0 = (unsigned)(uintptr_t)shm;
    LAS float* biasl = (LAS float*)(shm + L_BIAS);
    LAS float* wsf = (LAS float*)(shm + L_WS) + wid * 64;
    LAS unsigned short* stg = (LAS unsigned short*)(shm + L_ST + wid * 8192);
    LAS unsigned* flag = (LAS unsigned*)(shm + L_FLAG);
    if (first) asm volatile("s_waitcnt vmcnt(0) lgkmcnt(0)\n\ts_barrier" ::: "memory");
    if (build_tab) { const float b15 = tab[15 * 8 + h];
                     for (int i = 1856 + tid; i < NREL; i += 512) biasl[i] = (tab[t5_bucket(i - 2047) * 8 + h] - b15) * LOG2E;
                     if (tid < 128) ((LAS float*)(shm + L_GS))[tid] = gsub[tid] * 0.8f; }
    if (tid == 0) flag[0] = 0u;
    const LAS char* kp0 = (const LAS char*)shm + L_K + hi * 1024 + r32 * 16;
    const LAS char* vp0 = (const LAS char*)shm + L_V + ((lane >> 4) & 1) * 32 + (lane & 3) * 8 + (4 * hi + ((lane & 15) >> 2)) * 64;
    const int ibase = -qw - r32 + 2047 + 4 * hi;
    f32x16 o[4]; bool bad = false;
#define SBV __builtin_amdgcn_sched_barrier(0x406)
#define WB(N) asm volatile("s_waitcnt vmcnt(" #N ") lgkmcnt(0)\n\ts_barrier" ::: "memory")
#define QKT(P0, P1, t) do { int so_ = ((t) % 3) * 8192; asm volatile("" : "+s"(so_)); const LAS char* kp_ = kp0 + so_; bf16x8 kf[8]; \
        _Pragma("unroll") for (int d0 = 0; d0 < 4; ++d0) { kf[2 * d0] = *(const LAS bf16x8*)(kp_ + d0 * 2048); kf[2 * d0 + 1] = *(const LAS bf16x8*)(kp_ + d0 * 2048 + 512); } \
        __builtin_amdgcn_sched_barrier(0);     \
        P0 = MFMA32(kf[0], qr[0], (f32x16){}); P1 = MFMA32(kf[1], qr[0], (f32x16){}); \
        _Pragma("unroll") for (int d0 = 1; d0 < 4; ++d0) { P0 = MFMA32(kf[2 * d0], qr[d0], P0); P1 = MFMA32(kf[2 * d0 + 1], qr[d0], P1); } \
        if (64 * (t) + 63 - qw > -91) { const int ib = 64 * (t) + ibase; \
            _Pragma("unroll") for (int r = 0; r < 16; ++r) { const int kk = (r & 3) + 8 * (r >> 2); P0[r] += biasl[ib + kk]; P1[r] += biasl[ib + kk + 32]; } } } while (0)
#define SOFTMAX(P0, P1, PW) do { float rs = 0.f; \
        _Pragma("unroll") for (int r = 0; r < 16; ++r) { P0[r] = __builtin_amdgcn_exp2f(P0[r]); P1[r] = __builtin_amdgcn_exp2f(P1[r]); } \
        _Pragma("unroll") for (int r = 0; r < 16; ++r) rs += P0[r] + P1[r]; \
        l_run += rs; \
        _Pragma("unroll") for (int ks = 0; ks < 2; ++ks) _Pragma("unroll") for (int q = 0; q < 4; ++q) { PW[ks][q] = cvt_pk_bf16(P0[8 * ks + 2 * q], P0[8 * ks + 2 * q + 1]); PW[2 + ks][q] = cvt_pk_bf16(P1[8 * ks + 2 * q], P1[8 * ks + 2 * q + 1]); } } while (0)
#define RDV(dst, d0) do { _Pragma("unroll") for (int ks = 0; ks < 4; ++ks) { dst[2 * ks] = vtr(vp + (d0) * 4096 + ks * 1024); dst[2 * ks + 1] = vtr(vp + (d0) * 4096 + ks * 1024 + 512); } } while (0)
#define PVB(src, d0) do { _Pragma("unroll") for (int ks = 0; ks < 4; ++ks) { const bf16x8 vv = (bf16x8){src[2 * ks][0], src[2 * ks][1], src[2 * ks][2], src[2 * ks][3], src[2 * ks + 1][0], src[2 * ks + 1][1], src[2 * ks + 1][2], src[2 * ks + 1][3]}; \
        o[d0] = MFMA32(__builtin_bit_cast(bf16x8, pw[ks]), vv, o[d0]); } } while (0)
#define PV(t) do { int so_ = ((t) % 3) * 16384; asm volatile("" : "+s"(so_)); const LAS char* vp = vp0 + so_; s16x4 va[8]; \
        RDV(va, 0); SBV; PVB(va, 0); SBV; RDV(va, 1); SBV; PVB(va, 1); SBV; RDV(va, 2); SBV; PVB(va, 2); SBV; RDV(va, 3); SBV; PVB(va, 3); } while (0)
    for (int c = 0; c < 2; ++c) {
        const bf16* Qw = Q + (rowbase + qw) * DM + h * 128 + c * 64;
        const bf16* kbase = K + rowbase * DM + h * 128 + c * 64;
        const bf16* vbase = V + rowbase * DM + h * 128;
        const int p0i = wid * 2, p1i = wid * 2 + 1;
#define LANE_() ({ int l_ = lane; asm volatile("" : "+v"(l_)); l_; })
#define KVO() ((unsigned)((LANE_() * DM + wid * 8) * 2))
#define VVO(pi) ({ const int l2_ = LANE_(); (unsigned)(((16 * ((pi) & 3) + (l2_ >> 2)) * DM + ((pi) >> 2) * 32 + (l2_ & 3) * 8) * 2); })
#define DMA_KB(kb, t) glds16s((kb) + (size_t)(t) * 64 * DM, KVO(), (unsigned)__builtin_amdgcn_readfirstlane(lds0 + L_K + ((t) % 3) * 8192 + wid * 1024))
#define DMA_VB(vb, t) do { glds16s((vb) + (size_t)(t) * 64 * DM, VVO(p0i), (unsigned)__builtin_amdgcn_readfirstlane(lds0 + L_V + ((t) % 3) * 16384 + p0i * 1024)); \
        glds16s((vb) + (size_t)(t) * 64 * DM, VVO(p1i), (unsigned)__builtin_amdgcn_readfirstlane(lds0 + L_V + ((t) % 3) * 16384 + p1i * 1024)); } while (0)
#define DMA_K(t) DMA_KB(kbase, t)
#define DMA_V(t) DMA_VB(vbase, t)
#define PROLOGUE(kb, vb, qp) do { DMA_KB(kb, 0); DMA_VB(vb, 0); DMA_KB(kb, 1); DMA_VB(vb, 1); DMA_KB(kb, 2); \
        { const int lq_ = LANE_(); _Pragma("unroll") for (int d0 = 0; d0 < 4; ++d0) qr[d0] = *reinterpret_cast<const bf16x8*>(&(qp)[(long)(lq_ & 31) * DM + d0 * 16 + (lq_ >> 5) * 8]); } } while (0)
        if (c == 0 && first) PROLOGUE(kbase, vbase, Qw);
        asm volatile("" :: "v"(qr[0]), "v"(qr[1]), "v"(qr[2]), "v"(qr[3]));
        float l_run = 0.f;
#pragma unroll
        for (int d0 = 0; d0 < 4; ++d0) o[d0] = f32x16{};
        u32x4 pw[4];
        WB(0);
        { f32x16 s0, s1; QKT(s0, s1, 0); SOFTMAX(s0, s1, pw); }
        for (int t = 0; t < NT; ++t) {
            if (t + 2 < NT) WB(3); else if (t + 1 < NT) WB(2); else WB(0);
            if (t + 2 < NT) DMA_V(t + 2);
            if (t + 3 < NT) DMA_K(t + 3);
            if (t < ntw) {
                if (t + 1 < ntw) {
                    f32x16 n0, n1; u32x4 pwn[4];
                    QKT(n0, n1, t + 1);
                    __builtin_amdgcn_sched_barrier(0);
                    {
                        int so_ = (t % 3) * 16384; asm volatile("" : "+s"(so_)); const LAS char* vp = vp0 + so_;
                        s16x4 vl[4], vh[4]; float rs = 0.f;
#define VRD_(i) do { vl[(i) & 3] = vtr(vp + ((i) >> 2) * 4096 + ((i) & 3) * 1024); vh[(i) & 3] = vtr(vp + ((i) >> 2) * 4096 + ((i) & 3) * 1024 + 512); } while (0)
#define VFR_(i) (bf16x8){vl[(i) & 3][0], vl[(i) & 3][1], vl[(i) & 3][2], vl[(i) & 3][3], vh[(i) & 3][0], vh[(i) & 3][1], vh[(i) & 3][2], vh[(i) & 3][3]}
#define PIN_(x) asm volatile("" : "+v"(x))
#define GAP_(i, N, j) do { if ((i) + 2 < 16) VRD_((i) + 2); \
                            o[(i) >> 2] = MFMA32(__builtin_bit_cast(bf16x8, pw[(i) & 3]), VFR_(i), o[(i) >> 2]); PIN_(o[(i) >> 2]); \
                            N[j] = __builtin_amdgcn_exp2f(N[j]); N[(j) + 1] = __builtin_amdgcn_exp2f(N[(j) + 1]); PIN_(N); \
                            __builtin_amdgcn_sched_barrier(0); } while (0)
#define FIN_(i, N, j) do { rs += N[j] + N[(j) + 1]; pwn[(i) >> 2][(i) & 3] = cvt_pk_bf16(N[j], N[(j) + 1]); PIN_(rs); PIN_(pwn[(i) >> 2]); } while (0)
                        VRD_(0); VRD_(1); __builtin_amdgcn_sched_barrier(0);
                        GAP_(0, n0, 0);
                        FIN_(0, n0, 0);  GAP_(1, n0, 2);
                        FIN_(1, n0, 2);  GAP_(2, n0, 4);
                        FIN_(2, n0, 4);  GAP_(3, n0, 6);
                        FIN_(3, n0, 6);  GAP_(4, n0, 8);
                        FIN_(4, n0, 8);  GAP_(5, n0, 10);
                        FIN_(5, n0, 10); GAP_(6, n0, 12);
                        FIN_(6, n0, 12); GAP_(7, n0, 14);
                        FIN_(7, n0, 14); GAP_(8, n1, 0);
                        FIN_(8, n1, 0);  GAP_(9, n1, 2);
                        FIN_(9, n1, 2);  GAP_(10, n1, 4);
                        FIN_(10, n1, 4); GAP_(11, n1, 6);
                        FIN_(11, n1, 6); GAP_(12, n1, 8);
                        FIN_(12, n1, 8); GAP_(13, n1, 10);
                        FIN_(13, n1, 10); GAP_(14, n1, 12);
                        FIN_(14, n1, 12); GAP_(15, n1, 14);
                        FIN_(15, n1, 14);
                        l_run += rs;
#undef VRD_
#undef VFR_
#undef PIN_
#undef GAP_
#undef FIN_
                    }
#pragma unroll
                    for (int ks = 0; ks < 4; ++ks) pw[ks] = pwn[ks];
                } else { PV(t); }
            }
        }
        asm volatile("s_waitcnt lgkmcnt(0)\n\ts_barrier" ::: "memory");
        if (c == 0) PROLOGUE(kbase + 64, vbase, Qw + 64);
        else if (qb_next >= 0) { const bf16* Qn = Q + (rowbase + qb_next * 256 + 32 * blk) * DM + h * 128; PROLOGUE(kbase - 64, vbase, Qn); }
        l_run += __shfl_xor(l_run, 32);
        bad = bad || !(l_run > 1e-30f && l_run < 1e30f);
        if (hi == 0) wsf[32 + r32] = l_run;
        LDS_WAIT();
        LAS unsigned* stash = (LAS unsigned*)stg;
#pragma unroll
        for (int d0 = 0; d0 < 4; ++d0) {
            asm volatile("" : "+v"(o[d0]));
            if (c == 0) {
#pragma unroll
                for (int r = 0; r < 16; r += 2) { const float rl0 = __builtin_amdgcn_rcpf(wsf[32 + crow(r, hi)]), rl1 = __builtin_amdgcn_rcpf(wsf[32 + crow(r + 1, hi)]);
                    stash[(d0 * 8 + (r >> 1)) * 64 + lane] = cvt_pk_bf16(o[d0][r] * rl0, o[d0][r + 1] * rl1); }
            } else {
#pragma unroll
                for (int r = 0; r < 16; r += 2) { const float rl0 = __builtin_amdgcn_rcpf(wsf[32 + crow(r, hi)]) * lam, rl1 = __builtin_amdgcn_rcpf(wsf[32 + crow(r + 1, hi)]) * lam;
                    const unsigned w = stash[(d0 * 8 + (r >> 1)) * 64 + lane]; o[d0][r] = bflo(w) - o[d0][r] * rl0; o[d0][r + 1] = bfhi(w) - o[d0][r + 1] * rl1; }
            }
            asm volatile("" : "+v"(o[d0]));
        }
        LDS_WAIT();
#undef PROLOGUE
#undef DMA_K
#undef DMA_V
#undef DMA_KB
#undef DMA_VB
#undef LANE_
#undef KVO
#undef VVO
    }
#undef SBV
#undef WB
#undef QKT
#undef SOFTMAX
#undef RDV
#undef PVB
#undef PV
    if (__any(bad) && lane == 0) flag[0] = 1u;
    asm volatile("s_waitcnt lgkmcnt(0)\n\ts_barrier" ::: "memory");
    const bool redo = flag[0] != 0u;
    if (!redo) {
        const LAS float* gsl = (const LAS float*)(shm + L_GS);
        float gs[4];
#pragma unroll
        for (int d0 = 0; d0 < 4; ++d0) gs[d0] = gsl[32 * d0 + r32];
        float ss[16];
#pragma unroll
        for (int r = 0; r < 16; ++r) ss[r] = (o[0][r] * o[0][r] + o[1][r] * o[1][r]) + (o[2][r] * o[2][r] + o[3][r] * o[3][r]);
#define DPPADD_(ctrl) do { _Pragma("unroll") for (int r = 0; r < 16; ++r) ss[r] += __builtin_bit_cast(float, __builtin_amdgcn_update_dpp(0, __builtin_bit_cast(int, ss[r]), ctrl, 0xf, 0xf, true)); } while (0)
        DPPADD_(0xB1); DPPADD_(0x4E); DPPADD_(0x141); DPPADD_(0x140);
#undef DPPADD_
        float sx[16];
#pragma unroll
        for (int r = 0; r < 16; ++r) sx[r] = __builtin_bit_cast(float, __builtin_amdgcn_ds_swizzle(__builtin_bit_cast(int, ss[r]), (16 << 10) | 0x1f));
#pragma unroll
        for (int r = 0; r < 16; ++r) {
            const float rstd = __builtin_amdgcn_rsqf((ss[r] + sx[r]) * (1.f / 128.f) + EPS);
            const int orow = crow(r, hi);
            const unsigned w01 = cvt_pk_bf16(o[0][r] * rstd * gs[0], o[1][r] * rstd * gs[1]), w23 = cvt_pk_bf16(o[2][r] * rstd * gs[2], o[3][r] * rstd * gs[3]);
            stg[orow * 128 + r32] = (unsigned short)w01; stg[orow * 128 + 32 + r32] = (unsigned short)(w01 >> 16);
            stg[orow * 128 + 64 + r32] = (unsigned short)w23; stg[orow * 128 + 96 + r32] = (unsigned short)(w23 >> 16);
        }
        LDS_WAIT();
        bf16* Ow = O + (rowbase + qw) * DM + h * 128;
#pragma unroll
        for (int i = 0; i < 8; ++i) { const int idx = i * 64 + lane, row = idx >> 4, ch = idx & 15; const u32x4 v = *(const LAS u32x4*)(stg + row * 128 + ch * 8); *(u32x4*)(Ow + (long)row * DM + ch * 8) = v; }
    }
    asm volatile("s_waitcnt lgkmcnt(0)\n\ts_barrier" ::: "memory");
    return redo;
}
}

__device__ __forceinline__ void conv_unit(Frame& F, int tok0, const bf16* C, bf16* OB) {
    constexpr int CT = 32, NP = CT + 30;
    const int t = fresh_tid(), ch = 2 * t, lane = t & 63, wave = __builtin_amdgcn_readfirstlane(t >> 6);
    const float* cw = INP(I_CONVW); const float* cb = INP(I_CONVB); const float* lng = INP(I_LNG); const float* lnb = INP(I_LNB);
    LAS float* tile = (LAS float*)F.lds;
    unsigned wq0[16], wq1[16];
#pragma unroll
    for (int m = 0; m < 16; ++m) { const f32x2 wa = *(const f32x2*)(cw + (2 * m) * 1024 + ch); f32x2 wb = (f32x2){0.f, 0.f}; if (2 * m + 1 < 31) wb = *(const f32x2*)(cw + (2 * m + 1) * 1024 + ch);
        wq0[m] = cvt_pk_bf16(wa.x, wb.x); wq1[m] = cvt_pk_bf16(wa.y, wb.y); }
    const f32x2 bb = *(const f32x2*)(cb + ch);
    const int s_in_batch0 = tok0 & (SEQ - 1);
    const char* cbase = (const char*)(C + (size_t)tok0 * DM); const unsigned voff = (unsigned)ch * 2u;
#define PAIR0_(lo, hi) __builtin_amdgcn_perm(hi, lo, 0x05040100u)
#define PAIR1_(lo, hi) __builtin_amdgcn_perm(hi, lo, 0x07060302u)
#define DOT2_(a, b, c) __builtin_amdgcn_fdot2_f32_bf16(__builtin_bit_cast(bf16x2_t, a), __builtin_bit_cast(bf16x2_t, b), c, false)
    unsigned p0[NP], p1[NP], raw[CT], wlast;
    { unsigned w[NP];
#pragma unroll
      for (int i = 0; i < NP; ++i) { const int rel = i - 30; unsigned u = 0u; if (s_in_batch0 + rel >= 0) u = *(const unsigned*)(cbase + (long)rel * (DM * 2) + voff); w[i] = u; }
#pragma unroll
      for (int i = 0; i < NP - 1; ++i) { p0[i] = PAIR0_(w[i], w[i + 1]); p1[i] = PAIR1_(w[i], w[i + 1]); }
      p0[NP - 1] = w[NP - 1] & 0xffffu; p1[NP - 1] = w[NP - 1] >> 16; wlast = w[NP - 1]; }
#pragma unroll 1
    for (int k = 0; k < 128 / CT; ++k) {
#pragma unroll
        for (int i = 0; i < CT; ++i) { float a0 = bb.x, a1 = bb.y;
#pragma unroll
            for (int m = 0; m < 16; ++m) { a0 = DOT2_(p0[i + 2 * m], wq0[m], a0); a1 = DOT2_(p1[i + 2 * m], wq1[m], a1); }
            *(LAS f32x2*)(tile + i * 1024 + ch) = (f32x2){a0, a1};
            if ((i & 3) == 3) __builtin_amdgcn_sched_barrier(0); }
        {
#pragma unroll
            for (int i = 0; i < 29; ++i) { p0[i] = p0[i + CT]; p1[i] = p1[i + CT]; }
            const int r0 = CT * (k + 1);
            unsigned vo = voff; asm volatile("" : "+v"(vo));
#pragma unroll
            for (int i = 0; i < CT; ++i) { int rr = r0 + i; if (tok0 + rr > MTOK - 1) rr = MTOK - 1 - tok0; raw[i] = *(const unsigned*)(cbase + (long)rr * (DM * 2) + vo); } }
        LDS_WAIT(); __syncthreads();
        int lane_n; asm volatile("v_mbcnt_lo_u32_b32 %0, -1, 0\n\tv_mbcnt_hi_u32_b32 %0, -1, %0" : "=v"(lane_n));
        {
            constexpr int TQ = CT / 8;
            f32x4 v[TQ][4], lg[4], lb[4]; float mean[TQ], rstd[TQ];
#pragma unroll
            for (int j = 0; j < 4; ++j) { lg[j] = *(const f32x4*)(lng + lane_n * 4 + 256 * j); lb[j] = *(const f32x4*)(lnb + lane_n * 4 + 256 * j); }
#pragma unroll
            for (int q = 0; q < TQ; ++q) { const int i = wave * TQ + q; float s = 0.f;
#pragma unroll
                for (int j = 0; j < 4; ++j) { v[q][j] = *(const LAS f32x4*)(tile + i * 1024 + lane_n * 4 + 256 * j); s += (v[q][j].x + v[q][j].y) + (v[q][j].z + v[q][j].w); }
                mean[q] = s; }
#pragma unroll
            for (int q = 0; q < TQ; ++q) mean[q] = wave_sum(mean[q]) * (1.f / 1024.f);
#pragma unroll
            for (int q = 0; q < TQ; ++q) { float s2 = 0.f;
#pragma unroll
                for (int j = 0; j < 4; ++j) { v[q][j] = v[q][j] - mean[q]; s2 += (v[q][j].x * v[q][j].x + v[q][j].y * v[q][j].y) + (v[q][j].z * v[q][j].z + v[q][j].w * v[q][j].w); }
                rstd[q] = s2; }
#pragma unroll
            for (int q = 0; q < TQ; ++q) rstd[q] = __builtin_amdgcn_rsqf(wave_sum(rstd[q]) * (1.f / 1024.f) + EPS);
#pragma unroll
            for (int q = 0; q < TQ; ++q) { const int i = wave * TQ + q; bf16* orow = OB + (size_t)(tok0 + CT * k + i) * DM;
#pragma unroll
                for (int j = 0; j < 4; ++j) { const int c0 = lane_n * 4 + 256 * j;
                    f32x4 y = v[q][j] * rstd[q] * lg[j] + lb[j]; y.x = siluf_(y.x); y.y = siluf_(y.y); y.z = siluf_(y.z); y.w = siluf_(y.w);
                    u32x2 w; w.x = pk2(y.x, y.y); w.y = pk2(y.z, y.w); *(u32x2*)(orow + c0) = w; } }
        }
#pragma unroll
        for (int i = 0; i < CT; ++i) asm volatile("" : "+v"(raw[i]));
        p0[29] = PAIR0_(wlast, raw[0]); p1[29] = PAIR1_(wlast, raw[0]);
#pragma unroll
        for (int i = 0; i < CT - 1; ++i) { p0[30 + i] = PAIR0_(raw[i], raw[i + 1]); p1[30 + i] = PAIR1_(raw[i], raw[i + 1]); }
        p0[NP - 1] = raw[CT - 1] & 0xffffu; p1[NP - 1] = raw[CT - 1] >> 16; wlast = raw[CT - 1];
        LDS_WAIT(); __syncthreads();
    }
#undef PAIR0_
#undef PAIR1_
#undef DOT2_
}

using pg8::Unit; using pg8::Ops; using pg8::Acc;
#define TBUF(ws, i) ((bf16*)((ws) + WS_T + (size_t)(i) * UB))
#define GBUF(ws, i) ((bf16*)((ws) + WS_G + (size_t)(i) * UB))
struct SchedP1 { int G, c; unsigned char* ws; unsigned char* out;
    __device__ __forceinline__ void pre_epi(LAS unsigned char*) const {}
    __device__ __forceinline__ bool next(int i, Unit& u) const { const int L = i * G + c; if (L >= 3072 + 128) return false;
        if (L < 3072) { pg8::tile_order(L, 128, 24, u.pm, u.pn); u.kind = 0; } else if (L < 3136) { const int x = L - 3072; u.pm = x & 15; u.pn = x >> 4; u.kind = 1; } else { const int x = L - 3136; u.pm = x & 3; u.pn = x >> 2; u.kind = 2; } return true; }
    __device__ __forceinline__ void ops(const Unit& u, Ops& o) const { o.lda2 = 2048; o.ldb2 = 2048;
        const char* XN = (const char*)ws + WS_XN; const char* WIN = (const char*)ws + WS_WIN; const char* MN = (const char*)ws + WS_MN; const char* WMKV = (const char*)ws + WS_WMKV;
        if (u.kind == 0) { o.A = XN + (size_t)u.pm * 256 * 2048; o.B = WIN + (size_t)u.pn * 256 * 2048; }
        else if (u.kind == 1) { o.A = MN + (size_t)u.pm * 256 * 2048; o.B = WMKV + (size_t)u.pn * 256 * 2048; }
        else { o.A = WMKV + (size_t)(1024 + u.pm * 256) * 2048; o.B = MN + (size_t)u.pn * 256 * 2048; } }
};
struct EpiP1 { unsigned char* ws;
    __device__ __forceinline__ bool keep(const Unit&) const { return false; }
    __device__ __forceinline__ void operator()(const Acc& acc, const Unit& u, int wr, int wc, int fr, int fq, LAS unsigned char*) const {
        const int rl = wr * 64 + fr, cl = wc * 32 + 8 * fq;
        if (u.kind == 0) {
            const int pn = u.pn; const size_t row = (size_t)u.pm * 256 + rl;
            if (pn >= 12 && pn < 20) {
                bf16* base = GBUF(ws, 2) + row * DM + (pn - 12) * 128 + cl;
#pragma unroll
                for (int ai = 0; ai < 2; ++ai)
#pragma unroll
                    for (int m = 0; m < 4; ++m) { const f32x4 a0 = acc[ai][0][m][0], a1 = acc[ai][0][m][1], g0 = acc[ai][1][m][0], g1 = acc[ai][1][m][1]; float r[8];
#pragma unroll
                        for (int e = 0; e < 4; ++e) { r[e] = a0[e] * sigmoidf_(g0[e]); r[4 + e] = a1[e] * sigmoidf_(g1[e]); }
                        u32x4 w; w.x = cvt_pk_bf16(r[0], r[1]); w.y = cvt_pk_bf16(r[2], r[3]); w.z = cvt_pk_bf16(r[4], r[5]); w.w = cvt_pk_bf16(r[6], r[7]);
                        *(u32x4*)(base + (size_t)(ai * 128 + m * 16) * DM) = w; }
            } else {
                const int grp = pn < 12 ? (pn >> 2) : 3; const float sc = (grp == 0) ? C2A : 1.f; const int cc = (pn & 3) * 256;
                const size_t boff = (grp == 0) ? WS_T : (grp == 1) ? WS_G : (grp == 2) ? (WS_G + UB) : (WS_T + 2 * UB);
                pg8::store_plain(acc, (bf16*)(ws + boff) + row * DM + cc + cl, DM, sc);
            }
        } else if (u.kind == 1) pg8::store_plain(acc, (bf16*)(ws + WS_KM) + ((size_t)u.pm * 256 + rl) * 1024 + u.pn * 256 + cl, 1024, 1.f);
        else pg8::store_plain(acc, (bf16*)(ws + WS_VT) + ((size_t)u.pm * 256 + rl) * 4096 + u.pn * 256 + cl, 4096, 1.f);
    }
};
struct SchedX { int G, v; unsigned char* ws; unsigned char* out;
    __device__ __forceinline__ void pre_epi(LAS unsigned char*) const {}
    __device__ __forceinline__ bool next(int i, Unit& u) const {
        const int cnt = (512 - v + G - 1) / G;
        if (i >= 2 * cnt) return false; const int j = i % cnt; u.kind = i / cnt; u.pm = v + j * G; u.pn = j & 1; return true; }
    __device__ __forceinline__ void ops(const Unit& u, Ops& o) const { const int p = u.pm, b = p >> 5, h = (p >> 3) & 3, qb = p & 7;
        if (u.kind == 0) { o.A = (const char*)TBUF(ws, 2) + ((size_t)(b * SEQ + qb * 256) * DM + h * 256) * 2; o.lda2 = 2048; o.B = (const char*)ws + WS_KM + ((size_t)(b * 256) * 1024 + h * 256) * 2; o.ldb2 = 2048; }
        else { o.A = (const char*)out + OUT_P + (size_t)p * 131072; o.lda2 = 512; o.B = (const char*)ws + WS_VT + ((size_t)(h * 256) * 4096 + b * 256) * 2; o.ldb2 = 8192; } }
};
struct EpiX { unsigned char* ws; unsigned char* out; size_t oc_redirect;
    __device__ __forceinline__ bool keep(const Unit&) const { return false; }
    __device__ __forceinline__ void operator()(const Acc& acc, const Unit& u, int wr, int wc, int fr, int fq, LAS unsigned char* ldst) const {
        const int rl = wr * 64 + fr, cl = wc * 32 + 8 * fq; const int p = u.pm;
        LAS float* lsum = (LAS float*)(ldst + (LSUM_OFF - RING_BYTES)) + u.pn * 1024;
        if (u.kind == 0) {
            bf16* base = (bf16*)(out + OUT_P) + (size_t)p * 65536 + (size_t)rl * 256 + cl;
#pragma unroll
            for (int ai = 0; ai < 2; ++ai)
#pragma unroll
                for (int m = 0; m < 4; ++m) { float rs = 0.f;
#pragma unroll
                    for (int bj = 0; bj < 2; ++bj) { const f32x4 v0 = acc[ai][bj][m][0], v1 = acc[ai][bj][m][1]; float e[8];
#pragma unroll
                        for (int k = 0; k < 4; ++k) { e[k] = __builtin_amdgcn_exp2f(v0[k] * C2X); e[4 + k] = __builtin_amdgcn_exp2f(v1[k] * C2X); }
                        u32x4 w; w.x = cvt_pk_bf16(e[0], e[1]); w.y = cvt_pk_bf16(e[2], e[3]); w.z = cvt_pk_bf16(e[4], e[5]); w.w = cvt_pk_bf16(e[6], e[7]);
                        rs += (bflo(w.x) + bfhi(w.x)) + (bflo(w.y) + bfhi(w.y)) + (bflo(w.z) + bfhi(w.z)) + (bflo(w.w) + bfhi(w.w));
                        *(u32x4*)(base + (size_t)(ai * 128 + m * 16) * 256 + bj * 128) = w; }
                    rs += __shfl_xor(rs, 16); rs += __shfl_xor(rs, 32);
                    if (fq == 0) lsum[(ai * 128 + m * 16 + rl) * 4 + wc] = rs; }
        } else {
            const int b = p >> 5, h = (p >> 3) & 3, qb = p & 7;
            bf16* base = (bf16*)((unsigned char*)TBUF(ws, 2) + oc_redirect) + ((size_t)(b * SEQ + qb * 256) + rl) * DM + h * 256 + cl;
#pragma unroll
            for (int ai = 0; ai < 2; ++ai)
#pragma unroll
                for (int m = 0; m < 4; ++m) { const f32x4 l4 = *(const LAS f32x4*)(lsum + (ai * 128 + m * 16 + rl) * 4); const float rcp = __builtin_amdgcn_rcpf((l4.x + l4.y) + (l4.z + l4.w));
#pragma unroll
                    for (int bj = 0; bj < 2; ++bj) { const f32x4 v0 = acc[ai][bj][m][0] * rcp, v1 = acc[ai][bj][m][1] * rcp;
                        u32x4 w; w.x = cvt_pk_bf16(v0[0], v0[1]); w.y = cvt_pk_bf16(v0[2], v0[3]); w.z = cvt_pk_bf16(v1[0], v1[1]); w.w = cvt_pk_bf16(v1[2], v1[3]);
                        *(u32x4*)(base + (size_t)(ai * 128 + m * 16) * DM + bj * 128) = w; } }
        }
    }
};
struct SchedP3 { int G, c; unsigned char* ws; unsigned char* out;
    __device__ __forceinline__ void pre_epi(LAS unsigned char* lds) const { if (MK_N_LAUNCHES == 1) xcd_barrier_wait((unsigned*)ws + CW_BAR, (volatile LAS unsigned*)(lds + MISC_OFF) + 8); }
    __device__ __forceinline__ bool next(int i, Unit& u) const {
        if (i >= 12) return false; u.pm = (c >> 2) + (i >= 6 ? 64 : 0); u.pn = (c & 3) + 4 * (((i >= 6 ? i - 6 : i) + (c >> 5)) % 6); u.kind = 0; return true; }
    __device__ __forceinline__ void ops(const Unit& u, Ops& o) const { o.lda2 = 2048; o.ldb2 = 2048; o.A = (const char*)ws + WS_XN + (size_t)u.pm * 256 * 2048; o.B = (const char*)ws + WS_WIN + (size_t)(6144 + u.pn * 256) * 2048; }
};
struct EpiP3 { unsigned char* ws; const float* bmerge; int rep;
    __device__ __forceinline__ bool keep(const Unit&) const { return false; }
    __device__ __forceinline__ void operator()(const Acc& acc, const Unit& u, int wr, int wc, int fr, int fq, LAS unsigned char*) const {
        const int rl = wr * 64 + fr, cl = wc * 32 + 8 * fq; const int pn = u.pn; const size_t row = (size_t)u.pm * 256 + rl;
        if (pn < 12) {
            bf16* T = TBUF(ws, pn >> 2) + row * DM + (pn & 3) * 256 + cl;
            bf16* Tw = rep ? (bf16*)(ws + WS_END) + (row * DM + (pn & 3) * 256 + cl) : T;
#define O2_(c) ((size_t)(((c) >> 3) * 128 + (((c) >> 1) & 3) * 16) * DM + ((c) & 1) * 128)
            u32x4 oq[16];
#pragma unroll
            for (int c = 0; c < 16; ++c) oq[c] = *(const u32x4*)(T + O2_(c));
            asm volatile("" ::: "memory");
#pragma unroll
            for (int c = 0; c < 16; ++c) { const int ai = c >> 3, m = (c >> 1) & 3, bj = c & 1;
                const u32x4 o = oq[c];
                const f32x4 z0 = acc[ai][bj][m][0], z1 = acc[ai][bj][m][1];
                u32x4 w; w.x = cvt_pk_bf16(bflo(o.x) * siluf_(z0[0]), bfhi(o.x) * siluf_(z0[1])); w.y = cvt_pk_bf16(bflo(o.y) * siluf_(z0[2]), bfhi(o.y) * siluf_(z0[3]));
                w.z = cvt_pk_bf16(bflo(o.z) * siluf_(z1[0]), bfhi(o.z) * siluf_(z1[1])); w.w = cvt_pk_bf16(bflo(o.w) * siluf_(z1[2]), bfhi(o.w) * siluf_(z1[3]));
                *(u32x4*)(Tw + O2_(c)) = w; asm volatile("" ::: "memory"); }
#undef O2_
        } else {
            const int gi = (pn - 12) >> 2, cc = ((pn - 12) & 3) * 256 + cl;
            bf16* Gp = GBUF(ws, gi) + row * DM + cc; const float* bp = bmerge + gi * 1024 + cc;
            const f32x4 b00 = *(const f32x4*)(bp), b01 = *(const f32x4*)(bp + 4), b10 = *(const f32x4*)(bp + 128), b11 = *(const f32x4*)(bp + 132);
#pragma unroll
            for (int ai = 0; ai < 2; ++ai)
#pragma unroll
                for (int m = 0; m < 4; ++m)
#pragma unroll
                    for (int bj = 0; bj < 2; ++bj) { const f32x4 v0 = acc[ai][bj][m][0] + (bj ? b10 : b00), v1 = acc[ai][bj][m][1] + (bj ? b11 : b01);
#define SG_(x) __builtin_bit_cast(float, max(__builtin_bit_cast(unsigned, sigmoidf_(x)), 0x0DA24260u))
                        u32x4 w; w.x = cvt_pk_bf16(SG_(v0[0]), SG_(v0[1])); w.y = cvt_pk_bf16(SG_(v0[2]), SG_(v0[3])); w.z = cvt_pk_bf16(SG_(v1[0]), SG_(v1[1])); w.w = cvt_pk_bf16(SG_(v1[2]), SG_(v1[3]));
#undef SG_
                        *(u32x4*)(Gp + (size_t)(ai * 128 + m * 16) * DM + bj * 128) = w; }
        }
    }
};
struct SchedP4 { int G, v; unsigned char* ws;
    __device__ __forceinline__ void pre_epi(LAS unsigned char*) const {}
    __device__ __forceinline__ bool next(int i, Unit& u) const { const int tile = v + (i / 3) * G; if (tile >= 512) return false; u.pm = tile >> 2; u.pn = tile & 3; u.kind = i % 3; return true; }
    __device__ __forceinline__ void ops(const Unit& u, Ops& o) const { o.lda2 = 2048; o.ldb2 = 2048;
        o.A = (const char*)TBUF(ws, u.kind) + (size_t)u.pm * 256 * 2048; o.B = (const char*)ws + WS_WOA + (size_t)u.kind * (2 * MiB) + (size_t)u.pn * 256 * 2048; }
};
struct EpiP4 { unsigned char* ws; unsigned char* out;
    __device__ __forceinline__ bool keep(const Unit&) const { return true; }
    static __device__ __forceinline__ float gc(float g) { return g; }
    __device__ __forceinline__ void operator()(Acc& acc, const Unit& u, int wr, int wc, int fr, int fq, LAS unsigned char*) const {
        const int rl = wr * 64 + fr, cl = wc * 32 + 8 * fq; const size_t off = ((size_t)u.pm * 256 + rl) * DM + u.pn * 256 + cl;
        const bool lastb = u.kind == 2;
        const bf16* Ga = GBUF(ws, u.kind) + off; const bf16* Gb = GBUF(ws, lastb ? 2 : u.kind + 1) + off; bf16* Op = GBUF(ws, 0) + off;
        const float keepf = lastb ? 0.f : 1.f;
#define R_(a, b) (gc(a) * (lastb ? 1.f : __builtin_amdgcn_rcpf(gc(b))))
#define O2_(c) ((size_t)(((c) >> 3) * 128 + (((c) >> 1) & 3) * 16) * DM + ((c) & 1) * 128)
        constexpr int PD = 4;
        u32x4 gaq[PD], gbq[PD];
#pragma unroll
        for (int c = 0; c < PD; ++c) { gaq[c] = *(const u32x4*)(Ga + O2_(c)); gbq[c] = *(const u32x4*)(Gb + O2_(c)); }
#pragma unroll
        for (int c = 0; c < 16; ++c) { const int ai = c >> 3, m = (c >> 1) & 3, bj = c & 1;
            const u32x4 ga = gaq[c % PD], gb = gbq[c % PD];
            asm volatile("" :: "v"(ga), "v"(gb) : "memory");
            if (c + PD < 16) { gaq[c % PD] = *(const u32x4*)(Ga + O2_(c + PD)); gbq[c % PD] = *(const u32x4*)(Gb + O2_(c + PD)); }
            const f32x4 r0 = {R_(bflo(ga.x), bflo(gb.x)), R_(bfhi(ga.x), bfhi(gb.x)), R_(bflo(ga.y), bflo(gb.y)), R_(bfhi(ga.y), bfhi(gb.y))};
            const f32x4 r1 = {R_(bflo(ga.z), bflo(gb.z)), R_(bfhi(ga.z), bfhi(gb.z)), R_(bflo(ga.w), bflo(gb.w)), R_(bfhi(ga.w), bfhi(gb.w))};
            const f32x4 v0 = acc[ai][bj][m][0] * r0, v1 = acc[ai][bj][m][1] * r1;
            if (lastb) { u32x4 w; w.x = cvt_pk_bf16(v0[0], v0[1]); w.y = cvt_pk_bf16(v0[2], v0[3]); w.z = cvt_pk_bf16(v1[0], v1[1]); w.w = cvt_pk_bf16(v1[2], v1[3]); *(u32x4*)(Op + O2_(c)) = w; }
            acc[ai][bj][m][0] = v0 * keepf; acc[ai][bj][m][1] = v1 * keepf; asm volatile("" : "+v"(acc[ai][bj][m][0]), "+v"(acc[ai][bj][m][1])); }
#undef O2_
#undef R_
    }
};
struct SchedP5 { int G, v; unsigned char* ws; unsigned char* out;
    __device__ __forceinline__ void pre_epi(LAS unsigned char*) const {}
    __device__ __forceinline__ bool next(int i, Unit& u) const { const int tile = v + i * G; if (tile >= 512) return false; u.pm = tile >> 2; u.pn = tile & 3; u.kind = 0; return true; }
    __device__ __forceinline__ void ops(const Unit& u, Ops& o) const { o.lda2 = 2048; o.ldb2 = 2048; o.A = (const char*)GBUF(ws, 0) + (size_t)u.pm * 256 * 2048; o.B = (const char*)ws + WS_WOUT + (size_t)u.pn * 256 * 2048; }
};
struct EpiP5 { unsigned char* ws;
    __device__ __forceinline__ bool keep(const Unit&) const { return false; }
    __device__ __forceinline__ void operator()(const Acc& acc, const Unit& u, int wr, int wc, int fr, int fq, LAS unsigned char*) const {
        const int rl = wr * 64 + fr, cl = wc * 32 + 8 * fq; const size_t row0 = (size_t)u.pm * 256 + rl;
        pg8::store_plain(acc, TBUF(ws, 0) + row0 * DM + u.pn * 256 + cl, DM, 1.f);
        float* rsq = (float*)(ws + WS_MN);
#pragma unroll
        for (int ai = 0; ai < 2; ++ai)
#pragma unroll
            for (int m = 0; m < 4; ++m) { float ss = 0.f;
#pragma unroll
                for (int bj = 0; bj < 2; ++bj)
#pragma unroll
                    for (int n = 0; n < 2; ++n) { const f32x4 v = acc[ai][bj][m][n]; ss += (v[0] * v[0] + v[1] * v[1]) + (v[2] * v[2] + v[3] * v[3]); }
                rsq[(row0 + ai * 128 + m * 16) * 64 + u.pn * 16 + wc * 4 + fq] = ss; }
    }
};

#ifndef PHMASK
#define PHMASK 0x77f
#endif
#ifndef REPMASK
#define REPMASK 0
#endif
#define REP(k) (((REPMASK >> (k)) & 1) ? 2 : 1)
#ifndef ATT_V2
#define ATT_V2 2
#endif
#ifndef NOFALLBACK
#define NOFALLBACK 0
#endif

#define TD_BEGIN(k) unsigned long long td0_##k = 0; if (TIMEDUP == (k)) td0_##k = __builtin_amdgcn_s_memrealtime();
#define TD_END(k) if (TIMEDUP == (k)) { const unsigned long long td1 = __builtin_amdgcn_s_memrealtime(); const unsigned long long until = td1 + (td1 - td0_##k); while (__builtin_amdgcn_s_memrealtime() < until) __builtin_amdgcn_s_sleep(8); }
__global__ void __launch_bounds__(512, 2) mk_fwd(Args args) {
    extern __shared__ __attribute__((aligned(16))) unsigned char lds[];
    Frame F;
    F.lds = (LAS unsigned char*)lds;
    F.tid = threadIdx.x; F.lane = F.tid & 63; F.wave = __builtin_amdgcn_readfirstlane(F.tid >> 6);
    F.G = gridDim.x; { const int bx = blockIdx.x; F.vcu = (F.G % 8 == 0) ? (bx % 8) * (F.G / 8) + bx / 8 : bx; }
    F.out = args.out; F.ws = args.ws;
    unsigned char* ws = args.ws; unsigned char* outb = (unsigned char*)args.out;
    gu32* ctl = (gu32*)(ws + WS_CTL);
    for (int u = F.tid; u < (LDS_BYTES - LDSCTL_OFF) / 4; u += 512) ((LAS unsigned*)(F.lds + LDSCTL_OFF))[u] = 0u;
    __syncthreads();
    volatile LAS unsigned* MISC = (volatile LAS unsigned*)(F.lds + MISC_OFF);
    XcdBarrier bar; bar.bar = (unsigned*)(ctl + CW_BAR); bar.x = 0; bar.st = nullptr;
    if (MK_N_LAUNCHES == 1) bar = xcd_barrier_post((unsigned*)(ctl + CW_BAR), MISC + 8);
#define grp_on (MK_N_LAUNCHES == 1 && REPMASK == 0)
#define KO_ (2 * (int)bar.x)
    if (grp_on && threadIdx.x == 0) __hip_atomic_store((unsigned*)ws + CW_XCC + F.vcu, bar.x + 1u, __ATOMIC_RELAXED, __HIP_MEMORY_SCOPE_AGENT);
    const int lo = args.ph_lo, hi = args.ph_hi;
#define IN(k) (((PHMASK >> (k)) & 1) && lo <= (k) && (k) < hi)
#define SEAM(k) do { if (lo <= (k) && (k) + 1 < hi) xcd_barrier(bar); } while (0)

    { TD_BEGIN(0) if (IN(0)) { for (int rep = 0; rep < REP(0); ++rep) p0_prologue(F); } TD_END(0) }
    { TD_BEGIN(10) SEAM(0); TD_END(10) }
    if (grp_on) {
        if (threadIdx.x == 0) { const unsigned* xt = (const unsigned*)ws + CW_XCC + (F.vcu & ~3); const unsigned a0 = xb_ld((unsigned*)xt), a1 = xb_ld((unsigned*)xt + 1), a2 = xb_ld((unsigned*)xt + 2), a3 = xb_ld((unsigned*)xt + 3);
            MISC[13] = (a0 != 0u && a0 == a1 && a0 == a2 && a0 == a3) ? 1u : 0u; }
        __syncthreads();
    }
    TD_BEGIN(1)
    if (IN(1)) {
        SchedP1 S{F.G, (int)blockIdx.x, ws, outb}; EpiP1 E{ws};
        for (int rep = 0; rep < REP(1); ++rep) pg8::gemm_phase(F.lds, 16, S, E, KO_);
        if (F.G == 256 && blockIdx.x >= 128) p0_transposes(F, true, ((int)blockIdx.x - 128) * 8 + F.wave, 128 * 8);
        else if (F.G != 256) p0_transposes(F, true, F.vcu * 8 + F.wave, F.G * 8);
    }
    TD_END(1)
    { TD_BEGIN(11) SEAM(1); TD_END(11) }
    if (IN(2)) {
        TD_BEGIN(7)
        if ((PHMASK >> 8) & 1) { for (int rep = 0; rep < REP(7); ++rep) { SchedX S{F.G, F.vcu, ws, outb}; EpiX E{ws, outb, rep ? (size_t)(WS_END - (WS_T + 2 * UB)) : (size_t)0}; pg8::gemm_phase(F.lds, 4, S, E); } }
        TD_END(7)
        TD_BEGIN(8)
        if ((PHMASK >> 9) & 1) {
            const float* lq1 = INP(I_LQ1); const float* lk1 = INP(I_LK1); const float* lq2 = INP(I_LQ2); const float* lk2 = INP(I_LK2);
            const float s1 = wave_sum(lq1[F.lane] * lk1[F.lane]), s2 = wave_sum(lq2[F.lane] * lk2[F.lane]);
            const float lam = expf(s1) - expf(s2) + 0.2f;
            const float* tab = INP(I_RELB); const float* gsub = INP(I_GSUB);
            for (int rep = 0; rep < REP(2); ++rep)
            for (int v = F.vcu; v < 256; v += F.G) {
                const int bh = v >> 1, s = v & 1;
                bool pref = false, tabok = false; bf16x8 qr[4];
                for (int i = 0; i < 4; ++i) { const int qb = (i == 0) ? s : (i == 1) ? 3 - s : (i == 2) ? 4 + s : 7 - s; const int qbn = (i == 0) ? 3 - s : (i == 1) ? 4 + s : (i == 2) ? 7 - s : -1;
                    bf16* Od = rep ? (bf16*)(ws + WS_END) : TBUF(ws, 0);
                    bool redo = (ATT_V2 == 0);
                    if (ATT_V2 != 0) for (int attempt = 0; attempt < 2; ++attempt) {
                        redo = att3::attn_unit(bh >> 3, bh & 7, qb, qbn, !pref || attempt > 0, !tabok, qr, TBUF(ws, 0), GBUF(ws, 0), GBUF(ws, 1), Od, tab, gsub, lam, F.lds);
                        tabok = true;
                        if (!redo || NOFALLBACK) break; }
                    pref = qbn >= 0;
                    if (redo && NOFALLBACK == 0) {
                        asm volatile("s_waitcnt vmcnt(0) lgkmcnt(0)\n\ts_barrier" ::: "memory");
                        att::attn_unit(bh >> 3, bh & 7, qb, TBUF(ws, 0), GBUF(ws, 0), GBUF(ws, 1), Od, tab, gsub, lam, F.lds); pref = false; tabok = false; } }
            }
        }
        __syncthreads();
        TD_END(8)
        TD_BEGIN(9)
        if ((PHMASK >> 10) & 1) for (int rep = 0; rep < REP(8); ++rep) for (int v = F.vcu; v < 256; v += F.G) conv_unit(F, v * 128, GBUF(ws, 2), TBUF(ws, 1));
        TD_END(9)
    }
    { TD_BEGIN(12) if (grp_on) xcd_barrier_arrive(bar); else SEAM(2); TD_END(12) }
    TD_BEGIN(3)
    if (IN(3)) {
        for (int rep = 0; rep < REP(3); ++rep) { SchedP3 S{F.G, F.vcu, ws, outb}; EpiP3 E{ws, INP(I_BMERGE), rep};
        pg8::gemm_phase(F.lds, 16, S, E); }
    }
    TD_END(3)
    { TD_BEGIN(13) if (grp_on) grp_barrier((unsigned*)ws, F.vcu >> 2, 1u, MISC[13] != 0u); else SEAM(3); TD_END(13) }
    TD_BEGIN(4)
    if (IN(4)) {
        SchedP4 S{F.G, F.vcu, ws}; EpiP4 E{ws, outb};
        for (int rep = 0; rep < REP(4); ++rep) pg8::gemm_phase(F.lds, 16, S, E, KO_);
    }
    TD_END(4)
    { TD_BEGIN(14) if (grp_on) grp_barrier((unsigned*)ws, F.vcu >> 2, 2u, MISC[13] != 0u); else SEAM(4); TD_END(14) }
    TD_BEGIN(5)
    if (IN(5)) {
        SchedP5 S{F.G, F.vcu, ws, outb}; EpiP5 E{ws};
        for (int rep = 0; rep < REP(5); ++rep) pg8::gemm_phase(F.lds, 16, S, E, KO_);
    }
    TD_END(5)
    { TD_BEGIN(15) if (grp_on) grp_barrier((unsigned*)ws, F.vcu >> 2, 3u, MISC[13] != 0u); else SEAM(5); TD_END(15) }
    if (IN(6)) {
        const int t6 = fresh_tid(), lane6 = t6 & 63; const int gw = F.vcu * 8 + __builtin_amdgcn_readfirstlane(t6 >> 6);
        const float* gp = INP(I_GPOST); const float* xin = INP(I_X); const float* RSQ = (const float*)(ws + WS_MN); const bf16* Yb = TBUF(ws, 0);
        const f32x4 g6[4] = {*(const f32x4*)(gp + lane6 * 4), *(const f32x4*)(gp + lane6 * 4 + 256), *(const f32x4*)(gp + lane6 * 4 + 512), *(const f32x4*)(gp + lane6 * 4 + 768)};
        for (int rep = 0; rep < REP(6); ++rep)
        for (int t6b = 0; t6b < 4; ++t6b) {
            const int mb = ((gw >> 5) + 64 * (t6b >> 1)) * 256 + ((gw >> 3) & 3) * 64 + (gw & 7) * 8 + (t6b & 1) * 4;
            float ssr[4]; u32x2 yw[4][4]; f32x4 xv[4][4];
#pragma unroll
            for (int r = 0; r < 4; ++r) { const int m = mb + r; ssr[r] = RSQ[(size_t)m * 64 + lane6];
#pragma unroll
                for (int j = 0; j < 4; ++j) { const int c0 = lane6 * 4 + 256 * j; yw[r][j] = *(const u32x2*)(Yb + (size_t)m * DM + c0); xv[r][j] = *(const f32x4*)(xin + (size_t)m * DM + c0); } }
#pragma unroll
            for (int r = 0; r < 4; ++r) { const int m = mb + r;
                const float rstd = 1.f / sqrtf(wave_sum(ssr[r]) * (1.f / 1024.f) + EPS);
                float* orow = F.out + (size_t)m * DM;
#pragma unroll
                for (int j = 0; j < 4; ++j) { const int c0 = lane6 * 4 + 256 * j; const f32x4 g = g6[j];
                    f32x4 o; o.x = xv[r][j].x + bflo(yw[r][j].x) * rstd * g.x; o.y = xv[r][j].y + bfhi(yw[r][j].x) * rstd * g.y; o.z = xv[r][j].z + bflo(yw[r][j].y) * rstd * g.z; o.w = xv[r][j].w + bfhi(yw[r][j].y) * rstd * g.w;
                    *(f32x4*)(orow + c0) = o; } }
        }
    }
#ifndef DUMP
#define DUMP 0
#endif
    if (DUMP == 13 && lo <= 8 && 8 < hi) {
        const int t8 = fresh_tid();
        for (size_t i = (size_t)blockIdx.x * 512 + t8; i < (size_t)MTOK * DM / 2; i += (size_t)gridDim.x * 512) ((unsigned*)TBUF(ws, 1))[i] = ((const unsigned*)(outb + OUT_P))[i];
    }
    if (DUMP && MK_N_LAUNCHES == 1) xcd_barrier(bar);
    if (DUMP && ((lo <= 7 && 7 < hi) || MK_N_LAUNCHES == 1)) {
        const int t7 = fresh_tid();
        for (size_t i = (size_t)blockIdx.x * 512 + t7; i < (size_t)MTOK * DM / 2; i += (size_t)gridDim.x * 512) {
            float a = 0.f, b = 0.f;
#define ADDB(ptr) do { const unsigned w = ((const unsigned*)(ptr))[i]; a += bflo(w); b += bfhi(w); } while (0)
            if (DUMP == 1) { ADDB(TBUF(ws, 0)); ADDB(TBUF(ws, 2)); ADDB(GBUF(ws, 0)); ADDB(GBUF(ws, 1)); ADDB(GBUF(ws, 2)); const unsigned w = ((const unsigned*)(ws + WS_KM))[i & (4096 * 512 - 1)]; a += bflo(w); b += bfhi(w); const unsigned w2 = ((const unsigned*)(ws + WS_VT))[i & (4096 * 512 - 1)]; a += bflo(w2); b += bfhi(w2); }
            if (DUMP == 2) { ADDB(TBUF(ws, 0)); ADDB(TBUF(ws, 1)); ADDB(TBUF(ws, 2)); }
            if (DUMP == 3) { ADDB(TBUF(ws, 0)); ADDB(TBUF(ws, 1)); ADDB(TBUF(ws, 2)); ADDB(GBUF(ws, 0)); ADDB(GBUF(ws, 1)); ADDB(GBUF(ws, 2)); }
            if (DUMP == 4) { ADDB(ws + WS_G + 2 * UB - 0); }
            if (DUMP == 5) { ADDB(TBUF(ws, 0)); }
            if (DUMP == 10) { ADDB(TBUF(ws, 0)); }
            if (DUMP == 11 || DUMP == 13) { ADDB(TBUF(ws, 1)); }
            if (DUMP == 12) { ADDB(TBUF(ws, 2)); }
            ((f32x2*)F.out)[i] = (f32x2){a, b};
        }
    }
#undef IN
#undef SEAM
#undef grp_on
#undef KO_
}

extern "C" void kernel_launch(void* const* d_in, const int* in_sizes, int n_in, void* d_out, int out_size, void* d_ws, size_t ws_size, hipStream_t stream) {
    static int grid = 0;
    if (grid == 0) {
        if (n_in != 22 || in_sizes[0] != MTOK * DM || out_size != MTOK * DM || ws_size < WS_XN + 64 * MiB + (REPMASK ? UB : 0)) { fprintf(stderr, "kernel_launch: unexpected shapes / workspace (n_in %d, ws %zu, need %zu)\n", n_in, ws_size, (size_t)WS_END); grid = -1; return; }
        int dev = 0, cus = 0;
        if (hipGetDevice(&dev) != hipSuccess || hipDeviceGetAttribute(&cus, hipDeviceAttributeMultiprocessorCount, dev) != hipSuccess) { grid = -1; return; }
        if (hipFuncSetAttribute((const void*)mk_fwd, hipFuncAttributeMaxDynamicSharedMemorySize, LDS_BYTES) != hipSuccess) { fprintf(stderr, "kernel_launch: hipFuncSetAttribute failed\n"); grid = -1; return; }
        int per_cu = 0;
        if (hipOccupancyMaxActiveBlocksPerMultiprocessor(&per_cu, (const void*)mk_fwd, 512, LDS_BYTES) != hipSuccess || per_cu < 1) fprintf(stderr, "kernel_launch: occupancy query says %d\n", per_cu);
        (void)hipGetLastError();
        if (cus < 256) { fprintf(stderr, "kernel_launch: this kernel deals its P3..P5 work to 64 groups of four workgroups and needs 256 CUs (found %d)\n", cus); grid = -1; return; }
        grid = 256;
    }
    if (grid < 0) return;
    (void)hipMemsetAsync((char*)d_ws + WS_CTL, 0, CTL_ZERO_BYTES, stream);
    Args a{};
    for (int i = 0; i < 22; ++i) a.in[i] = (const float*)d_in[i];
    a.out = (float*)d_out; a.ws = (unsigned char*)d_ws;
    if (MK_N_LAUNCHES == 1) { a.ph_lo = 0; a.ph_hi = DUMP ? (DUMP >= 10 ? 3 : DUMP + 1) : N_PHASES; hipLaunchKernelGGL(mk_fwd, dim3(grid), dim3(512), LDS_BYTES, stream, a); }
    else { const int np = DUMP ? (DUMP >= 10 ? 3 : DUMP + 1) : N_PHASES;
        for (int p = 0; p < np; ++p) { a.ph_lo = p; a.ph_hi = p + 1; hipLaunchKernelGGL(mk_fwd, dim3(grid), dim3(512), LDS_BYTES, stream, a); }
        if (DUMP == 13) { a.ph_lo = 8; a.ph_hi = 9; hipLaunchKernelGGL(mk_fwd, dim3(grid), dim3(512), LDS_BYTES, stream, a); }
        if (DUMP) { a.ph_lo = 7; a.ph_hi = 8; hipLaunchKernelGGL(mk_fwd, dim3(grid), dim3(512), LDS_BYTES, stream, a); } }
}
```
